# Optimizing an MI355X kernel written in HIP

```python
import math
import jax, jax.numpy as jnp
from jax import lax
import numpy as np

D_MODEL = 1024
BATCH = 8
SEQ = 4096
DEPTH = 2

HEAD_DIM = 64
ROPE_THETA = 500000.0
ROPE_DIM = HEAD_DIM // 4
NORM_EPS = 1e-6
Q_BLOCK = 128
NEG = -1e30
D_FF = 4 * D_MODEL

A_HEADS = 4
A_NOPE = HEAD_DIM - ROPE_DIM
A_VDIM = HEAD_DIM
A_KV_RANK = 128
IDX_HEADS = 4
IDX_DIM = 32
IDX_ROPE = IDX_DIM // 4
DSA_TOPK = 256

B_WIDTH = 256
S5_GROUP = 16
S5_GROUPS = B_WIDTH // S5_GROUP
S5_STATE = 64
S5_DT_MIN = 1e-3
S5_DT_MAX = 1e-1

C_HEADS = 8
C_KV_HEADS = 2
C_GROUP = C_HEADS // C_KV_HEADS
CMP_BLOCK = 32
CMP_STRIDE = 16
SEL_BLOCK = 64
SEL_TOPN = 16
SEL_FORCE = 1e9
WINDOW = 512

D_MIX = A_HEADS * A_VDIM + B_WIDTH + C_HEADS * HEAD_DIM
IN_SIZES = (
    A_HEADS * HEAD_DIM,
    A_KV_RANK,
    ROPE_DIM,
    IDX_HEADS * IDX_DIM,
    IDX_DIM,
    IDX_HEADS,
    B_WIDTH,
    C_HEADS * HEAD_DIM,
    6 * C_KV_HEADS * HEAD_DIM,
    3 * C_HEADS,
)
N_IN = sum(IN_SIZES)

kernel_name = "hybrid_dsa_s5_nsa_parallel_heads"


def rms_norm(x, g):
    xf = x.astype(jnp.float32)
    y = xf * lax.rsqrt(jnp.mean(xf * xf, axis=-1, keepdims=True) + NORM_EPS)
    return (y * g.astype(jnp.float32)).astype(x.dtype)


def rope_tables(positions, rot_dim):
    inv = ROPE_THETA ** (-jnp.arange(0, rot_dim, 2, dtype=jnp.float32) / rot_dim)
    ang = positions.astype(jnp.float32)[..., None] * inv
    return jnp.cos(ang), jnp.sin(ang)


def partial_rope(x, cos, sin):
    half = cos.shape[-1]
    shape = cos.shape[:2] + (1,) * (x.ndim - 3) + (half,)
    c = cos.reshape(shape).astype(x.dtype)
    s = sin.reshape(shape).astype(x.dtype)
    x1, x2, rest = x[..., :half], x[..., half:2 * half], x[..., 2 * half:]
    return jnp.concatenate([x1 * c - x2 * s, x2 * c + x1 * s, rest], axis=-1)


def masked_softmax(s, mask):
    s = jnp.where(mask, s.astype(jnp.float32), NEG)
    p = jax.nn.softmax(s, axis=-1)
    return jnp.where(mask, p, 0.0)


def to_blocks(a):
    b, l = a.shape[:2]
    return jnp.moveaxis(a.reshape((b, l // Q_BLOCK, Q_BLOCK) + a.shape[2:]), 1, 0)


def from_blocks(a):
    nb, b, q = a.shape[:3]
    return jnp.moveaxis(a, 0, 1).reshape((b, nb * q) + a.shape[3:])


def sel_overlap(n_cmp, n_blk):
    cs = np.arange(n_cmp)[:, None] * CMP_STRIDE
    ss = np.arange(n_blk)[None, :] * SEL_BLOCK
    ov = np.minimum(cs + CMP_BLOCK, ss + SEL_BLOCK) - np.maximum(cs, ss)
    return np.clip(ov, 0, None).astype(np.float32) / CMP_BLOCK


def dsa_mixer(q, ckv, k_rope, iq, ik, iw, cos, sin, cos_i, sin_i, kv_g, w_uk, w_uv):
    bsz, seq = q.shape[:2]
    k_top = min(DSA_TOPK, seq // 4)
    q = partial_rope(q.reshape(bsz, seq, A_HEADS, HEAD_DIM), cos, sin)
    q_rope, q_nope = q[..., :ROPE_DIM], q[..., ROPE_DIM:]
    q_lat = jnp.einsum('bthn,rhn->bthr', q_nope, w_uk)
    c = rms_norm(ckv, kv_g)
    k_rope = partial_rope(k_rope, cos, sin)
    iq = partial_rope(iq.reshape(bsz, seq, IDX_HEADS, IDX_DIM), cos_i, sin_i)
    ik = partial_rope(ik, cos_i, sin_i)
    iw = iw.astype(jnp.float32) * IDX_HEADS ** -0.5
    key_pos = jnp.arange(seq)
    take = jax.vmap(lambda a, i: a[i])

    def block(args):
        ql, qr, iqb, iwb, t = args
        rel = jax.nn.relu(jnp.einsum('bqhd,bsd->bqhs', iqb, ik).astype(jnp.float32) * IDX_DIM ** -0.5)
        score = jnp.einsum('bqhs,bqh->bqs', rel, iwb)
        score = jnp.where(key_pos[None, None, :] <= t[None, :, None], score, -jnp.inf)
        _, sel = lax.top_k(score, k_top)
        c_sel = take(c, sel)
        kr_sel = take(k_rope, sel)
        s = (jnp.einsum('bqhr,bqkr->bqhk', ql, c_sel)
             + jnp.einsum('bqhd,bqkd->bqhk', qr, kr_sel)) * HEAD_DIM ** -0.5
        p = masked_softmax(s, (sel <= t[None, :, None])[:, :, None, :])
        o_lat = jnp.einsum('bqhk,bqkr->bqhr', p.astype(c.dtype), c_sel)
        return jnp.einsum('bqhr,rhv->bqhv', o_lat, w_uv)

    t_blocks = key_pos.reshape(-1, Q_BLOCK)
    out = lax.map(block, (to_blocks(q_lat), to_blocks(q_rope), to_blocks(iq), to_blocks(iw), t_blocks))
    return from_blocks(out).reshape(bsz, seq, A_HEADS * A_VDIM)


def _complex_linear_combine(e1, e2):
    a1r, a1i, b1r, b1i = e1
    a2r, a2i, b2r, b2i = e2
    return (a2r * a1r - a2i * a1i, a2r * a1i + a2i * a1r,
            a2r * b1r - a2i * b1i + b2r, a2r * b1i + a2i * b1r + b2i)


def s5_mixer(u, lam_re, lam_im, log_step, b_re, b_im, c_re, c_im, d, glu_w, glu_b):
    f32 = jnp.float32
    bsz, seq, _ = u.shape
    ug = u.astype(f32).reshape(bsz, seq, S5_GROUPS, S5_GROUP)
    lr, li = lam_re.astype(f32), lam_im.astype(f32)
    step = jnp.exp(log_step.astype(f32))[:, None]
    mag = jnp.exp(lr * step)
    ar, ai = mag * jnp.cos(li * step), mag * jnp.sin(li * step)
    den = lr * lr + li * li
    zr = ((ar - 1.0) * lr + ai * li) / den
    zi = (ai * lr - (ar - 1.0) * li) / den
    br, bi = b_re.astype(f32), b_im.astype(f32)
    bbr = zr[..., None] * br - zi[..., None] * bi
    bbi = zr[..., None] * bi + zi[..., None] * br
    xr = jnp.einsum('blgh,gph->lbgp', ug, bbr)
    xi = jnp.einsum('blgh,gph->lbgp', ug, bbi)
    a_shape = (seq, 1) + ar.shape
    _, _, hr, hi = lax.associative_scan(
        _complex_linear_combine,
        (jnp.broadcast_to(ar, a_shape), jnp.broadcast_to(ai, a_shape), xr, xi), axis=0)
    y = (jnp.einsum('lbgp,ghp->blgh', hr, c_re.astype(f32))
         - jnp.einsum('lbgp,ghp->blgh', hi, c_im.astype(f32))
         + d.astype(f32) * ug)
    y = jax.nn.gelu(y.reshape(bsz, seq, B_WIDTH))
    y = y * jax.nn.sigmoid(y @ glu_w.astype(f32) + glu_b.astype(f32))
    return y.astype(u.dtype)


def nsa_mixer(q, kv, gate, cos, sin, pos_k, pos_v, k_w1, k_w2, v_w1, v_w2):
    bsz, seq = q.shape[:2]
    G, HG, DH = C_KV_HEADS, C_GROUP, HEAD_DIM
    q = q.reshape(bsz, seq, G, HG, DH)
    q_rot = partial_rope(q, cos, sin)
    kv = kv.reshape(bsz, seq, 6, G, DH)
    k_c, v_c, k_s, v_s, k_w, v_w = (kv[:, :, i] for i in range(6))
    k_s = partial_rope(k_s, cos, sin)
    k_w = partial_rope(k_w, cos, sin)
    gate = jax.nn.sigmoid(gate.astype(jnp.float32)).reshape(bsz, seq, G, HG, 3)

    n_cmp = (seq - CMP_BLOCK) // CMP_STRIDE + 1
    n_blk = seq // SEL_BLOCK
    n_top = min(SEL_TOPN, n_blk)
    cmp_tok = np.arange(n_cmp)[:, None] * CMP_STRIDE + np.arange(CMP_BLOCK)[None, :]
    cmp_end = jnp.asarray(cmp_tok[:, -1])
    overlap = jnp.asarray(sel_overlap(n_cmp, n_blk))

    def compress(a, pos, w1, w2):
        blk = a[:, cmp_tok] + pos[:, None, :]
        blk = jnp.moveaxis(blk, 3, 2).reshape(bsz, n_cmp, G, CMP_BLOCK * DH)
        return jax.nn.gelu(blk @ w1) @ w2

    k_cmp = compress(k_c, pos_k, k_w1, k_w2)
    v_cmp = compress(v_c, pos_v, v_w1, v_w2)
    pad = ((0, 0), (WINDOW, 0), (0, 0), (0, 0))
    k_wp, v_wp = jnp.pad(k_w, pad), jnp.pad(v_w, pad)
    blk_id = jnp.arange(n_blk)
    tok_in_blk = jnp.arange(SEL_BLOCK)
    slab = jnp.arange(WINDOW + Q_BLOCK)
    b_idx = jnp.arange(bsz)[:, None, None, None]
    g_idx = jnp.arange(G)[None, None, :, None]
    scale = DH ** -0.5

    def block(args):
        qb, qrb, gb, t = args
        s_c = jnp.einsum('bqghd,bngd->bqghn', qb, k_cmp) * scale
        p_c = masked_softmax(s_c, (cmp_end[None, :] <= t[:, None])[None, :, None, None, :])
        o_c = jnp.einsum('bqghn,bngd->bqghd', p_c.astype(v_cmp.dtype), v_cmp)
        imp = jnp.einsum('bqghn,nm->bqgm', p_c, overlap)
        cur = (t // SEL_BLOCK)[:, None]
        forced = (blk_id[None] == 0) | (blk_id[None] == cur) | (blk_id[None] == cur - 1)
        imp = jnp.where(forced[None, :, None, :], SEL_FORCE, imp)
        imp = jnp.where((blk_id[None] * SEL_BLOCK <= t[:, None])[None, :, None, :], imp, -jnp.inf)
        _, sel = lax.top_k(imp, n_top)
        tok = (sel[..., None] * SEL_BLOCK + tok_in_blk).reshape(bsz, Q_BLOCK, G, n_top * SEL_BLOCK)
        ks = k_s[b_idx, tok, g_idx]
        vs = v_s[b_idx, tok, g_idx]
        s_s = jnp.einsum('bqghd,bqgtd->bqght', qrb, ks) * scale
        p_s = masked_softmax(s_s, (tok <= t[None, :, None, None])[:, :, :, None, :])
        o_s = jnp.einsum('bqght,bqgtd->bqghd', p_s.astype(vs.dtype), vs)
        q0 = t[0]
        kw = lax.dynamic_slice_in_dim(k_wp, q0, WINDOW + Q_BLOCK, axis=1)
        vw = lax.dynamic_slice_in_dim(v_wp, q0, WINDOW + Q_BLOCK, axis=1)
        s_pos = q0 - WINDOW + slab
        win = ((s_pos[None] <= t[:, None]) & (s_pos[None] > t[:, None] - WINDOW)
               & (s_pos[None] >= 0))
        s_w = jnp.einsum('bqghd,bsgd->bqghs', qrb, kw) * scale
        p_w = masked_softmax(s_w, win[None, :, None, None, :])
        o_w = jnp.einsum('bqghs,bsgd->bqghd', p_w.astype(vw.dtype), vw)
        o = gb[..., 0:1] * o_c + gb[..., 1:2] * o_s + gb[..., 2:3] * o_w
        return o.astype(qb.dtype)

    t_blocks = jnp.arange(seq).reshape(-1, Q_BLOCK)
    out = lax.map(block, (to_blocks(q), to_blocks(q_rot), to_blocks(gate), t_blocks))
    return from_blocks(out).reshape(bsz, seq, C_HEADS * HEAD_DIM)


def setup_inputs(seed: int = 0) -> dict:
    key = jax.random.key(seed)
    ks = iter(jax.random.split(key, 32))
    f32 = jnp.float32

    def nrm(shape, scale):
        return jax.random.normal(next(ks), shape, f32) * scale

    def gain(shape):
        return 1.0 + 0.02 * jax.random.normal(next(ks), shape, f32)

    x = nrm((BATCH, SEQ, D_MODEL), 1.0)
    start = jax.random.randint(next(ks), (BATCH, 1), 0, 1024, dtype=jnp.int32)
    positions = start + jnp.arange(SEQ, dtype=jnp.int32)[None, :]
    gp = (DEPTH, S5_GROUPS, S5_STATE)
    return {
        'x': x,
        'positions': positions,
        'ln1_g': gain((DEPTH, D_MODEL)),
        'w_in': nrm((DEPTH, D_MODEL, N_IN), D_MODEL ** -0.5),
        'kv_norm_g': gain((DEPTH, A_KV_RANK)),
        'w_uk': nrm((DEPTH, A_KV_RANK, A_HEADS, A_NOPE), A_KV_RANK ** -0.5),
        'w_uv': nrm((DEPTH, A_KV_RANK, A_HEADS, A_VDIM), A_KV_RANK ** -0.5),
        's5_lambda_re': -0.5 + nrm(gp, 0.01),
        's5_lambda_im': math.pi * jnp.arange(S5_STATE, dtype=f32) + nrm(gp, 0.01),
        's5_log_step': jax.random.uniform(next(ks), (DEPTH, S5_GROUPS), f32,
                                          math.log(S5_DT_MIN), math.log(S5_DT_MAX)),
        's5_b_re': nrm((DEPTH, S5_GROUPS, S5_STATE, S5_GROUP), (2 * S5_GROUP) ** -0.5),
        's5_b_im': nrm((DEPTH, S5_GROUPS, S5_STATE, S5_GROUP), (2 * S5_GROUP) ** -0.5),
        's5_c_re': nrm((DEPTH, S5_GROUPS, S5_GROUP, S5_STATE), (2 * S5_STATE) ** -0.5),
        's5_c_im': nrm((DEPTH, S5_GROUPS, S5_GROUP, S5_STATE), (2 * S5_STATE) ** -0.5),
        's5_d': nrm((DEPTH, S5_GROUPS, S5_GROUP), 1.0),
        's5_glu_w': nrm((DEPTH, B_WIDTH, B_WIDTH), B_WIDTH ** -0.5),
        's5_glu_b': nrm((DEPTH, B_WIDTH), 0.01),
        'cmp_pos_k': nrm((DEPTH, CMP_BLOCK, HEAD_DIM), 0.02),
        'cmp_pos_v': nrm((DEPTH, CMP_BLOCK, HEAD_DIM), 0.02),
        'cmp_k_w1': nrm((DEPTH, CMP_BLOCK * HEAD_DIM, HEAD_DIM), (CMP_BLOCK * HEAD_DIM) ** -0.5),
        'cmp_k_w2': nrm((DEPTH, HEAD_DIM, HEAD_DIM), HEAD_DIM ** -0.5),
        'cmp_v_w1': nrm((DEPTH, CMP_BLOCK * HEAD_DIM, HEAD_DIM), (CMP_BLOCK * HEAD_DIM) ** -0.5),
        'cmp_v_w2': nrm((DEPTH, HEAD_DIM, HEAD_DIM), HEAD_DIM ** -0.5),
        'gain_a': gain((DEPTH, A_HEADS * A_VDIM)),
        'gain_b': gain((DEPTH, B_WIDTH)),
        'gain_c': gain((DEPTH, C_HEADS * HEAD_DIM)),
        'w_out': nrm((DEPTH, D_MIX, D_MODEL), D_MIX ** -0.5),
        'ln2_g': gain((DEPTH, D_MODEL)),
        'w_up': nrm((DEPTH, D_MODEL, D_FF), D_MODEL ** -0.5),
        'w_down': nrm((DEPTH, D_FF, D_MODEL), D_FF ** -0.5),
        'final_g': gain((D_MODEL,)),
    }


def reference(x, positions, ln1_g, w_in, kv_norm_g, w_uk, w_uv,
              s5_lambda_re, s5_lambda_im, s5_log_step, s5_b_re, s5_b_im,
              s5_c_re, s5_c_im, s5_d, s5_glu_w, s5_glu_b,
              cmp_pos_k, cmp_pos_v, cmp_k_w1, cmp_k_w2, cmp_v_w1, cmp_v_w2,
              gain_a, gain_b, gain_c, w_out, ln2_g, w_up, w_down, final_g):
    cos, sin = rope_tables(positions, ROPE_DIM)
    cos_i, sin_i = rope_tables(positions, IDX_ROPE)
    offsets = np.cumsum(IN_SIZES)[:-1].tolist()
    for layer in range(DEPTH):
        h = rms_norm(x, ln1_g[layer])
        (a_q, a_ckv, a_kr, i_q, i_k, i_w, b_u, c_q, c_kv, c_gate) = jnp.split(
            h @ w_in[layer], offsets, axis=-1)
        a_out = dsa_mixer(a_q, a_ckv, a_kr, i_q, i_k, i_w, cos, sin, cos_i, sin_i,
                          kv_norm_g[layer], w_uk[layer], w_uv[layer])
        b_out = s5_mixer(b_u, s5_lambda_re[layer], s5_lambda_im[layer], s5_log_step[layer],
                         s5_b_re[layer], s5_b_im[layer], s5_c_re[layer], s5_c_im[layer],
                         s5_d[layer], s5_glu_w[layer], s5_glu_b[layer])
        c_out = nsa_mixer(c_q, c_kv, c_gate, cos, sin, cmp_pos_k[layer], cmp_pos_v[layer],
                          cmp_k_w1[layer], cmp_k_w2[layer], cmp_v_w1[layer], cmp_v_w2[layer])
        mixed = jnp.concatenate([rms_norm(a_out, gain_a[layer]),
                                 rms_norm(b_out, gain_b[layer]),
                                 rms_norm(c_out, gain_c[layer])], axis=-1)
        x = x + mixed @ w_out[layer]
        z = rms_norm(x, ln2_g[layer]) @ w_up[layer]
        x = x + jnp.square(jax.nn.relu(z)) @ w_down[layer]
    return rms_norm(x, final_g)
```

```cpp
#include <hip/hip_runtime.h>
#include <hip/hip_cooperative_groups.h>
#include <cstdio>
#include <cmath>
namespace cg = cooperative_groups;

#define LAS __attribute__((address_space(3)))
#define GAS __attribute__((address_space(1)))
typedef _Float16 f16;
typedef _Float16 h8 __attribute__((ext_vector_type(8)));
typedef _Float16 h4 __attribute__((ext_vector_type(4)));
typedef _Float16 h2 __attribute__((ext_vector_type(2)));
typedef float f32x4 __attribute__((ext_vector_type(4)));
typedef float f32x2 __attribute__((ext_vector_type(2)));
typedef unsigned u32x4 __attribute__((ext_vector_type(4)));
typedef unsigned u32x2 __attribute__((ext_vector_type(2)));
typedef float f32x16 __attribute__((ext_vector_type(16)));
typedef short v4i16_t __attribute__((ext_vector_type(4)));
#define MFMA32(a, b, c) __builtin_amdgcn_mfma_f32_32x32x16_f16((a), (b), (c), 0, 0, 0)

constexpr int BATCH = 8, SEQ = 4096, M = BATCH * SEQ, D = 1024, NIN = 2124, DFF = 4096, DEPTH = 2;
constexpr float EPS = 1e-6f;
constexpr int NWAVES = 8, NTHREADS = 512;
constexpr int LDS_BYTES = 152 * 1024;
constexpr int C_AQ = 0, C_CKV = 256, C_KR = 384, C_IQ = 400, C_IK = 528, C_IW = 560, C_BU = 564, C_CQ = 820, C_CKVN = 1332, C_GATE = 2100;
constexpr int PH_LD = 1792;
constexpr int H_QA = 0, H_KA = 576, H_BU = 720, H_VC = 976, H_KS = 1104, H_VS = 1232, H_KW = 1360, H_VW = 1488, H_GATE = 1616, H_IK = 1640, H_IW = 1672, H_END = 1676;
constexpr int PP_LD = 1024;
constexpr int P_CQ = 0, P_KC = 512, P_IQ = 640, P_IK = 768, P_IW = 800, P_END = 804;
constexpr int P_IKS = 832, P_IQS = 864;
constexpr float ISC = 8.f;
constexpr bool SPLIT = false;
constexpr int NPREC = 768, NPLAIN = 1792;
constexpr float XSCALE = 16.f, WSCALE = 128.f;

constexpr size_t MiB = 1u << 20;
constexpr size_t WS_ROPE = 1 * MiB;
constexpr size_t WS_S5C = 4 * MiB;
constexpr int S5C_STRIDE = 196608;
constexpr int S5_AR = 0, S5_AI = 1024, S5_BBR = 2048, S5_BBI = 18432, S5_ATR = 34816, S5_ATI = 100352, S5_CB = 165888;
constexpr size_t WS_SS1 = 6 * MiB, WS_SS2 = 8 * MiB;
constexpr size_t WS_HLOC = 10 * MiB;
constexpr size_t WS_KCMP = 14 * MiB, WS_VCMP = 15 * MiB;
constexpr size_t WS_W = 16 * MiB, WL_STRIDE = 28 * MiB;
constexpr size_t WL_INP = 0, WL_INH = (size_t)768 * 1024 * 2,        WL_OUT = 10 * MiB, WL_UP = 12 * MiB, WL_DOWN = 20 * MiB;
constexpr size_t WS_XA = 72 * MiB, WS_XB = 136 * MiB, WS_PP = 200 * MiB, WS_PH = 328 * MiB, WS_H = 200 * MiB, WS_BM = 456 * MiB, WS_END = 484 * MiB;
constexpr size_t WS_WUVT = 5 * MiB + 768 * 1024;
constexpr size_t WS_GLUT = 472 * MiB;
constexpr size_t WS_W1T = 474 * MiB;
constexpr size_t WS_BBT = 476 * MiB;
constexpr size_t WS_CMT = 473 * MiB;
constexpr size_t WS_IKT = 480 * MiB;
constexpr size_t XPLANE = WS_XB - WS_XA;

struct Args {
    const float* in[31];
    float* out;
    unsigned char* ws;
    float inv16[8];
    float inv8[4];
    int ph_lo, ph_hi;
};

typedef const Args __attribute__((address_space(4)))* ArgsP;
__device__ __forceinline__ const float* gin(ArgsP a, int i) { return (const float*)(GAS const float*)a->in[i]; }
__device__ __forceinline__ float* gout(ArgsP a) { return (float*)(GAS float*)a->out; }
template <class T> __device__ __forceinline__ T* launder_g(T* p) { GAS T* q = (GAS T*)p; asm volatile("" : "+v"(q)); return (T*)q; }
__device__ __forceinline__ ArgsP fresh_args() { ArgsP p = (ArgsP)__builtin_amdgcn_kernarg_segment_ptr(); asm volatile("" : "+s"(p)); return p; }
template <int CTRL> __device__ __forceinline__ float dpp_mv(float v) { return __builtin_bit_cast(float, __builtin_amdgcn_mov_dpp(__builtin_bit_cast(int, v), CTRL, 0xF, 0xF, true)); }
__device__ __forceinline__ float wave_sum(float v) {
    v += dpp_mv<0xB1>(v); v += dpp_mv<0x4E>(v); v += dpp_mv<0x141>(v); v += dpp_mv<0x140>(v);
    const int vi = __builtin_bit_cast(int, v);
    return (__builtin_bit_cast(float, __builtin_amdgcn_readlane(vi, 0)) + __builtin_bit_cast(float, __builtin_amdgcn_readlane(vi, 16)))
         + (__builtin_bit_cast(float, __builtin_amdgcn_readlane(vi, 32)) + __builtin_bit_cast(float, __builtin_amdgcn_readlane(vi, 48)));
}
__device__ __forceinline__ float wave_max(float v) {
#pragma unroll
    for (int o = 1; o < 64; o <<= 1) v = fmaxf(v, __shfl_xor(v, o));
    return v;
}
__device__ __forceinline__ int wave_sum_i(int v) {
#pragma unroll
    for (int o = 1; o < 64; o <<= 1) v += __shfl_xor(v, o);
    return v;
}
__device__ __forceinline__ float max_x32(float v) { const auto rr = __builtin_amdgcn_permlane32_swap(__float_as_uint(v), __float_as_uint(v), false, false); return fmaxf(__uint_as_float(rr[0]), __uint_as_float(rr[1])); }
__device__ __forceinline__ float add_x32(float v) { const auto rr = __builtin_amdgcn_permlane32_swap(__float_as_uint(v), __float_as_uint(v), false, false); return __uint_as_float(rr[0]) + __uint_as_float(rr[1]); }
__device__ __forceinline__ float partner_x32(float v, int hf) { const auto rr = __builtin_amdgcn_permlane32_swap(__float_as_uint(v), __float_as_uint(v), false, false); return __uint_as_float(hf ? rr[0] : rr[1]); }
__device__ __forceinline__ float gelu_tanh(float x) {
    const float u = 0.7978845608028654f * (x + 0.044715f * x * x * x);
    const float e = __builtin_amdgcn_exp2f(2.885390081777927f * u);
    return x * (1.f - __builtin_amdgcn_rcpf(1.f + e));
}
__device__ __forceinline__ float sigmoidf(float x) { return __builtin_amdgcn_rcpf(1.f + __builtin_amdgcn_exp2f(-1.4426950408889634f * x)); }
__device__ __forceinline__ unsigned mono_key(float f) {
    unsigned u = __float_as_uint(f);
    return (u & 0x80000000u) ? ~u : (u | 0x80000000u);
}
__device__ __forceinline__ void lds_fence() { asm volatile("s_waitcnt lgkmcnt(0)" ::: "memory"); }
template <int CTRL> __device__ __forceinline__ float dpp_f(float v) { return __builtin_bit_cast(float, __builtin_amdgcn_mov_dpp(__builtin_bit_cast(int, v), CTRL, 0xF, 0xF, true)); }

namespace pg8 {
constexpr int BM = 256, BK = 64, HALF = 128, HTB = HALF * BK * 2, STAGE_BYTES = 8 * HTB, NXCD = 8, WGM = 8;
__device__ __forceinline__ int lds_byte(int r, int c) { const int st = (r >> 4) * 2 + (c >> 5), rr = r & 15, cc = c & 31, ob = rr * 64 + cc * 2; return st * 1024 + (ob ^ (((ob >> 9) & 1) << 5)); }
__device__ __forceinline__ void stage_rc(int b, int& R, int& C) { const int st = b / 1024, sb = b % 1024, swz = sb ^ (((sb >> 9) & 1) << 5); R = (st >> 1) * 16 + swz / 64; C = (st & 1) * 32 + (swz % 64) / 2; }
__device__ __forceinline__ int perm32(int rho) { const int n = rho >> 4, i = rho & 15; return 8 * (i >> 2) + 4 * n + (i & 3); }

struct Unit { int pm, pn; };
struct Gemm { const f16* A; const f16* Bt; int lda, ldb, K;
    const float* xin_f; const f16* xin_h; float* xout; f16* XH; float* ss; float rs, hs; };

struct StaticOrder {
    int nM, nN, nwg, G, c, rev;
    __device__ void init(int M_, int N_, int G_, int c_, int rev_ = 0) { nM = M_ / BM; nN = N_ / BM; nwg = nM * nN; G = G_; c = c_; rev = rev_; }
    __device__ bool next(int i, Unit& u) const {
        const long L = (long)i * G + c; if (L >= nwg) return false;
        int wgid = (int)L; { const int q = nwg / NXCD, r = nwg % NXCD, xcd = wgid % NXCD, off = wgid / NXCD; wgid = (xcd < r ? xcd * (q + 1) : r * (q + 1) + (xcd - r) * q) + off; }
        const int nig = WGM * nN, gid = wgid / nig, fm = gid * WGM, gsz = (nM - fm) < WGM ? (nM - fm) : WGM;
        u.pm = fm + ((wgid % nig) % gsz); u.pn = (wgid % nig) / gsz; if (rev) u.pm = nM - 1 - u.pm; return true;
    }
};

template <bool WRAPA>
__device__ __forceinline__ size_t koffA(int kt) {
    if constexpr (WRAPA) return (size_t)(kt & 15) * (BK * 2) + (((kt >> 4) == 1) ? XPLANE : 0);
    else return (size_t)kt * (BK * 2);
}

template <class Epi, bool WRAPA>
__device__ __forceinline__ void gemm_phase(LAS unsigned char* lds, const Gemm g, const StaticOrder& S, const Epi& E) {
    int tid = threadIdx.x; asm volatile("" : "+v"(tid));
    const int wid = __builtin_amdgcn_readfirstlane(tid >> 6), lane = tid & 63, wr = wid >> 2, wc = wid & 3, fr = lane & 15, fq = lane >> 4;
    const int nt = g.K / BK;
    unsigned voffA[2], voffB[2];
#pragma unroll
    for (int i = 0; i < 2; ++i) { int R, C; stage_rc(tid * 16 + i * 8192, R, C); const int Rb = (R & ~31) + perm32(R & 31);
        voffA[i] = (unsigned)(R * g.lda + C) * 2u; voffB[i] = (unsigned)(Rb * g.ldb + C) * 2u; }
    const size_t kstep = (size_t)(BK * 2);
    const size_t hstepA = (size_t)HALF * g.lda * 2, hstepB = (size_t)HALF * g.ldb * 2;
    const size_t tstepA = 2 * hstepA, tstepB = 2 * hstepB;
    const unsigned ldsw = (unsigned)wid * 1024u;
    const int aoff = lds_byte(wr * 64 + fr, fq * 8), boff = lds_byte(wc * 32 + fr, fq * 8);
#define PG8_SA(b, h) (((b) * 2 + (h)) * HTB)
#define PG8_SB(b, h) ((4 + (b) * 2 + (h)) * HTB)
#define PG8_STAGE(bufoff, gbase, voff) do { _Pragma("unroll") for (int _i = 0; _i < 2; ++_i) \
        __builtin_amdgcn_global_load_lds((const unsigned*)((const char*)(gbase) + (voff)[_i]), (LAS unsigned*)(lds + (bufoff) + ldsw + _i * 8192), 16, 0, 0); } while (0)
#define PG8_LDA(dst, b, h) do { _Pragma("unroll") for (int m = 0; m < 4; ++m) _Pragma("unroll") for (int k = 0; k < 2; ++k) dst[m][k] = *(const LAS h8*)(lds + PG8_SA(b, h) + aoff + m * 2048 + k * 1024); } while (0)
#define PG8_LDB(dst, b, h) do { _Pragma("unroll") for (int n = 0; n < 2; ++n) _Pragma("unroll") for (int k = 0; k < 2; ++k) dst[n][k] = *(const LAS h8*)(lds + PG8_SB(b, h) + boff + n * 2048 + k * 1024); } while (0)
#define PG8_MMA(ai, bj, At, Bt) do { __builtin_amdgcn_s_setprio(1); _Pragma("unroll") for (int m = 0; m < 4; ++m) _Pragma("unroll") for (int n = 0; n < 2; ++n) _Pragma("unroll") for (int k = 0; k < 2; ++k) \
        acc[ai][bj][m][n] = __builtin_amdgcn_mfma_f32_16x16x32_f16(Bt[n][k], At[m][k], acc[ai][bj][m][n], 0, 0, 0); __builtin_amdgcn_s_setprio(0); } while (0)
#define PG8_WAIT_V(n) asm volatile("s_waitcnt vmcnt(" #n ")" ::: "memory")
#define PG8_WAIT_L(n) asm volatile("s_waitcnt lgkmcnt(" #n ")" ::: "memory")
#define PG8_BAR __builtin_amdgcn_s_barrier()
#define PG8_SCHED __builtin_amdgcn_sched_barrier(0)
    Unit cur, nxt; int ui = 0;
    if (!S.next(0, cur)) return;
    f32x4 acc[2][2][4][2];
#pragma unroll
    for (int a = 0; a < 2; ++a)
#pragma unroll
        for (int b = 0; b < 2; ++b)
#pragma unroll
            for (int m = 0; m < 4; ++m)
#pragma unroll
                for (int n = 0; n < 2; ++n) acc[a][b][m][n] = (f32x4){0.f, 0.f, 0.f, 0.f};
    h8 At[4][2], B0[2][2], B1[2][2];
    const char* cA = (const char*)g.A + (size_t)cur.pm * tstepA; const char* cB = (const char*)g.Bt + (size_t)cur.pn * tstepB;
    PG8_STAGE(PG8_SB(0, 0), cB, voffB); PG8_STAGE(PG8_SB(0, 1), cB + hstepB, voffB); PG8_STAGE(PG8_SA(0, 0), cA + koffA<WRAPA>(0), voffA); PG8_STAGE(PG8_SA(0, 1), cA + koffA<WRAPA>(0) + hstepA, voffA);
    if (wr == 1) PG8_BAR;
    PG8_WAIT_V(2); PG8_BAR;
    PG8_STAGE(PG8_SB(1, 0), cB + kstep, voffB); PG8_STAGE(PG8_SA(1, 0), cA + koffA<WRAPA>(1), voffA); PG8_STAGE(PG8_SB(1, 1), cB + hstepB + kstep, voffB);
    PG8_WAIT_V(6); PG8_BAR;
    for (;;) {
        const bool has_next = S.next(ui + 1, nxt);
        const char* nA = has_next ? (const char*)g.A + (size_t)nxt.pm * tstepA : cA; const char* nB = has_next ? (const char*)g.Bt + (size_t)nxt.pn * tstepB : cB;
        for (int t = 0; t < nt; t += 2) {
            const bool last = (t == nt - 2);
            const char* a1 = cA + koffA<WRAPA>(t + 1);
            const char* a2 = last ? nA + koffA<WRAPA>(0) : cA + koffA<WRAPA>(t + 2); const char* b2 = last ? nB : cB + (size_t)(t + 2) * kstep;
            const char* a3 = last ? nA + koffA<WRAPA>(1) : cA + koffA<WRAPA>(t + 3); const char* b3 = b2 + kstep;
            PG8_LDB(B0, 0, 0); PG8_LDB(B1, 0, 1); PG8_SCHED; PG8_LDA(At, 0, 0); PG8_STAGE(PG8_SA(1, 1), a1 + hstepA, voffA);
            PG8_WAIT_V(8); PG8_WAIT_L(0); PG8_BAR; PG8_MMA(0, 0, At, B0); PG8_MMA(0, 1, At, B1); PG8_BAR; PG8_SCHED;
            PG8_LDA(At, 0, 1); PG8_STAGE(PG8_SB(0, 0), b2, voffB); PG8_STAGE(PG8_SB(0, 1), b2 + hstepB, voffB); PG8_STAGE(PG8_SA(0, 0), a2, voffA);
            PG8_WAIT_V(8); PG8_WAIT_L(0); PG8_BAR; PG8_MMA(1, 0, At, B0); PG8_MMA(1, 1, At, B1); PG8_BAR; PG8_SCHED;
            PG8_LDB(B0, 1, 0); PG8_LDB(B1, 1, 1); PG8_SCHED; PG8_LDA(At, 1, 0); PG8_STAGE(PG8_SA(0, 1), a2 + hstepA, voffA);
            PG8_WAIT_V(8); PG8_WAIT_L(0); PG8_BAR; PG8_MMA(0, 0, At, B0); PG8_MMA(0, 1, At, B1); PG8_BAR; PG8_SCHED;
            PG8_LDA(At, 1, 1); PG8_STAGE(PG8_SB(1, 0), b3, voffB); PG8_STAGE(PG8_SB(1, 1), b3 + hstepB, voffB); PG8_STAGE(PG8_SA(1, 0), a3, voffA);
            PG8_WAIT_V(8); PG8_WAIT_L(0); PG8_BAR; PG8_MMA(1, 0, At, B0); PG8_MMA(1, 1, At, B1); PG8_BAR; PG8_SCHED;
        }
        if (wr == 0) PG8_BAR;
        E(acc, cur, wr, wc, fr, fq, g);
        if (!has_next) break;
#pragma unroll
        for (int a = 0; a < 2; ++a)
#pragma unroll
            for (int b = 0; b < 2; ++b)
#pragma unroll
                for (int m = 0; m < 4; ++m)
#pragma unroll
                    for (int n = 0; n < 2; ++n) acc[a][b][m][n] = (f32x4){0.f, 0.f, 0.f, 0.f};
        cur = nxt; cA = nA; cB = nB; ++ui;
        if (wr == 1) PG8_BAR;
    }
    PG8_WAIT_V(0);
    PG8_BAR;
#undef PG8_SA
#undef PG8_SB
#undef PG8_STAGE
#undef PG8_LDA
#undef PG8_LDB
#undef PG8_MMA
#undef PG8_WAIT_V
#undef PG8_WAIT_L
#undef PG8_BAR
#undef PG8_SCHED
}

__device__ __forceinline__ float rstd_from_ss(const float* ss, int row) {
    const f32x4* p = (const f32x4*)(ss + (size_t)row * 16);
    const f32x4 a = p[0], b = p[1], c = p[2], d = p[3];
    const float s = ((a[0] + a[1]) + (a[2] + a[3])) + ((b[0] + b[1]) + (b[2] + b[3])) + ((c[0] + c[1]) + (c[2] + c[3])) + ((d[0] + d[1]) + (d[2] + d[3]));
    return rsqrtf(s * (1.f / 1024.f) + EPS);
}
__device__ __forceinline__ u32x4 pack8h(const f32x4 v0, const f32x4 v1) {
    h8 h; h[0] = (f16)v0[0]; h[1] = (f16)v0[1]; h[2] = (f16)v0[2]; h[3] = (f16)v0[3]; h[4] = (f16)v1[0]; h[5] = (f16)v1[1]; h[6] = (f16)v1[2]; h[7] = (f16)v1[3];
    return __builtin_bit_cast(u32x4, h);
}
template <bool F32OUT> struct EpiIn {
    void* O; int ldc; const float* ss; float sc;
    __device__ __forceinline__ void operator()(const f32x4 (&acc)[2][2][4][2], const Unit& u, int wr, int wc, int fr, int fq, const Gemm&) const {
        const int row0 = u.pm * BM + wr * 64 + fr, col0 = u.pn * BM + wc * 32 + 8 * fq;
#pragma unroll
        for (int ai = 0; ai < 2; ++ai)
#pragma unroll
            for (int m = 0; m < 4; ++m) {
                const int row = row0 + ai * HALF + m * 16;
                const float r = rstd_from_ss(ss, row) * sc;
#pragma unroll
                for (int bj = 0; bj < 2; ++bj) {
                    if (col0 + bj * HALF >= (F32OUT ? NPREC : H_END)) continue;
                    const f32x4 v0 = acc[ai][bj][m][0] * r, v1 = acc[ai][bj][m][1] * r;
                    if constexpr (F32OUT) { float* p = (float*)O + (size_t)row * ldc + col0 + bj * HALF; *(f32x4*)p = v0; *(f32x4*)(p + 4) = v1; }
                    else { f16* p = (f16*)O + (size_t)row * ldc + col0 + bj * HALF; *(u32x4*)p = pack8h(v0, v1); }
                }
            }
    }
};
struct EpiInX {
    float* PPo; f16* PHo; const float* ss; float sc1, sc2;
    __device__ __forceinline__ void operator()(const f32x4 (&acc)[2][2][4][2], const Unit& u, int wr, int wc, int fr, int fq, const Gemm&) const {
        const int row0 = u.pm * BM + wr * 64 + fr;
        const bool f32out = u.pn < NPREC / BM;
        const int col0 = (f32out ? u.pn : u.pn - NPREC / BM) * BM + wc * 32 + 8 * fq;
        const float sc = f32out ? sc1 : sc2;
#pragma unroll
        for (int ai = 0; ai < 2; ++ai)
#pragma unroll
            for (int m = 0; m < 4; ++m) {
                const int row = row0 + ai * HALF + m * 16;
                const float r = rstd_from_ss(ss, row) * sc;
#pragma unroll
                for (int bj = 0; bj < 2; ++bj) {
                    const int col = col0 + bj * HALF;
                    const f32x4 v0 = acc[ai][bj][m][0] * r, v1 = acc[ai][bj][m][1] * r;
                    if (f32out) { float* p = PPo + (size_t)row * PP_LD + col; *(f32x4*)p = v0; *(f32x4*)(p + 4) = v1; }
                    else if (col < H_END) *(u32x4*)(PHo + (size_t)row * PH_LD + col) = pack8h(v0, v1);
                }
            }
    }
};
template <bool RES_F16, bool OUT_F32, bool OUT_H> struct EpiRes {
    __device__ __forceinline__ void operator()(const f32x4 (&acc)[2][2][4][2], const Unit& u, int wr, int wc, int fr, int fq, const Gemm& G) const {
        const float* xin_f = G.xin_f; const f16* xin_h = G.xin_h; float* xout = G.xout; f16* XH = G.XH; float* ss = G.ss; const float rs = G.rs, hs = G.hs;
        const int row0 = u.pm * BM + wr * 64 + fr, col0 = u.pn * BM + wc * 32 + 8 * fq;
#pragma unroll
        for (int ai = 0; ai < 2; ++ai)
#pragma unroll
            for (int m = 0; m < 4; ++m) {
                const int row = row0 + ai * HALF + m * 16;
                float sq = 0.f;
#pragma unroll
                for (int bj = 0; bj < 2; ++bj) {
                    const size_t off = (size_t)row * D + col0 + bj * HALF;
                    f32x4 x0, x1;
                    if constexpr (RES_F16) { const h8 xh = *(const h8*)(xin_h + off);
                        x0 = (f32x4){(float)xh[0], (float)xh[1], (float)xh[2], (float)xh[3]} * rs; x1 = (f32x4){(float)xh[4], (float)xh[5], (float)xh[6], (float)xh[7]} * rs; }
                    else { x0 = *(const f32x4*)(xin_f + off); x1 = *(const f32x4*)(xin_f + off + 4); }
                    const f32x4 v0 = acc[ai][bj][m][0] + x0, v1 = acc[ai][bj][m][1] + x1;
                    if constexpr (OUT_F32) { *(f32x4*)(xout + off) = v0; *(f32x4*)(xout + off + 4) = v1; }
                    sq += (v0[0] * v0[0] + v0[1] * v0[1]) + (v0[2] * v0[2] + v0[3] * v0[3]) + (v1[0] * v1[0] + v1[1] * v1[1]) + (v1[2] * v1[2] + v1[3] * v1[3]);
                    if constexpr (OUT_H) *(u32x4*)(XH + off) = pack8h(v0 * hs, v1 * hs);
                }
                sq += __shfl_xor(sq, 16); sq += __shfl_xor(sq, 32);
                if (fq == 0) ss[(size_t)row * 16 + u.pn * 4 + wc] = sq;
            }
    }
};
struct EpiUp {
    f16* O; const float* ss;
    __device__ __forceinline__ void operator()(const f32x4 (&acc)[2][2][4][2], const Unit& u, int wr, int wc, int fr, int fq, const Gemm&) const {
        const int row0 = u.pm * BM + wr * 64 + fr, col0 = u.pn * BM + wc * 32 + 8 * fq;
#pragma unroll
        for (int ai = 0; ai < 2; ++ai)
#pragma unroll
            for (int m = 0; m < 4; ++m) {
                const int row = row0 + ai * HALF + m * 16;
                const float r = rstd_from_ss(ss, row);
#pragma unroll
                for (int bj = 0; bj < 2; ++bj) {
                    f32x4 v0 = acc[ai][bj][m][0] * r, v1 = acc[ai][bj][m][1] * r;
#pragma unroll
                    for (int j = 0; j < 4; ++j) { const float a = fmaxf(v0[j], 0.f), b = fmaxf(v1[j], 0.f); v0[j] = a * a; v1[j] = b * b; }
                    *(u32x4*)(O + (size_t)row * DFF + col0 + bj * HALF) = pack8h(v0, v1);
                }
            }
    }
};
}


#define XB_TMO      128
#define XB_XCNT(j)  (256  + 64 * (j))
#define XB_XSUB(j)  (1280 + 64 * (j))
#define XB_XGEN(j)  (2304 + 64 * (j))
#define XB_TOP      3328
#define XB_TOPGEN   3392
#define XCD_BAR_WORDS 3456
#define XB_SPIN_CAP (1u << 22)
__device__ __forceinline__ unsigned xb_ld(unsigned* p)              { return __hip_atomic_load(p, __ATOMIC_RELAXED, __HIP_MEMORY_SCOPE_AGENT); }
__device__ __forceinline__ unsigned xb_add(unsigned* p, unsigned v) { return __hip_atomic_fetch_add(p, v, __ATOMIC_RELAXED, __HIP_MEMORY_SCOPE_AGENT); }
__device__ __forceinline__ unsigned xb_xcc_id() { return (unsigned)__builtin_amdgcn_s_getreg((3 << 11) | 20) & 0xFu; }
#define XB_SPIN(cond, bar) do { unsigned _sp = 0; while (cond) { __builtin_amdgcn_s_sleep(1); \
    if ((++_sp & 255u) == 0u) { if (xb_ld(&(bar)[XB_TMO])) break; if (_sp > XB_SPIN_CAP) { atomicAdd(&(bar)[XB_TMO], 1u); break; } } } } while (0)
struct XcdBarrier { unsigned* bar; unsigned x; volatile LAS unsigned* st; };
__device__ __forceinline__ XcdBarrier xcd_barrier_post(unsigned* bar, volatile LAS unsigned* st) {
    XcdBarrier b; b.bar = bar; b.x = xb_xcc_id(); b.st = st;
    if (threadIdx.x == 0) (void)xb_add(&bar[XB_XCNT(b.x)], 1u);
    return b;
}
__device__ __forceinline__ void xcd_barrier_complete(unsigned* bar, unsigned x, unsigned& nloc, unsigned& nx) {
    const unsigned G = gridDim.x * gridDim.y * gridDim.z;
    unsigned sum, cnt, mine, sp = 0u;
    for (;;) {
        sum = 0u; cnt = 0u; mine = 0u;
#pragma unroll
        for (unsigned j = 0; j < 16; ++j) { const unsigned c = xb_ld(&bar[XB_XCNT(j)]); sum += c; cnt += (c > 0u) ? 1u : 0u; mine = (j == x) ? c : mine; }
        if (sum == G) break;
        __builtin_amdgcn_s_sleep(1);
        if ((++sp & 255u) == 0u) { if (xb_ld(&bar[XB_TMO])) break; if (sp > XB_SPIN_CAP) { atomicAdd(&bar[XB_TMO], 1u); break; } }
    }
    nloc = mine > 0u ? mine : 1u; nx = cnt > 0u ? cnt : 1u;
}
__device__ __forceinline__ void xcd_barrier(const XcdBarrier& b) {
    asm volatile("s_waitcnt vmcnt(0)" ::: "memory");
    __syncthreads();
    if (threadIdx.x == 0) {
        unsigned* bar = b.bar;
        __builtin_amdgcn_s_waitcnt(0);
        unsigned nloc = b.st[0], nx = b.st[1];
        if (nloc == 0u) { xcd_barrier_complete(bar, b.x, nloc, nx); b.st[0] = nloc; b.st[1] = nx; }
        const unsigned old = xb_add(&bar[XB_XSUB(b.x)], 1u);
        const unsigned gen = old / nloc;
        if (old + 1u == (gen + 1u) * nloc) {
            __builtin_amdgcn_fence(__ATOMIC_RELEASE, "agent");
            asm volatile("s_waitcnt vmcnt(0)" ::: "memory");
            const unsigned og = xb_add(&bar[XB_TOP], 1u);
            const unsigned tg = og / nx;
            if (og + 1u == (tg + 1u) * nx) xb_add(&bar[XB_TOPGEN], 1u);
            else XB_SPIN(xb_ld(&bar[XB_TOPGEN]) == tg, bar);
            __builtin_amdgcn_fence(__ATOMIC_ACQUIRE, "agent");
            xb_add(&bar[XB_XGEN(b.x)], 1u);
            asm volatile("s_waitcnt vmcnt(0)" ::: "memory");
        } else {
            XB_SPIN(xb_ld(&bar[XB_XGEN(b.x)]) == gen, bar);
            __builtin_amdgcn_fence(__ATOMIC_ACQUIRE, "agent");
            asm volatile("s_waitcnt vmcnt(0)" ::: "memory");
        }
    }
    __syncthreads();
}

struct Frame {
    LAS unsigned char* lds;
    GAS unsigned char* ws;
    int tid, lane, wave, gw, ngw, G, bx;
};
__device__ __forceinline__ void refresh(Frame& F) {
    int t = threadIdx.x; asm volatile("" : "+v"(t));
    F.tid = t; F.lane = t & 63; F.wave = __builtin_amdgcn_readfirstlane(t >> 6);
    int bx = blockIdx.x; asm volatile("" : "+s"(bx));
    F.bx = bx; F.gw = bx * NWAVES + F.wave;
    { GAS unsigned char* wsp = F.ws; asm volatile("" : "+s"(wsp)); F.ws = wsp; }
}

__device__ __forceinline__ float winh_val(const float* Win, const float* g1, const float* wuk, int k, int n) {
    int src = -1;
    if (n < H_KA) {
        const int h = n / 144, j = n % 144;
        if (j < 128) return 0.f;
        src = C_AQ + h * 64 + (j - 128);
    }
    else if (n < H_KA + 128) src = C_CKV + (n - H_KA);
    else if (n < H_BU) src = C_KR + (n - H_KA - 128);
    else if (n < H_VC) src = C_BU + (n - H_BU);
    else if (n < H_KS) src = C_CKVN + 128 + (n - H_VC);
    else if (n < H_VS) src = C_CKVN + 256 + (n - H_KS);
    else if (n < H_KW) src = C_CKVN + 384 + (n - H_VS);
    else if (n < H_VW) src = C_CKVN + 512 + (n - H_KW);
    else if (n < H_GATE) src = C_CKVN + 640 + (n - H_VW);
    else if (n < H_IK) src = C_GATE + (n - H_GATE);
    else if (n < H_IW) src = C_IK + (n - H_IK);
    else if (n < H_END) src = C_IW + (n - H_IW);
    if (src < 0) return 0.f;
    return Win[(size_t)k * NIN + src] * g1[k];
}
__device__ __forceinline__ float winp_val(const float* Win, const float* g1, int k, int n) {
    int src = -1;
    if (n < P_KC) src = C_CQ + n;
    else if (n < P_IQ) src = C_CKVN + (n - P_KC);
    else if (n < P_IK) src = C_IQ + (n - P_IQ);
    if (src < 0) return 0.f;
    return Win[(size_t)k * NIN + src] * g1[k];
}

__device__ __forceinline__ void tile_store(const LAS float* scr, f16* dst, int ldd, int k0, int n0, int lane, bool lo_part, bool skip_absorbed = false) {
    const int c = lane & 7;
#pragma unroll
    for (int j = 0; j < 4; ++j) {
        const int n = (lane >> 3) + 8 * j; const LAS float* s = scr + (8 * c) * 33 + n;
        if (skip_absorbed && (n0 + n) < H_KA && ((n0 + n) % 144) < 128) continue;
        h8 o;
#pragma unroll
        for (int e = 0; e < 8; ++e) { const float v = s[e * 33]; const f16 hi = (f16)v; o[e] = lo_part ? (f16)(v - (float)hi) : hi; }
        *(u32x4*)(dst + (size_t)(n0 + n) * ldd + k0 + 8 * c) = __builtin_bit_cast(u32x4, o);
    }
}

__device__ __forceinline__ void p0_prologue(Frame& F, ArgsP a) {
    LAS float* scr = (LAS float*)(F.lds + F.wave * 16384);
    const int lane = F.lane;
    constexpr int T_INP = (NPREC / 32) * (D / 64), T_INH = (NPLAIN / 32) * (D / 64), T_OUT = (D / 32) * (D / 64), T_UP = (DFF / 32) * (D / 64), T_DOWN = (D / 32) * (DFF / 64);
    constexpr int T_LAYER = T_INP + T_INH + T_OUT + T_UP + T_DOWN;
    for (int it = F.gw; it < DEPTH * T_LAYER; it += F.ngw) {
        const int L = it / T_LAYER; int r = it % T_LAYER;
        const float* Win = gin(a, 3) + (size_t)L * D * NIN; const float* g1 = gin(a, 2) + L * D;
        GAS unsigned char* wl = F.ws + WS_W + (size_t)L * WL_STRIDE;
        int kind, nkb;
        if (r < T_INP) { kind = 0; nkb = D / 64; }
        else if ((r -= T_INP) < T_INH) { kind = 1; nkb = D / 64; }
        else if ((r -= T_INH) < T_OUT) { kind = 2; nkb = D / 64; }
        else if ((r -= T_OUT) < T_UP) { kind = 3; nkb = D / 64; }
        else { r -= T_UP; kind = 4; nkb = DFF / 64; }
        const int nb = r / nkb, kb = r % nkb, n0 = nb * 32, k0 = kb * 64;
        const int kkb = lane >> 5, nn = lane & 31, n = n0 + nn;
        if (kind == 0) {
#pragma unroll 8
            for (int i = 0; i < 32; ++i) { const int kk = 2 * i + kkb; scr[kk * 33 + nn] = winp_val(Win, g1, k0 + kk, n) * WSCALE; }
        } else if (kind == 1) {
            for (int i = 0; i < 32; ++i) { const int kk = 2 * i + kkb; scr[kk * 33 + nn] = winh_val(Win, g1, gin(a, 5) + (size_t)L * 128 * 192, k0 + kk, n); }
        } else if (kind == 2) {
            const float* src = gin(a, 26) + (size_t)L * D * D + n;
#pragma unroll 8
            for (int i = 0; i < 32; ++i) { const int kk = 2 * i + kkb; scr[kk * 33 + nn] = src[(size_t)(k0 + kk) * D]; }
        } else if (kind == 3) {
            const float* src = gin(a, 28) + (size_t)L * D * DFF + n; const float* g2 = gin(a, 27) + L * D;
#pragma unroll 8
            for (int i = 0; i < 32; ++i) { const int kk = 2 * i + kkb; scr[kk * 33 + nn] = src[(size_t)(k0 + kk) * DFF] * g2[k0 + kk]; }
        } else {
            const float* src = gin(a, 29) + (size_t)L * DFF * D + n;
#pragma unroll 8
            for (int i = 0; i < 32; ++i) { const int kk = 2 * i + kkb; scr[kk * 33 + nn] = src[(size_t)(k0 + kk) * D]; }
        }
        lds_fence();
        if (kind == 0) tile_store(scr, (f16*)(wl + WL_INP), D, k0, n0, lane, false);
        else if (kind == 1) tile_store(scr, (f16*)(wl + WL_INH), D, k0, n0, lane, false, true);
        else if (kind == 2) tile_store(scr, (f16*)(wl + WL_OUT), D, k0, n0, lane, false);
        else if (kind == 3) tile_store(scr, (f16*)(wl + WL_UP), D, k0, n0, lane, false);
        else tile_store(scr, (f16*)(wl + WL_DOWN), DFF, k0, n0, lane, false);
        lds_fence();
    }
    for (int it = F.gw; it < DEPTH * 4 * 64; it += F.ngw) {
        const int L = it >> 8, h = (it >> 6) & 3, kb = it & 63, k0 = kb * 16;
        const float* Win = gin(a, 3) + (size_t)L * D * NIN + C_AQ + h * 64 + 16; const float* g1 = gin(a, 2) + L * D;
        const float* wuk = gin(a, 5) + (size_t)L * 128 * 192 + h * 48;
        float wa[48], wb[48];
#pragma unroll
        for (int q4 = 0; q4 < 12; ++q4) { const f32x4 va = *(const f32x4*)(wuk + (size_t)lane * 192 + 4 * q4), vb = *(const f32x4*)(wuk + (size_t)(lane + 64) * 192 + 4 * q4);
#pragma unroll
            for (int e = 0; e < 4; ++e) { wa[4 * q4 + e] = va[e]; wb[4 * q4 + e] = vb[e]; } }
        f16* dst = (f16*)(F.ws + WS_W + (size_t)L * WL_STRIDE + WL_INH) + (size_t)(h * 144) * D + k0;
#pragma unroll
        for (int kh = 0; kh < 2; ++kh) {
            h8 oa, ob;
#pragma unroll
            for (int kk = 0; kk < 8; ++kk) {
                const int k = k0 + kh * 8 + kk; const float* wr_ = Win + (size_t)k * NIN; float sa = 0.f, sb = 0.f;
#pragma unroll
                for (int q4 = 0; q4 < 12; ++q4) { const f32x4 x4 = *(const f32x4*)(wr_ + 4 * q4);
#pragma unroll
                    for (int e = 0; e < 4; ++e) { sa += x4[e] * wa[4 * q4 + e]; sb += x4[e] * wb[4 * q4 + e]; } }
                const float gk = g1[k]; oa[kk] = (f16)(sa * gk); ob[kk] = (f16)(sb * gk);
            }
            *(u32x4*)(dst + (size_t)lane * D + kh * 8) = __builtin_bit_cast(u32x4, oa);
            *(u32x4*)(dst + (size_t)(lane + 64) * D + kh * 8) = __builtin_bit_cast(u32x4, ob);
        }
    }
    {
        const float* x = gin(a, 0); f16* XA = (f16*)(F.ws + WS_XA); float* ss = (float*)(F.ws + WS_SS1);
        for (int m0 = F.gw; m0 < M; m0 += 4 * F.ngw) {
            f32x4 v[4][4];
#pragma unroll
            for (int r = 0; r < 4; ++r)
#pragma unroll
                for (int j = 0; j < 4; ++j) v[r][j] = *(const f32x4*)(x + (size_t)min(m0 + r * F.ngw, M - 1) * D + j * 256 + lane * 4);
#pragma unroll
            for (int r = 0; r < 4; ++r) {
                const int m = m0 + r * F.ngw;
                if (m < M) {
                    float sq = 0.f;
#pragma unroll
                    for (int j = 0; j < 4; ++j) {
                        const f32x4 vv = v[r][j];
                        sq += (vv[0] * vv[0] + vv[1] * vv[1]) + (vv[2] * vv[2] + vv[3] * vv[3]);
                        h4 hi;
#pragma unroll
                        for (int e = 0; e < 4; ++e) hi[e] = (f16)(vv[e] * XSCALE);
                        *(u32x2*)(XA + (size_t)m * D + j * 256 + lane * 4) = __builtin_bit_cast(u32x2, hi);
                    }
                    sq = wave_sum(sq);
                    if (lane < 16) ss[(size_t)m * 16 + lane] = (lane == 0) ? sq : 0.f;
                }
            }
        }
    }
    {
        const int* pos = (const int*)gin(a, 1); float* R = (float*)(F.ws + WS_ROPE);
        for (int m = F.bx * NTHREADS + F.tid; m < M; m += F.G * NTHREADS) {
            const float p = (float)pos[m];
#pragma unroll
            for (int i = 0; i < 8; ++i) { const float ang = p * a->inv16[i]; R[(size_t)m * 8 + i] = (float)cos((double)ang); R[(size_t)M * 8 + (size_t)m * 8 + i] = (float)sin((double)ang); }
#pragma unroll
            for (int i = 0; i < 4; ++i) { const float ang = p * a->inv8[i]; R[(size_t)M * 16 + (size_t)m * 4 + i] = (float)cos((double)ang); R[(size_t)M * 20 + (size_t)m * 4 + i] = (float)sin((double)ang); }
        }
    }
    for (int idx = F.bx * NTHREADS + F.tid; idx < DEPTH * 1024; idx += F.G * NTHREADS) {
        const int L = idx >> 10, gp = idx & 1023, g = gp >> 6;
        float* C = (float*)(F.ws + WS_S5C) + (size_t)L * S5C_STRIDE;
        const double lr = gin(a, 7)[L * 1024 + gp], li = gin(a, 8)[L * 1024 + gp], step = exp((double)gin(a, 9)[L * 16 + g]);
        const double mag = exp(lr * step), th = li * step, ar = mag * cos(th), ai = mag * sin(th);
        const double den = lr * lr + li * li, zr = ((ar - 1.0) * lr + ai * li) / den, zi = (ai * lr - (ar - 1.0) * li) / den;
        C[S5_AR + gp] = (float)ar; C[S5_AI + gp] = (float)ai;
        for (int h = 0; h < 16; ++h) {
            const double br = gin(a, 10)[(size_t)L * 16384 + gp * 16 + h], bi = gin(a, 11)[(size_t)L * 16384 + gp * 16 + h];
            C[S5_BBR + gp * 16 + h] = (float)(zr * br - zi * bi); C[S5_BBI + gp * 16 + h] = (float)(zr * bi + zi * br);
        }
    }
    for (int idx = F.bx * NTHREADS + F.tid; idx < DEPTH * 1024 * 64; idx += F.G * NTHREADS) {
        const int k = idx & 63, gp = (idx >> 6) & 1023, L = idx >> 16, g = gp >> 6;
        float* C = (float*)(F.ws + WS_S5C) + (size_t)L * S5C_STRIDE;
        const double lr = gin(a, 7)[L * 1024 + gp], li = gin(a, 8)[L * 1024 + gp], step = exp((double)gin(a, 9)[L * 16 + g]);
        const double e = 64.0 * k, mg = exp(lr * step * e), an = li * step * e;
        C[S5_ATR + k * 1024 + gp] = (float)(mg * cos(an)); C[S5_ATI + k * 1024 + gp] = (float)(mg * sin(an));
    }
    for (int idx = F.bx * NTHREADS + F.tid; idx < DEPTH * 16 * 128 * 16; idx += F.G * NTHREADS) {
        const int ch = idx & 15, col = (idx >> 4) & 127, g = (idx >> 11) & 15, L = idx >> 15, p = col & 63, gp = g * 64 + p;
        const double lr = gin(a, 7)[L * 1024 + gp], li = gin(a, 8)[L * 1024 + gp], step = exp((double)gin(a, 9)[L * 16 + g]);
        const double mag = exp(lr * step), th = li * step, ar = mag * cos(th), ai = mag * sin(th);
        const double den = lr * lr + li * li, zr = ((ar - 1.0) * lr + ai * li) / den, zi = (ai * lr - (ar - 1.0) * li) / den;
        const double br = gin(a, 10)[(size_t)L * 16384 + gp * 16 + ch], bi = gin(a, 11)[(size_t)L * 16384 + gp * 16 + ch];
        ((f16*)(F.ws + WS_BBT))[idx] = (f16)(256.0 * ((col < 64) ? (zr * br - zi * bi) : (zr * bi + zi * br)));
    }
    for (int idx = F.bx * NTHREADS + F.tid; idx < DEPTH * 2 * 64 * 2048; idx += F.G * NTHREADS) {
        const int col = idx & 63, k = (idx >> 6) & 2047, kv = (idx >> 17) & 1, L = idx >> 18;
        const float v = gin(a, kv ? 21 : 19)[(size_t)L * 2048 * 64 + (size_t)k * 64 + col] * WSCALE;
        const f16 hi = (f16)v;
        f16* d = (f16*)(F.ws + WS_W1T) + ((((size_t)((L * 2 + kv) * 2) * 2 + (col >> 5)) * 128 + (k >> 4)) * 64 + (col & 31) + 32 * ((k >> 3) & 1)) * 8 + (k & 7);
        d[0] = hi; d[(size_t)2 * 128 * 512] = (f16)(v - (float)hi);
    }
    for (int idx = F.bx * NTHREADS + F.tid; idx < DEPTH * 16 * 32 * 128; idx += F.G * NTHREADS) {
        const int k = idx & 127, ho = (idx >> 7) & 31, g = (idx >> 12) & 15, L = idx >> 16;
        float v = 0.f;
        if (ho < 16) v = (k < 64) ? gin(a, 12)[(size_t)L * 16384 + (g * 16 + ho) * 64 + k] : -gin(a, 13)[(size_t)L * 16384 + (g * 16 + ho) * 64 + (k - 64)];
        ((f16*)(F.ws + WS_CMT))[((((size_t)(L * 16 + g) * 8 + (k >> 4)) * 64 + ho + 32 * ((k >> 3) & 1)) * 8) + (k & 7)] = (f16)v;
    }
    for (int idx = F.bx * NTHREADS + F.tid; idx < DEPTH * 65536; idx += F.G * NTHREADS) {
        const int col = idx & 255, k = (idx >> 8) & 255, L = idx >> 16;
        ((f16*)(F.ws + WS_GLUT))[((((size_t)(L * 8 + (col >> 5)) * 16 + (k >> 4)) * 64 + (col & 31) + 32 * ((k >> 3) & 1)) * 8) + (k & 7)] = (f16)gin(a, 15)[(size_t)L * 65536 + k * 256 + col];
    }
    for (int idx = F.bx * NTHREADS + F.tid; idx < DEPTH * 4 * 64 * 128; idx += F.G * NTHREADS) {
        const int r = idx & 127, v = (idx >> 7) & 63, h = (idx >> 13) & 3, L = idx >> 15;
        ((f16*)(F.ws + WS_WUVT))[idx] = (f16)gin(a, 6)[(size_t)L * 128 * 256 + r * 256 + h * 64 + v];
    }
    for (int it = F.gw; it < DEPTH * 2 * 32; it += F.ngw) {
        const int L = it >> 6, kv = (it >> 5) & 1, part = it & 31;
        const float* pos = gin(a, 17 + kv) + (size_t)L * 2048 + part * 64; const float* w1 = gin(a, kv ? 21 : 19) + (size_t)L * 2048 * 64 + (size_t)part * 64 * 64;
        float s = 0.f;
#pragma unroll 16
        for (int i = 0; i < 64; ++i) s += pos[i] * w1[(size_t)i * 64 + lane];
        ((float*)(F.ws + WS_S5C) + (size_t)L * S5C_STRIDE + S5_CB)[(part * 2 + kv) * 64 + lane] = s;
    }
}

__device__ __forceinline__ void rope_f16(f16* q, int i, int half, float c, float s) {
    const float x1 = (float)q[i], x2 = (float)q[i + half];
    q[i] = (f16)(x1 * c - x2 * s); q[i + half] = (f16)(x2 * c + x1 * s);
}
__device__ __forceinline__ void rope16h(f16* p, const float* cs, const float* sn) {
    const h8 a = *(const h8*)p, b = *(const h8*)(p + 8);
    const f32x4 c0 = *(const f32x4*)cs, c1 = *(const f32x4*)(cs + 4), s0 = *(const f32x4*)sn, s1 = *(const f32x4*)(sn + 4);
    const float c[8] = {c0[0], c0[1], c0[2], c0[3], c1[0], c1[1], c1[2], c1[3]}, s[8] = {s0[0], s0[1], s0[2], s0[3], s1[0], s1[1], s1[2], s1[3]};
    h8 oa, ob;
#pragma unroll
    for (int i = 0; i < 8; ++i) { const float x1 = (float)a[i], x2 = (float)b[i]; oa[i] = (f16)(x1 * c[i] - x2 * s[i]); ob[i] = (f16)(x2 * c[i] + x1 * s[i]); }
    *(h8*)p = oa; *(h8*)(p + 8) = ob;
}
__device__ __forceinline__ void rope8f(float* p, const float* cs, const float* sn) {
    const f32x4 a = *(const f32x4*)p, b = *(const f32x4*)(p + 4), c = *(const f32x4*)cs, s = *(const f32x4*)sn;
    *(f32x4*)p = a * c - b * s; *(f32x4*)(p + 4) = b * c + a * s;
}
__device__ __forceinline__ void p2_finalize(Frame& F, int L, ArgsP a) {
    const int lane = F.lane, l = lane & 15;
    float* PP = (float*)(F.ws + WS_PP); f16* PH = (f16*)(F.ws + WS_PH); const float* R = (const float*)(F.ws + WS_ROPE);
    const float* kvg = gin(a, 4) + L * 128 + 8 * l;
    const f32x4 kg0 = *(const f32x4*)kvg, kg1 = *(const f32x4*)(kvg + 4);
    for (int m0 = F.gw * 4; m0 < M; m0 += F.ngw * 4) {
        const int m = m0 + (lane >> 4);
        float* pp = PP + (size_t)m * PP_LD; f16* ph = PH + (size_t)m * PH_LD;
        const float* c16 = R + (size_t)m * 8; const float* s16 = R + (size_t)M * 8 + (size_t)m * 8;
        const float* c8 = R + (size_t)M * 16 + (size_t)m * 4; const float* s8 = R + (size_t)M * 20 + (size_t)m * 4;
        const h8 cv = *(const h8*)(ph + H_KA + 8 * l);
        float cf[8]; float sq = 0.f;
#pragma unroll
        for (int i = 0; i < 8; ++i) { cf[i] = (float)cv[i]; sq += cf[i] * cf[i]; }
        sq += dpp_f<0xB1>(sq); sq += dpp_f<0x4E>(sq); sq += dpp_f<0x141>(sq); sq += dpp_f<0x140>(sq);
        if (l < 4) rope16h(ph + H_QA + l * 144 + 128, c16, s16);
        else if (l == 4) rope16h(ph + H_KA + 128, c16, s16);
        else if (l < 7) rope16h(ph + H_KS + (l - 5) * 64, c16, s16);
        else if (l < 9) rope16h(ph + H_KW + (l - 7) * 64, c16, s16);
        else if (l < 14) {
            float* src = (l == 13) ? pp + P_IK : pp + P_IQ + (l - 9) * 32;
            if (l == 13) {
#pragma unroll
                for (int c4 = 0; c4 < 4; ++c4) { const h8 kh = *(const h8*)(ph + H_IK + 8 * c4);
                    *(f32x4*)(src + 8 * c4) = (f32x4){(float)kh[0], (float)kh[1], (float)kh[2], (float)kh[3]}; *(f32x4*)(src + 8 * c4 + 4) = (f32x4){(float)kh[4], (float)kh[5], (float)kh[6], (float)kh[7]}; }
            }
            f16* dh = (f16*)(pp + P_IQS) + (l - 9) * 32; f16* dl = dh + 128;
            f16* kt = (f16*)(F.ws + WS_IKT) + ((size_t)(m >> 5) * 256 + (m & 31)) * 8;
            rope8f(src, c8, s8);
#pragma unroll
            for (int c4 = 0; c4 < 4; ++c4) {
                const f32x4 x0 = *(const f32x4*)(src + 8 * c4), x1 = *(const f32x4*)(src + 8 * c4 + 4);
                h8 hi, lo;
#pragma unroll
                for (int e = 0; e < 4; ++e) { const float a0 = x0[e] * ISC, a1 = x1[e] * ISC; hi[e] = (f16)a0; lo[e] = (f16)(a0 - (float)hi[e]); hi[4 + e] = (f16)a1; lo[4 + e] = (f16)(a1 - (float)hi[4 + e]); }
                if (l == 13) { *(h8*)(kt + ((c4 >> 1) * 64 + 32 * (c4 & 1)) * 8) = hi; *(h8*)(kt + ((2 + (c4 >> 1)) * 64 + 32 * (c4 & 1)) * 8) = lo; }
                else { *(h8*)(dh + 8 * c4) = hi; *(h8*)(dl + 8 * c4) = lo; }
            }
        }
        else if (l == 14) { const h4 wh = *(const h4*)(ph + H_IW); *(f32x4*)(pp + P_IW) = (f32x4){(float)wh[0], (float)wh[1], (float)wh[2], (float)wh[3]} * 0.5f; }
        else {
#pragma unroll
            for (int j = 0; j < 3; ++j) { h8 g = *(const h8*)(ph + H_GATE + 8 * j);
#pragma unroll
                for (int i = 0; i < 8; ++i) g[i] = (f16)sigmoidf((float)g[i]);
                *(h8*)(ph + H_GATE + 8 * j) = g; }
        }
        const float rk = rsqrtf(sq * (1.f / 128.f) + EPS);
        h8 co;
#pragma unroll
        for (int i = 0; i < 4; ++i) { co[i] = (f16)(cf[i] * rk * kg0[i]); co[4 + i] = (f16)(cf[4 + i] * rk * kg1[i]); }
        *(h8*)(ph + H_KA + 8 * l) = co;
    }
}

__device__ __forceinline__ void p2_compress(Frame& F, int L, ArgsP a) {
    const int lane = F.lane, w = F.wave, hf = lane >> 5, r31 = lane & 31;
    const float* PP = (const float*)(F.ws + WS_PP); const f16* PH = (const f16*)(F.ws + WS_PH);
    constexpr int TRS = 144, TSZ = 272 * TRS;
    LAS unsigned char* TH = F.lds; LAS unsigned char* TL = F.lds + TSZ;
    LAS float* part = (LAS float*)(F.lds + 2 * TSZ);
    const float* CB = (const float*)(F.ws + WS_S5C) + (size_t)L * S5C_STRIDE + S5_CB;
    constexpr float ASC = 8.f;
    for (int it = F.bx; it < 512; it += F.G) {
        const int kv = it >> 8, b = (it >> 5) & 7, g = (it >> 4) & 1, nb = it & 15, n0 = nb * 16, tok0 = n0 * 16;
        __syncthreads();
        for (int e = F.tid; e < 272 * 8; e += NTHREADS) {
            const int tl = e >> 3, c8 = e & 7, tok = tok0 + tl; h8 hi, lo;
#pragma unroll
            for (int i = 0; i < 8; ++i) { hi[i] = (f16)0.f; lo[i] = (f16)0.f; }
            if (tok < SEQ) {
                if (kv == 0) {
                    const float* p = PP + (size_t)(b * SEQ + tok) * PP_LD + P_KC + g * 64 + c8 * 8;
                    const f32x4 x0 = *(const f32x4*)p, x1 = *(const f32x4*)(p + 4);
#pragma unroll
                    for (int i = 0; i < 4; ++i) { const float a0 = x0[i] * ASC, a1 = x1[i] * ASC; hi[i] = (f16)a0; lo[i] = (f16)(a0 - (float)hi[i]); hi[4 + i] = (f16)a1; lo[4 + i] = (f16)(a1 - (float)hi[4 + i]); }
                } else {
                    const h8 hv = *(const h8*)(PH + (size_t)(b * SEQ + tok) * PH_LD + H_VC + g * 64 + c8 * 8);
#pragma unroll
                    for (int i = 0; i < 8; ++i) hi[i] = (f16)((float)hv[i] * ASC);
                }
            }
            *(LAS h8*)(TH + tl * TRS + c8 * 16) = hi; *(LAS h8*)(TL + tl * TRS + c8 * 16) = lo;
        }
        __syncthreads();
        f32x16 A0, A1;
#pragma unroll
        for (int i = 0; i < 16; ++i) { A0[i] = 0.f; A1[i] = 0.f; }
        {
            const int nl = (r31 < 16) ? r31 : 15;
            const f16* wt = (const f16*)(F.ws + WS_W1T) + (((size_t)((L * 2 + kv) * 2) * 2 * 128 + 16 * w) * 64 + lane) * 8;
#pragma unroll 8
            for (int s_ = 0; s_ < 16; ++s_) {
                const int kg0 = 256 * w + 16 * s_, l = kg0 >> 6, d0 = (kg0 & 63) + 8 * hf;
                const int off = (16 * nl + l) * TRS + d0 * 2;
                const h8 ah = *(const LAS h8*)(TH + off);
                const h8 bh0 = *(const h8*)(wt + (size_t)s_ * 512), bh1 = *(const h8*)(wt + (size_t)(128 + s_) * 512);
                A0 = MFMA32(ah, bh0, A0); A1 = MFMA32(ah, bh1, A1);
                if (SPLIT && kv == 0) {
                    const h8 al = *(const LAS h8*)(TL + off);
                    const h8 bl0 = *(const h8*)(wt + (size_t)(256 + s_) * 512), bl1 = *(const h8*)(wt + (size_t)(384 + s_) * 512);
                    A0 = MFMA32(ah, bl0, A0); A1 = MFMA32(ah, bl1, A1);
                    A0 = MFMA32(al, bh0, A0); A1 = MFMA32(al, bh1, A1);
                }
            }
        }
#pragma unroll
        for (int i = 0; i < 8; ++i) { const int row = (i & 3) + 8 * (i >> 2) + 4 * hf; part[(w * 16 + row) * 64 + r31] = A0[i]; part[(w * 16 + row) * 64 + 32 + r31] = A1[i]; }
        __syncthreads();
        float acc0 = 0.f, acc1 = 0.f;
#pragma unroll
        for (int ww = 0; ww < 8; ++ww) { acc0 += part[(ww * 16 + 2 * w) * 64 + lane]; acc1 += part[(ww * 16 + 2 * w + 1) * 64 + lane]; }
        float cb = 0.f;
#pragma unroll 8
        for (int part = 0; part < 32; ++part) cb += CB[(part * 2 + kv) * 64 + lane];
        const float osc = 1.f / (ASC * WSCALE);
        const float h0 = gelu_tanh(acc0 * osc + cb), h1 = gelu_tanh(acc1 * osc + cb);
        const float* w2 = gin(a, kv ? 22 : 20) + (size_t)L * 64 * 64;
        float o0 = 0.f, o1 = 0.f;
#pragma unroll
        for (int i0 = 0; i0 < 64; i0 += 16) {
            float wv[16];
#pragma unroll
            for (int i = 0; i < 16; ++i) wv[i] = w2[(i0 + i) * 64 + lane];
#pragma unroll
            for (int i = 0; i < 16; ++i) {
                o0 += __builtin_bit_cast(float, __builtin_amdgcn_readlane(__builtin_bit_cast(int, h0), i0 + i)) * wv[i];
                o1 += __builtin_bit_cast(float, __builtin_amdgcn_readlane(__builtin_bit_cast(int, h1), i0 + i)) * wv[i];
            }
        }
        float* dst = (float*)(F.ws + (kv ? WS_VCMP : WS_KCMP));
        const int na = n0 + 2 * w, nb2 = na + 1;
        if (na < 255) dst[((size_t)(b * 256 + na) * 2 + g) * 64 + lane] = o0;
        if (nb2 < 255) dst[((size_t)(b * 256 + nb2) * 2 + g) * 64 + lane] = o1;
    }
    __syncthreads();
}

__device__ __forceinline__ void s5_load_u(Frame& F, LAS float* ul, int b, int g, int c) {
    const f16* PH = (const f16*)(F.ws + WS_PH);
    const f16* p = PH + (size_t)(b * SEQ + c * 64 + F.lane) * PH_LD + H_BU + g * 16;
    const h8 u0 = *(const h8*)p, u1 = *(const h8*)(p + 8);
    LAS float* d = ul + F.lane * 16;
    *(LAS f32x4*)(d) = (f32x4){(float)u0[0], (float)u0[1], (float)u0[2], (float)u0[3]};
    *(LAS f32x4*)(d + 4) = (f32x4){(float)u0[4], (float)u0[5], (float)u0[6], (float)u0[7]};
    *(LAS f32x4*)(d + 8) = (f32x4){(float)u1[0], (float)u1[1], (float)u1[2], (float)u1[3]};
    *(LAS f32x4*)(d + 12) = (f32x4){(float)u1[4], (float)u1[5], (float)u1[6], (float)u1[7]};
    lds_fence();
}
__device__ __forceinline__ void p2_s5_local(Frame& F, int L) {
    const int lane = F.lane, hf = lane >> 5, r31 = lane & 31;
    const float* C = (const float*)(F.ws + WS_S5C) + (size_t)L * S5C_STRIDE;
    constexpr int HRS = 272;
    LAS unsigned char* ht = F.lds + F.wave * (32 * HRS);
    f32x2* HL = (f32x2*)(F.ws + WS_HLOC);
    for (int it = F.gw; it < 8 * 16 * 64; it += F.ngw) {
        const int b = it >> 10, g = (it >> 6) & 15, c = it & 63, gp = g * 64 + lane;
        const float ar = C[S5_AR + gp], ai = C[S5_AI + gp];
        h8 bb[4];
        {
            const f16* bp_ = (const f16*)(F.ws + WS_BBT) + ((size_t)((L * 16 + g) * 128 + r31)) * 16 + 8 * hf;
#pragma unroll
            for (int ct = 0; ct < 4; ++ct) bb[ct] = *(const h8*)(bp_ + (size_t)ct * 32 * 16);
        }
        const f16* up = (const f16*)(F.ws + WS_PH) + (size_t)(b * SEQ + c * 64 + r31) * PH_LD + H_BU + g * 16 + 8 * hf;
        const h8 uf0 = *(const h8*)up, uf1 = *(const h8*)(up + (size_t)32 * PH_LD);
        float hr = 0.f, hi = 0.f;
#pragma unroll
        for (int half = 0; half < 2; ++half) {
#pragma unroll
            for (int ct = 0; ct < 4; ++ct) {
                f32x16 X;
#pragma unroll
                for (int i = 0; i < 16; ++i) X[i] = 0.f;
                X = MFMA32(half ? uf1 : uf0, bb[ct], X);
#pragma unroll
                for (int i = 0; i < 16; ++i) *(LAS f16*)(ht + ((i & 3) + 8 * (i >> 2) + 4 * hf) * HRS + (32 * ct + r31) * 2) = (f16)X[i];
            }
            lds_fence();
#pragma unroll 8
            for (int jj = 0; jj < 32; ++jj) {
                const float xr = (float)*(const LAS f16*)(ht + jj * HRS + lane * 2) * (1.f / 256.f), xi = (float)*(const LAS f16*)(ht + jj * HRS + 128 + lane * 2) * (1.f / 256.f);
                const float nr = ar * hr - ai * hi + xr, ni = ar * hi + ai * hr + xi; hr = nr; hi = ni;
            }
            lds_fence();
        }
        HL[(size_t)it * 64 + lane] = (f32x2){hr, hi};
    }
}

__device__ __forceinline__ void p4_s5_out(Frame& F, int L, ArgsP a) {
    const int lane = F.lane, w = F.wave, tid = F.tid;
    const float* C = (const float*)(F.ws + WS_S5C) + (size_t)L * S5C_STRIDE;
    LAS f16* yh = (LAS f16*)F.lds;
    LAS float* ul = (LAS float*)(F.lds + 34816 + w * 4096);
    constexpr int HRS = 272;
    LAS unsigned char* ht = F.lds + 67584 + w * (32 * HRS);
    LAS float* bo = (LAS float*)(F.lds + 34816);
    const f32x2* HL = (const f32x2*)(F.ws + WS_HLOC);
    f16* MIX = (f16*)(F.ws + WS_XA);
    const float* dvec = gin(a, 14) + L * 256;
    const float* glub = gin(a, 16) + L * 256; const float* gainb = gin(a, 24) + L * 256;
    const int hf = lane >> 5, r31 = lane & 31;
    for (int it = F.bx; it < 512; it += F.G) {
        const int b = it & 7, cc = (it >> 3) & 31, c = (it < 256) ? cc : 63 - cc;
        __syncthreads();
        for (int gi = 0; gi < 2; ++gi) {
            const int g = 2 * w + gi, gp = g * 64 + lane;
            const float ar = C[S5_AR + gp], ai = C[S5_AI + gp];
            float hr = 0.f, hi = 0.f;
#pragma unroll 16
            for (int cp = 0; cp < c; ++cp) {
                const int k = c - 1 - cp; const float tr = C[S5_ATR + k * 1024 + gp], ti = C[S5_ATI + k * 1024 + gp];
                const f32x2 hl = HL[((size_t)((b * 16 + g) * 64 + cp)) * 64 + lane];
                hr += tr * hl[0] - ti * hl[1]; hi += tr * hl[1] + ti * hl[0];
            }
            h8 bb[4];
            {
                const f16* bp_ = (const f16*)(F.ws + WS_BBT) + ((size_t)((L * 16 + g) * 128 + r31)) * 16 + 8 * hf;
#pragma unroll
                for (int ct = 0; ct < 4; ++ct) bb[ct] = *(const h8*)(bp_ + (size_t)ct * 32 * 16);
            }
            h8 cm[8];
            {
                const f16* cp_ = (const f16*)(F.ws + WS_CMT) + ((size_t)(L * 16 + g) * 8 * 64 + lane) * 8;
#pragma unroll
                for (int s = 0; s < 8; ++s) cm[s] = *(const h8*)(cp_ + (size_t)s * 512);
            }
            s5_load_u(F, ul, b, g, c);
            const float dho = (r31 < 16) ? dvec[g * 16 + r31] : 0.f;
            const f16* up = (const f16*)(F.ws + WS_PH) + (size_t)(b * SEQ + c * 64 + r31) * PH_LD + H_BU + g * 16 + 8 * hf;
            for (int half = 0; half < 2; ++half) {
                {
                    const h8 uf = *(const h8*)(up + (size_t)(half * 32) * PH_LD);
#pragma unroll
                    for (int ct = 0; ct < 4; ++ct) {
                        f32x16 X;
#pragma unroll
                        for (int i = 0; i < 16; ++i) X[i] = 0.f;
                        X = MFMA32(uf, bb[ct], X);
#pragma unroll
                        for (int i = 0; i < 16; ++i) *(LAS f16*)(ht + ((i & 3) + 8 * (i >> 2) + 4 * hf) * HRS + (32 * ct + r31) * 2) = (f16)X[i];
                    }
                }
                lds_fence();
#pragma unroll 8
                for (int jj = 0; jj < 32; ++jj) {
                    LAS f16* pr = (LAS f16*)(ht + jj * HRS + lane * 2); LAS f16* pi = (LAS f16*)(ht + jj * HRS + 128 + lane * 2);
                    const float xr = (float)*pr * (1.f / 256.f), xi = (float)*pi * (1.f / 256.f);
                    const float nr = ar * hr - ai * hi + xr, ni = ar * hi + ai * hr + xi; hr = nr; hi = ni;
                    *pr = (f16)hr; *pi = (f16)hi;
                }
                lds_fence();
                f32x16 Y;
#pragma unroll
                for (int i = 0; i < 16; ++i) Y[i] = 0.f;
#pragma unroll
                for (int s = 0; s < 8; ++s) { const h8 af = *(const LAS h8*)(ht + r31 * HRS + (16 * s + 8 * hf) * 2); Y = MFMA32(af, cm[s], Y); }
                if (r31 < 16) {
#pragma unroll
                    for (int i = 0; i < 16; ++i) {
                        const int tok = half * 32 + (i & 3) + 8 * (i >> 2) + 4 * hf;
                        const float y = Y[i] + dho * ul[tok * 16 + r31];
                        yh[tok * 264 + g * 16 + r31] = (f16)gelu_tanh(y);
                    }
                }
                lds_fence();
            }
        }
        __syncthreads();
        {
            const int hf = lane >> 5, r31 = lane & 31, col = 32 * w + r31;
            f32x16 G0, G1;
#pragma unroll
            for (int i = 0; i < 16; ++i) { G0[i] = 0.f; G1[i] = 0.f; }
            const f16* bp = (const f16*)(F.ws + WS_GLUT) + ((size_t)(L * 8 + w) * 16 * 64 + lane) * 8;
            LAS const f16* ap = yh + r31 * 264 + 8 * hf;
#pragma unroll 8
            for (int s = 0; s < 16; ++s) {
                const h8 bf = *(const h8*)(bp + (size_t)s * 512);
                const h8 a0 = *(const LAS h8*)(ap + 16 * s), a1 = *(const LAS h8*)(ap + 32 * 264 + 16 * s);
                G0 = MFMA32(a0, bf, G0); G1 = MFMA32(a1, bf, G1);
            }
            const float gb = glub[col];
#pragma unroll
            for (int i = 0; i < 16; ++i) {
                const int t0_ = (i & 3) + 8 * (i >> 2) + 4 * hf, t1_ = t0_ + 32;
                bo[t0_ * 256 + col] = (float)yh[t0_ * 264 + col] * sigmoidf(G0[i] + gb);
                bo[t1_ * 256 + col] = (float)yh[t1_ * 264 + col] * sigmoidf(G1[i] + gb);
            }
        }
        __syncthreads();
        for (int i = 0; i < 8; ++i) {
            const int tok = w * 8 + i; const f32x4 v = *(const LAS f32x4*)(bo + tok * 256 + lane * 4);
            float sq = (v[0] * v[0] + v[1] * v[1]) + (v[2] * v[2] + v[3] * v[3]); sq = wave_sum(sq);
            const float r = rsqrtf(sq * (1.f / 256.f) + EPS); const f32x4 gn = *(const f32x4*)(gainb + lane * 4);
            h4 o; o[0] = (f16)(v[0] * r * gn[0]); o[1] = (f16)(v[1] * r * gn[1]); o[2] = (f16)(v[2] * r * gn[2]); o[3] = (f16)(v[3] * r * gn[3]);
            *(u32x2*)(MIX + (size_t)(b * SEQ + c * 64 + tok) * D + 256 + lane * 4) = __builtin_bit_cast(u32x2, o);
        }
    }
    __syncthreads();
}

constexpr int NSA_WSTRIDE = 10240;
struct OS { float m[4], l[4], o[4]; };
__device__ __forceinline__ void nsa_block(Frame& F, OS& st, const LAS float* qr, LAS float* pl, const f16* rowbase  , int tok0, bool valid, int kcol, int vcol) {
    const int lane = F.lane;
    const f16* kp = rowbase + (size_t)(tok0 + lane) * PH_LD + kcol;
    float s0 = 0.f, s1 = 0.f, s2 = 0.f, s3 = 0.f;
#pragma unroll 2
    for (int c8 = 0; c8 < 8; ++c8) {
        const h8 k8 = *(const h8*)(kp + c8 * 8);
#pragma unroll
        for (int q4 = 0; q4 < 2; ++q4) {
            const int d = c8 * 8 + q4 * 4;
            const f32x4 a0 = *(const LAS f32x4*)(qr + d), a1 = *(const LAS f32x4*)(qr + 64 + d), a2 = *(const LAS f32x4*)(qr + 128 + d), a3 = *(const LAS f32x4*)(qr + 192 + d);
#pragma unroll
            for (int e = 0; e < 4; ++e) { const float kf = (float)k8[q4 * 4 + e]; s0 += a0[e] * kf; s1 += a1[e] * kf; s2 += a2[e] * kf; s3 += a3[e] * kf; }
        }
    }
    float sv[4] = {s0, s1, s2, s3}; float al[4]; f32x4 pv;
#pragma unroll
    for (int h = 0; h < 4; ++h) {
        const float s = valid ? sv[h] : -1e30f;
        const float bm = wave_max(s), mn = fmaxf(st.m[h], bm);
        al[h] = __expf(st.m[h] - mn);
        const float p = valid ? __expf(s - mn) : 0.f;
        st.l[h] = st.l[h] * al[h] + wave_sum(p); st.m[h] = mn; st.o[h] *= al[h]; pv[h] = p;
    }
    *(LAS f32x4*)(pl + lane * 4) = pv;
    lds_fence();
    const f16* vp = rowbase + (size_t)tok0 * PH_LD + vcol + lane;
#pragma unroll 8
    for (int i = 0; i < 64; ++i) {
        const float v = (float)vp[(size_t)i * PH_LD]; const f32x4 p4 = *(const LAS f32x4*)(pl + i * 4);
        st.o[0] += p4[0] * v; st.o[1] += p4[1] * v; st.o[2] += p4[2] * v; st.o[3] += p4[3] * v;
    }
    lds_fence();
}
__device__ __forceinline__ void nsa_token(Frame& F, int L, ArgsP a, int b, int t, LAS unsigned char* wl) {
    const int lane = F.lane;
    const float* PP = (const float*)(F.ws + WS_PP); const f16* PH = (const f16*)(F.ws + WS_PH); const float* R = (const float*)(F.ws + WS_ROPE);
    LAS float* qs = (LAS float*)wl; LAS float* qr = (LAS float*)(wl + 1024); LAS float* pc = (LAS float*)(wl + 2048); LAS float* pl = (LAS float*)(wl + 6144); LAS float* cvl = (LAS float*)(wl + 7168);
    const int m = b * SEQ + t, cur = t >> 6;
    const f16* rowbase = PH + (size_t)(b * SEQ) * PH_LD;
    const float* KC = (const float*)(F.ws + WS_KCMP); const float* VC = (const float*)(F.ws + WS_VCMP);
    const f16* gatep = PH + (size_t)m * PH_LD + H_GATE;
    for (int g = 0; g < 2; ++g) {
        {
            const float* qp = PP + (size_t)m * PP_LD + P_CQ + g * 256;
            const float c = (lane < 16) ? R[(size_t)m * 8 + (lane & 7)] : 1.f, s = (lane < 16) ? R[(size_t)M * 8 + (size_t)m * 8 + (lane & 7)] : 0.f;
#pragma unroll
            for (int h = 0; h < 4; ++h) {
                const float x = qp[h * 64 + lane];
                const float other = __shfl_xor(x, 8);
                float xr = x;
                if (lane < 8) xr = x * c - other * s; else if (lane < 16) xr = x * c + other * s;
                qs[h * 64 + lane] = x * 0.125f; qr[h * 64 + lane] = xr * 0.125f;
            }
        }
        lds_fence();
        const int ncv = (t < 31) ? 0 : min(255, ((t - 31) >> 4) + 1);
        float sc[4][4];
#pragma unroll
        for (int j = 0; j < 4; ++j) {
            const int n = j * 64 + lane;
#pragma unroll
            for (int h = 0; h < 4; ++h) sc[j][h] = -1e30f;
            if (j * 64 < ncv) {
                const float* kp = KC + ((size_t)(b * 256 + n) * 2 + g) * 64;
                float s0 = 0.f, s1 = 0.f, s2 = 0.f, s3 = 0.f;
#pragma unroll 4
                for (int d4 = 0; d4 < 16; ++d4) {
                    const f32x4 k4 = *(const f32x4*)(kp + d4 * 4);
                    const f32x4 a0 = *(const LAS f32x4*)(qs + d4 * 4), a1 = *(const LAS f32x4*)(qs + 64 + d4 * 4), a2 = *(const LAS f32x4*)(qs + 128 + d4 * 4), a3 = *(const LAS f32x4*)(qs + 192 + d4 * 4);
#pragma unroll
                    for (int e = 0; e < 4; ++e) { s0 += a0[e] * k4[e]; s1 += a1[e] * k4[e]; s2 += a2[e] * k4[e]; s3 += a3[e] * k4[e]; }
                }
                if (n < ncv) { sc[j][0] = s0; sc[j][1] = s1; sc[j][2] = s2; sc[j][3] = s3; }
            }
        }
#pragma unroll
        for (int h = 0; h < 4; ++h) {
            float mx = fmaxf(fmaxf(sc[0][h], sc[1][h]), fmaxf(sc[2][h], sc[3][h])); mx = wave_max(mx);
            float sm = 0.f;
#pragma unroll
            for (int j = 0; j < 4; ++j) { const float p = ((j * 64 + lane) < ncv) ? __expf(sc[j][h] - mx) : 0.f; sc[j][h] = p; sm += p; }
            sm = wave_sum(sm);
            const float inv = (ncv > 0) ? 1.f / sm : 0.f;
#pragma unroll
            for (int j = 0; j < 4; ++j) pc[h * 256 + j * 64 + lane] = sc[j][h] * inv;
        }
        lds_fence();
        float oc[4] = {0.f, 0.f, 0.f, 0.f};
        {
            const float* vp = VC + ((size_t)(b * 256) * 2 + g) * 64 + lane;
#pragma unroll 4
            for (int n = 0; n < ncv; ++n) {
                const float v = vp[(size_t)n * 128];
                oc[0] += pc[n] * v; oc[1] += pc[256 + n] * v; oc[2] += pc[512 + n] * v; oc[3] += pc[768 + n] * v;
            }
        }
        unsigned long long selmask;
        if (cur < 16) selmask = (1ull << (cur + 1)) - 1ull;
        else {
            float imp = 0.f;
#pragma unroll
            for (int h = 0; h < 4; ++h) {
                const LAS float* p = pc + h * 256 + 4 * lane;
                const f32x4 p4 = *(const LAS f32x4*)p;
                const float pm1 = (lane > 0) ? p[-1] : 0.f;
                imp += (p4[0] + p4[1] + p4[2]) + 0.5f * p4[3] + 0.5f * pm1;
            }
            float val = imp;
            if (lane == 0 || lane == cur || lane == cur - 1) val = 1e9f;
            if (lane > cur) val = -INFINITY;
            int rank = 0;
            for (int j = 0; j < 64; ++j) { const float o = __shfl(val, j); rank += (o > val || (o == val && j < lane)) ? 1 : 0; }
            selmask = __ballot(rank < 16);
        }
        OS ss;
#pragma unroll
        for (int h = 0; h < 4; ++h) { ss.m[h] = -1e30f; ss.l[h] = 0.f; ss.o[h] = 0.f; }
        {
            unsigned long long mk = selmask;
            while (mk) {
                const int mb = __builtin_ctzll(mk); mk &= mk - 1ull;
                const int tok0 = mb * 64;
                nsa_block(F, ss, qr, pl, rowbase, tok0, (tok0 + lane) <= t, H_KS + g * 64, H_VS + g * 64);
            }
        }
        OS sw;
#pragma unroll
        for (int h = 0; h < 4; ++h) { sw.m[h] = -1e30f; sw.l[h] = 0.f; sw.o[h] = 0.f; }
        {
            const int lo = (t - 511 > 0) ? (t - 511) : 0;
            for (int mb = lo >> 6; mb <= cur; ++mb) {
                const int tok = mb * 64 + lane;
                nsa_block(F, sw, qr, pl, rowbase, mb * 64, (tok <= t) && (tok > t - 512), H_KW + g * 64, H_VW + g * 64);
            }
        }
#pragma unroll
        for (int h = 0; h < 4; ++h) {
            const float g0 = (float)gatep[g * 12 + h * 3 + 0], g1 = (float)gatep[g * 12 + h * 3 + 1], g2 = (float)gatep[g * 12 + h * 3 + 2];
            const float os_ = (ss.l[h] > 0.f) ? ss.o[h] / ss.l[h] : 0.f, ow_ = (sw.l[h] > 0.f) ? sw.o[h] / sw.l[h] : 0.f;
            cvl[(g * 4 + h) * 64 + lane] = g0 * oc[h] + g1 * os_ + g2 * ow_;
        }
        lds_fence();
    }
    float cv[8]; float sq = 0.f;
#pragma unroll
    for (int i = 0; i < 8; ++i) { cv[i] = cvl[i * 64 + lane]; sq += cv[i] * cv[i]; }
    sq = wave_sum(sq);
    const float r = rsqrtf(sq * (1.f / 512.f) + EPS);
    const float* gc = gin(a, 25) + L * 512;
    f16* dst = (f16*)(F.ws + WS_XA) + (size_t)m * D + 512;
#pragma unroll
    for (int i = 0; i < 8; ++i) dst[i * 64 + lane] = (f16)(cv[i] * r * gc[i * 64 + lane]);
}


namespace nsa {
constexpr int KRS = 144, VRS = 192, KTB = 64 * KRS, VTB = 64 * VRS;
constexpr int KT = 0, KL = 2 * KTB, VT = 4 * KTB, WSF = VT + 2 * VTB, IMP = WSF + 2048, SELM = IMP + 16384, GTAB = SELM + 512, OTS = 272, OT = GTAB + 4096, LDS_END = OT + 8 * 32 * OTS;
static_assert(LDS_END <= LDS_BYTES, "nsa LDS map");
constexpr float LOG2E = 1.4426950408889634f;
constexpr float QSC = 0.125f * LOG2E;
constexpr float CQS = 8.f, CKS = 64.f, CSC = 0.125f * LOG2E / (CQS * CKS);
__device__ __forceinline__ h4 tr_read4(LAS const unsigned char* p) { return __builtin_bit_cast(h4, __builtin_amdgcn_ds_read_tr16_b64_v4i16((LAS v4i16_t*)p)); }
__device__ __forceinline__ int crow(int i, int hf) { return (i & 3) + 8 * (i >> 2) + 4 * hf; }

template <int MODE> __device__ __forceinline__ void st_load(const Frame& F, int b, int g, int blk, int kcol, int vcol, f32x4& r0, f32x4& r1, f32x4& r2, f32x4& r3) {
    const int key = F.tid >> 3, ch = F.tid & 7;
    if constexpr (MODE == 0) {
        const size_t off = ((size_t)(b * 256 + blk * 64 + key) * 2 + g) * 64 + ch * 8;
        const float* kp = (const float*)(F.ws + WS_KCMP) + off; const float* vp = (const float*)(F.ws + WS_VCMP) + off;
        r0 = *(const f32x4*)kp; r1 = *(const f32x4*)(kp + 4); r2 = *(const f32x4*)vp; r3 = *(const f32x4*)(vp + 4);
    } else {
        const f16* rowp = (const f16*)(F.ws + WS_PH) + (size_t)(b * SEQ + blk * 64 + key) * PH_LD;
        r0 = *(const f32x4*)(rowp + kcol + ch * 8); r2 = *(const f32x4*)(rowp + vcol + ch * 8);
    }
}
template <int MODE> __device__ __forceinline__ void st_write(const Frame& F, int buf, const f32x4& r0, const f32x4& r1, const f32x4& r2, const f32x4& r3) {
    const int key = F.tid >> 3, ch = F.tid & 7;
    LAS unsigned char* kd = F.lds + KT + buf * KTB + key * KRS + ch * 16; LAS unsigned char* vd = F.lds + VT + buf * VTB + key * VRS + ch * 16;
    if constexpr (MODE == 0) {
        h8 hi, lo;
#pragma unroll
        for (int e = 0; e < 4; ++e) { const float x0 = r0[e] * CKS, x1 = r1[e] * CKS; hi[e] = (f16)x0; lo[e] = (f16)(x0 - (float)hi[e]); hi[4 + e] = (f16)x1; lo[4 + e] = (f16)(x1 - (float)hi[4 + e]); }
        *(LAS u32x4*)kd = __builtin_bit_cast(u32x4, hi); if constexpr (SPLIT) *(LAS u32x4*)(kd + (KL - KT)) = __builtin_bit_cast(u32x4, lo);
        *(LAS u32x4*)vd = pg8::pack8h(r2, r3);
    } else {
        *(LAS f32x4*)kd = r0; *(LAS f32x4*)vd = r2;
    }
}
template <bool PREC> __device__ __forceinline__ void s_tiles(const Frame& F, int buf, const h8 (&qa)[4], const h8 (&qb)[4], f32x16& S0, f32x16& S1) {
    const int r = F.lane & 31, hf = F.lane >> 5;
    LAS const unsigned char* k0 = F.lds + KT + buf * KTB + r * KRS + hf * 16;
#pragma unroll
    for (int i = 0; i < 16; ++i) { S0[i] = 0.f; S1[i] = 0.f; }
    h8 a0[2], a1[2], l0[2], l1[2];
#define NSA_KRD(s) do { a0[(s) & 1] = *(const LAS h8*)(k0 + (s) * 32); a1[(s) & 1] = *(const LAS h8*)(k0 + 32 * KRS + (s) * 32); \
        if constexpr (PREC) { l0[(s) & 1] = *(const LAS h8*)(k0 + (KL - KT) + (s) * 32); l1[(s) & 1] = *(const LAS h8*)(k0 + (KL - KT) + 32 * KRS + (s) * 32); } } while (0)
    NSA_KRD(0);
    __builtin_amdgcn_sched_barrier(0);
#pragma unroll
    for (int s = 0; s < 4; ++s) {
        if (s + 1 < 4) NSA_KRD(s + 1);
        __builtin_amdgcn_sched_barrier(0);
        S0 = MFMA32(a0[s & 1], qa[s], S0); S1 = MFMA32(a1[s & 1], qa[s], S1);
        if constexpr (PREC) {
            S0 = MFMA32(a0[s & 1], qb[s], S0); S1 = MFMA32(a1[s & 1], qb[s], S1);
            S0 = MFMA32(l0[s & 1], qa[s], S0); S1 = MFMA32(l1[s & 1], qa[s], S1);
        }
        __builtin_amdgcn_sched_barrier(0);
    }
#undef NSA_KRD
}
__device__ __forceinline__ h8 pack_step(const f32x16& x, int s) {
    h8 r;
#pragma unroll
    for (int j = 0; j < 8; ++j) r[j] = (f16)x[8 * s + j];
    return r;
}
__device__ __forceinline__ void pv_tiles(const Frame& F, int buf, const f32x16& P0, const f32x16& P1, f32x16 (&O)[2]) {
    const int lane = F.lane, hf = lane >> 5, blk = (lane >> 4) & 1, q = (lane & 15) >> 2, p = lane & 3;
    LAS const unsigned char* vb = F.lds + VT + buf * VTB + (4 * hf + q) * VRS + (16 * blk + 4 * p) * 2;
    h4 vl[3], vh[3];
#define NSA_VRD(i) do { LAS const unsigned char* ad_ = vb + (16 * ((i) >> 1)) * VRS + 64 * ((i) & 1); vl[(i) % 3] = tr_read4(ad_); vh[(i) % 3] = tr_read4(ad_ + 8 * VRS); } while (0)
    NSA_VRD(0); NSA_VRD(1);
    h8 pf[4];
    pf[0] = pack_step(P0, 0);
    __builtin_amdgcn_sched_barrier(0);
#pragma unroll
    for (int i = 0; i < 8; ++i) {
        if (i + 2 < 8) NSA_VRD(i + 2);
        __builtin_amdgcn_sched_barrier(0);
        const h8 av = __builtin_shufflevector(vl[i % 3], vh[i % 3], 0, 1, 2, 3, 4, 5, 6, 7);
        O[i & 1] = MFMA32(av, pf[i >> 1], O[i & 1]);
        if ((i & 1) == 0 && i < 6) pf[(i >> 1) + 1] = (i < 2) ? pack_step(P0, 1) : pack_step(P1, (i >> 1) - 1);
        __builtin_amdgcn_sched_barrier(0);
    }
#undef NSA_VRD
}
__device__ __forceinline__ float max16(const f32x16& x) {
    float m = fmaxf(fmaxf(fmaxf(x[0], x[1]), fmaxf(x[2], x[3])), fmaxf(fmaxf(x[4], x[5]), fmaxf(x[6], x[7])));
    return fmaxf(m, fmaxf(fmaxf(fmaxf(x[8], x[9]), fmaxf(x[10], x[11])), fmaxf(fmaxf(x[12], x[13]), fmaxf(x[14], x[15]))));
}
__device__ __forceinline__ float sum16(const f32x16& x) {
    return (((x[0] + x[1]) + (x[2] + x[3])) + ((x[4] + x[5]) + (x[6] + x[7]))) + (((x[8] + x[9]) + (x[10] + x[11])) + ((x[12] + x[13]) + (x[14] + x[15])));
}
__device__ __forceinline__ void osm_step(f32x16& S0, f32x16& S1, float& mrun, float& lrun, f32x16 (&O)[2]) {
    float mx = fmaxf(max16(S0), max16(S1)); mx = max_x32(mx);
    const float mn = fmaxf(mrun, mx), alpha = __builtin_amdgcn_exp2f(mrun - mn); mrun = mn;
#pragma unroll
    for (int i = 0; i < 16; ++i) { S0[i] = __builtin_amdgcn_exp2f(S0[i] - mn); S1[i] = __builtin_amdgcn_exp2f(S1[i] - mn); }
    float sm = sum16(S0) + sum16(S1); sm = add_x32(sm);
    lrun = lrun * alpha + sm;
    O[0] = O[0] * alpha; O[1] = O[1] * alpha;
}

__device__ __forceinline__ float max3f(float a, float b, float c) { float r; asm("v_max3_f32 %0, %1, %2, %3" : "=v"(r) : "v"(a), "v"(b), "v"(c)); return r; }
__device__ __forceinline__ float max2f(float a, float b) { float r; asm("v_max_f32_e32 %0, %1, %2" : "=v"(r) : "v"(a), "v"(b)); return r; }
constexpr int SW_SLOTB = 8192, SW_K = 0, SW_V = 3 * SW_SLOTB;
typedef LAS const char* lds_cptr;
__device__ __forceinline__ void sw_glds16(const void* gsrc, unsigned lds_dst) { unsigned keep;
    asm volatile("s_mov_b32 %0, m0\n\ts_mov_b32 m0, %2\n\ts_nop 0\n\tglobal_load_lds_dwordx4 %1, off\n\ts_mov_b32 m0, %0" : "=&s"(keep) : "v"(gsrc), "s"(lds_dst) : "memory"); }
#define SW_WAIT_BAR(N) asm volatile("s_waitcnt vmcnt(" #N ") lgkmcnt(0)\n\ts_barrier" ::: "memory")
#define SW_SBAR() __builtin_amdgcn_sched_barrier(0)
__device__ __forceinline__ float sw_fadd(float a, float b) { float r; asm("v_add_f32_e32 %0, %1, %2" : "=v"(r) : "v"(a), "v"(b)); return r; }
__device__ __forceinline__ float sw_fsub(float a, float b) { float r; asm("v_sub_f32_e32 %0, %1, %2" : "=v"(r) : "v"(a), "v"(b)); return r; }
__device__ __forceinline__ unsigned sw_cvtpk(float lo, float hi) { f32x2 v = {lo, hi}; h2 b = __builtin_convertvector(v, h2); return __builtin_bit_cast(unsigned, b); }
__device__ __forceinline__ void sw_kload8(h8* kf, lds_cptr kp) {
    kf[0] = *(const LAS h8*)(kp);        kf[1] = *(const LAS h8*)(kp + 512);  kf[2] = *(const LAS h8*)(kp + 2048); kf[3] = *(const LAS h8*)(kp + 2560);
    kf[4] = *(const LAS h8*)(kp + 4096); kf[5] = *(const LAS h8*)(kp + 4608); kf[6] = *(const LAS h8*)(kp + 6144); kf[7] = *(const LAS h8*)(kp + 6656); }
__device__ __forceinline__ void sw_kload2(h8* kf, lds_cptr kp, int j) { kf[2 * j] = *(const LAS h8*)(kp + j * 2048); kf[2 * j + 1] = *(const LAS h8*)(kp + j * 2048 + 512); }
__device__ __forceinline__ h4 sw_vtr(lds_cptr p) { return __builtin_bit_cast(h4, __builtin_amdgcn_ds_read_tr16_b64_v4i16((LAS v4i16_t*)p)); }
__device__ __forceinline__ float sw_rowmax(const f32x16& p0, const f32x16& p1) {
    float a = max3f(p0[0], p0[1], p1[0]), b = max3f(p0[2], p0[3], p1[1]); a = max3f(a, p1[2], p1[3]);
#pragma unroll
    for (int r = 4; r < 16; r += 4) { a = max3f(a, p0[r], p0[r + 1]); b = max3f(b, p0[r + 2], p0[r + 3]); a = max3f(a, p1[r], p1[r + 1]); b = max3f(b, p1[r + 2], p1[r + 3]); }
    const float m = max2f(a, b);
    auto rr = __builtin_amdgcn_permlane32_swap(__float_as_uint(m), __float_as_uint(m), false, false);
    return max2f(__uint_as_float(rr[0]), __uint_as_float(rr[1]));
}
template <int MODE> __device__ __forceinline__ void sw_mask(f32x16& p0, f32x16& p1, int t, int c, int NTr, int tq, int hi, unsigned sel_lo, unsigned sel_hi) {
    const float NEG = -INFINITY;
    if (t >= NTr) {
#pragma unroll
        for (int r = 0; r < 16; ++r) { p0[r] = NEG; p1[r] = NEG; }
        return;
    }
    if (MODE == 1) {
        const bool bit = ((t < 32) ? (sel_lo >> t) : (sel_hi >> (t - 32))) & 1u;
        if (t == c) {
#pragma unroll
            for (int r = 0; r < 16; ++r) { const int kk = (r & 3) + 8 * (r >> 2) + 4 * hi; if (!(bit && kk <= tq)) p0[r] = NEG; if (!(bit && kk + 32 <= tq)) p1[r] = NEG; }
        } else if (!__all(bit)) {
#pragma unroll
            for (int r = 0; r < 16; ++r) { if (!bit) { p0[r] = NEG; p1[r] = NEG; } }
        }
    } else {
        if (t == 0) {
#pragma unroll
            for (int r = 0; r < 16; ++r) { const int kk = (r & 3) + 8 * (r >> 2) + 4 * hi; if (kk > tq) p0[r] = NEG; if (kk + 32 > tq) p1[r] = NEG; }
        } else if (t == 8) {
#pragma unroll
            for (int r = 0; r < 16; ++r) { const int kk = (r & 3) + 8 * (r >> 2) + 4 * hi; if (kk <= tq) p0[r] = NEG; if (kk + 32 <= tq) p1[r] = NEG; }
        }
    }
}
template <int MODE, int THRL>
__device__ __forceinline__ void sweep(Frame& F, LAS unsigned char* ring, LAS float* wsf, const f16* Kg, const f16* Vg, int c, int NTr, const h8 (&qr)[4], int tq, unsigned sel_lo, unsigned sel_hi, f32x16 (&o)[2], float (&rli)[16]) {
    const int lane = F.lane, r32 = lane & 31, hi = lane >> 5, wid = F.wave;
    const int NT = (NTr < 4) ? 4 : ((NTr + 1) & ~1);
#define SW_SRC(t) ((MODE == 1) ? (((t) < c) ? (t) : c) : (c - (((t) < NTr) ? (t) : (NTr - 1))))
    const unsigned lds0 = (unsigned)(unsigned long)ring;
    const f16* ksrc = Kg + (size_t)lane * PH_LD + wid * 8;
    const f16* vsrc = Vg + (size_t)(16 * (wid & 3) + (lane >> 2)) * PH_LD + (wid >> 2) * 32 + (lane & 3) * 8;
    const unsigned kdst = lds0 + SW_K + wid * 1024, vdst = lds0 + SW_V + wid * 1024;
#define SW_DMA_K(t, slot) sw_glds16(ksrc + (size_t)SW_SRC(t) * 64 * PH_LD, (unsigned)__builtin_amdgcn_readfirstlane((int)(kdst + (slot))))
#define SW_DMA_V(t, slot) sw_glds16(vsrc + (size_t)SW_SRC(t) * 64 * PH_LD, (unsigned)__builtin_amdgcn_readfirstlane((int)(vdst + (slot))))
    h8 kf[8];
    const lds_cptr shm3 = (lds_cptr)ring; const lds_cptr kp0 = shm3 + SW_K + hi * 1024 + r32 * 16;
    const lds_cptr vp0 = shm3 + SW_V + ((lane >> 4) & 1) * 32 + (lane & 3) * 8 + (4 * hi + ((lane & 15) >> 2)) * 64;
    SW_DMA_K(0, 0); SW_DMA_V(0, 0); SW_DMA_K(1, SW_SLOTB);
    float mhat = 0.f, l_reg = 0.f; o[0] = f32x16{}; o[1] = f32x16{}; f32x16 negm = f32x16{}; asm volatile("" : "+v"(negm));
#define SW_CMASK(P0, P1, t) sw_mask<MODE>(P0, P1, (t), c, NTr, tq, hi, sel_lo, sel_hi)
    bool resc = false;
#define SW_START(P0, P1) do { const float rm = sw_rowmax(P0, P1); resc = false; \
    { const float dl = rm; mhat = sw_fadd(mhat, dl); \
      _Pragma("unroll") for (int r = 0; r < 16; ++r) { P0[r] = sw_fsub(P0[r], dl); P1[r] = sw_fsub(P1[r], dl); } \
      _Pragma("unroll") for (int r = 0; r < 16; ++r) negm[r] = -mhat; asm volatile("" : "+v"(negm)); } \
    _Pragma("unroll") for (int r = 0; r < 16; ++r) P0[r] = __builtin_amdgcn_exp2f(P0[r]); } while (0)
#define SW_RESC() do { if (resc) { asm volatile("s_waitcnt lgkmcnt(0)" ::: "memory"); \
      _Pragma("unroll") for (int d_ = 0; d_ < 2; ++d_) _Pragma("unroll") for (int r = 0; r < 16; ++r) o[d_][r] *= wsf[(r & 3) + 8 * (r >> 2) + 4 * hi]; } } while (0)
    f32x16 pA0, pA1, pB0, pB1;
    int sl_prev = 0, sl_cur = 0, sl_next = SW_SLOTB;
#define SW_ROT() do { sl_prev = sl_cur; sl_cur = sl_next; sl_next = (sl_next == 2 * SW_SLOTB) ? 0 : sl_next + SW_SLOTB; } while (0)
    SW_DMA_K(2, 2 * SW_SLOTB);
    SW_WAIT_BAR(3);
    {
        const lds_cptr kb = kp0;
#pragma unroll
        for (int d0 = 0; d0 < 4; ++d0) {
            const h8 b0 = *(const LAS h8*)(kb + d0 * 2048), b1 = *(const LAS h8*)(kb + d0 * 2048 + 512);
            if (d0 == 0) { pA0 = MFMA32(b0, qr[0], negm); pA1 = MFMA32(b1, qr[0], negm); }
            else { pA0 = MFMA32(b0, qr[d0], pA0); pA1 = MFMA32(b1, qr[d0], pA1); }
        }
    }
    asm volatile("s_nop 15\n\ts_nop 7" : "+v"(pA0), "+v"(pA1)); SW_CMASK(pA0, pA1, 0);
    SW_START(pA0, pA1);
#pragma unroll
    for (int r = 0; r < 16; ++r) pA1[r] = __builtin_amdgcn_exp2f(pA1[r]);
    SW_WAIT_BAR(0);
    SW_DMA_K(3, 0); SW_DMA_V(1, SW_SLOTB);
    SW_ROT();
    sw_kload8(kf, kp0 + sl_cur);
    SW_WAIT_BAR(2);
    h4 vlo[8], vhi[8]; u32x4 pw0, pw1, pw2, pw3;
#define SW_PKW(P, B) sw_cvtpk(P[B], P[B + 1])
#define SW_PAF(k) __builtin_bit_cast(h8, pw##k)
#define SW_VFR(i) (h8){vlo[i][0], vlo[i][1], vlo[i][2], vlo[i][3], vhi[i][0], vhi[i][1], vhi[i][2], vhi[i][3]}
#define SW_PIN(x) asm volatile("" : "+v"(x))
#define SW_MX3(a, b, c_) __builtin_fmaxf(__builtin_fmaxf((a), (b)), (c_))
#define SW_GAPA(MF, A0, A1, A2, A3, W0, W1, PW) do { MF; sacc += A0; sacc += A1; sacc += A2; sacc += A3; SW_PIN(sacc); W0; W1; SW_PIN(PW); SW_SBAR(); } while (0)
#define SW_EX(v) __builtin_amdgcn_exp2f(v)
#define SW_GAPB(MF, X, B) do { MF; X[B] = SW_EX(X[B]); X[B + 1] = SW_EX(X[B + 1]); X[B + 2] = SW_EX(X[B + 2]); X[B + 3] = SW_EX(X[B + 3]); SW_PIN(X); SW_SBAR(); } while (0)
#define SW_VRD(i) do { vlo[i] = sw_vtr(vp_ + (((i) >> 2) * 4096 + ((i) & 3) * 1024)); vhi[i] = sw_vtr(vp_ + (((i) >> 2) * 4096 + ((i) & 3) * 1024 + 512)); } while (0)
#define SW_KRD(G, j) do { if (G) { sw_kload2(kf, kp0 + sl_next, j); SW_SBAR(); } } while (0)
#define SW_STEP(C0, C1, P0, P1, t, GK, GV, GL) do { SW_SBAR(); \
    const lds_cptr vp_ = vp0 + sl_prev; \
    SW_VRD(0); SW_SBAR(); float sacc = (P0[0] + P0[1]); \
    SW_GAPA(C0 = MFMA32(kf[0], qr[0], negm), P0[2], P0[3], P0[4], P0[5],     pw0[0] = SW_PKW(P0, 0), pw0[1] = SW_PKW(P0, 2), pw0); \
    SW_VRD(4); SW_SBAR(); SW_GAPA(C1 = MFMA32(kf[1], qr[0], negm), P0[6], P0[7], P0[8], P0[9],     pw0[2] = SW_PKW(P0, 4), pw0[3] = SW_PKW(P0, 6), pw0); \
    SW_VRD(1); SW_SBAR(); SW_GAPA(C0 = MFMA32(kf[2], qr[1], C0),   P0[10], P0[11], P0[12], P0[13], pw1[0] = SW_PKW(P0, 8), pw1[1] = SW_PKW(P0, 10), pw1); \
    SW_VRD(5); SW_SBAR(); SW_GAPA(C1 = MFMA32(kf[3], qr[1], C1),   P0[14], P0[15], P1[0], P1[1],   pw1[2] = SW_PKW(P0, 12), pw1[3] = SW_PKW(P0, 14), pw1); \
    SW_VRD(2); SW_SBAR(); SW_GAPA(C0 = MFMA32(kf[4], qr[2], C0),   P1[2], P1[3], P1[4], P1[5],     pw2[0] = SW_PKW(P1, 0), pw2[1] = SW_PKW(P1, 2), pw2); \
    SW_VRD(6); SW_SBAR(); SW_GAPA(C1 = MFMA32(kf[5], qr[2], C1),   P1[6], P1[7], P1[8], P1[9],     pw2[2] = SW_PKW(P1, 4), pw2[3] = SW_PKW(P1, 6), pw2); \
    SW_VRD(3); SW_SBAR(); SW_GAPA(C0 = MFMA32(kf[6], qr[3], C0),   P1[10], P1[11], P1[12], P1[13], pw3[0] = SW_PKW(P1, 8), pw3[1] = SW_PKW(P1, 10), pw3); \
    SW_VRD(7); SW_SBAR(); SW_GAPA(C1 = MFMA32(kf[7], qr[3], C1),   P1[14], P1[15], 0.f, 0.f,       pw3[2] = SW_PKW(P1, 12), pw3[3] = SW_PKW(P1, 14), pw3); \
    l_reg += sacc; \
    if (GK) { SW_DMA_K((t) + 3, sl_cur); } if (GV) { SW_DMA_V((t) + 1, sl_next); } \
    SW_CMASK(C0, C1, t); \
    { float a = SW_MX3(C0[0], C0[1], C1[0]), b = SW_MX3(C0[2], C0[3], C1[1]); a = SW_MX3(a, C1[2], C1[3]); \
      _Pragma("unroll") for (int r = 4; r < 16; r += 4) { a = SW_MX3(a, C0[r], C0[r + 1]); b = SW_MX3(b, C0[r + 2], C0[r + 3]); a = SW_MX3(a, C1[r], C1[r + 1]); b = SW_MX3(b, C1[r + 2], C1[r + 3]); } \
      float rm = __builtin_fmaxf(a, b); { auto rr = __builtin_amdgcn_permlane32_swap(__float_as_uint(rm), __float_as_uint(rm), false, false); rm = __builtin_fmaxf(__uint_as_float(rr[0]), __uint_as_float(rr[1])); } \
      resc = false; \
      if (__builtin_expect(__any(rm > (float)THRL), 0)) { const float dl = __builtin_fmaxf(rm, 0.f); mhat += dl; \
        _Pragma("unroll") for (int r = 0; r < 16; ++r) { C0[r] -= dl; C1[r] -= dl; } \
        _Pragma("unroll") for (int r = 0; r < 16; ++r) negm[r] = -mhat; asm volatile("" : "+v"(negm)); \
        const float f = __builtin_amdgcn_exp2f(-dl); l_reg *= f; if (hi == 0) wsf[r32] = f; resc = true; } } \
    SW_SBAR(); \
    SW_GAPB(o[0] = MFMA32(SW_PAF(0), SW_VFR(0), o[0]), C0, 0); \
    SW_GAPB(o[1] = MFMA32(SW_PAF(0), SW_VFR(4), o[1]), C0, 4); \
    SW_KRD(GL, 0); SW_GAPB(o[0] = MFMA32(SW_PAF(1), SW_VFR(1), o[0]), C0, 8); \
    SW_KRD(GL, 1); SW_GAPB(o[1] = MFMA32(SW_PAF(1), SW_VFR(5), o[1]), C0, 12); \
    SW_KRD(GL, 2); SW_GAPB(o[0] = MFMA32(SW_PAF(2), SW_VFR(2), o[0]), C1, 0); \
    SW_KRD(GL, 3); SW_GAPB(o[1] = MFMA32(SW_PAF(2), SW_VFR(6), o[1]), C1, 4); \
    SW_GAPB(o[0] = MFMA32(SW_PAF(3), SW_VFR(3), o[0]), C1, 8); \
    SW_GAPB(o[1] = MFMA32(SW_PAF(3), SW_VFR(7), o[1]), C1, 12); \
    } while (0)
    int t = 1;
#define SW_ENDW(tt) do { if ((tt) + 3 < NT) { SW_WAIT_BAR(2); } else if ((tt) + 2 < NT) { SW_WAIT_BAR(1); } else { SW_WAIT_BAR(0); } } while (0)
    for (; t + 1 < NT; t += 2) {
        SW_STEP(pB0, pB1, pA0, pA1, t, (t + 3 < NT), (t + 1 < NT), (t + 1 < NT));         SW_ENDW(t);     SW_RESC(); SW_ROT();
        SW_STEP(pA0, pA1, pB0, pB1, t + 1, (t + 4 < NT), (t + 2 < NT), (t + 2 < NT));     SW_ENDW(t + 1); SW_RESC(); SW_ROT();
    }
    SW_STEP(pB0, pB1, pA0, pA1, NT - 1, false, false, false); SW_RESC();
    {
        float sacc = pB0[0] + pB0[1];
#pragma unroll
        for (int r = 2; r < 16; ++r) sacc += pB0[r];
#pragma unroll
        for (int r = 0; r < 16; ++r) sacc += pB1[r];
        l_reg += sacc;
        pw0 = (u32x4){SW_PKW(pB0, 0), SW_PKW(pB0, 2), SW_PKW(pB0, 4), SW_PKW(pB0, 6)}; pw1 = (u32x4){SW_PKW(pB0, 8), SW_PKW(pB0, 10), SW_PKW(pB0, 12), SW_PKW(pB0, 14)};
        pw2 = (u32x4){SW_PKW(pB1, 0), SW_PKW(pB1, 2), SW_PKW(pB1, 4), SW_PKW(pB1, 6)}; pw3 = (u32x4){SW_PKW(pB1, 8), SW_PKW(pB1, 10), SW_PKW(pB1, 12), SW_PKW(pB1, 14)};
        SW_SBAR();
        const lds_cptr vq = vp0 + sl_cur;
#pragma unroll
        for (int d0 = 0; d0 < 2; ++d0) {
            h4 lo_[4], hi_[4];
#pragma unroll
            for (int ks = 0; ks < 4; ++ks) { lo_[ks] = sw_vtr(vq + d0 * 4096 + ks * 1024); hi_[ks] = sw_vtr(vq + d0 * 4096 + ks * 1024 + 512); }
#define SW_PK(k) (h8){lo_[k][0], lo_[k][1], lo_[k][2], lo_[k][3], hi_[k][0], hi_[k][1], hi_[k][2], hi_[k][3]}
            o[d0] = MFMA32(SW_PAF(0), SW_PK(0), o[d0]); o[d0] = MFMA32(SW_PAF(1), SW_PK(1), o[d0]); o[d0] = MFMA32(SW_PAF(2), SW_PK(2), o[d0]); o[d0] = MFMA32(SW_PAF(3), SW_PK(3), o[d0]);
#undef SW_PK
        }
    }
    { auto rr = __builtin_amdgcn_permlane32_swap(__float_as_uint(l_reg), __float_as_uint(l_reg), false, false); l_reg = __uint_as_float(rr[0]) + __uint_as_float(rr[1]); }
    if (hi == 0) wsf[32 + r32] = l_reg;
    asm volatile("s_waitcnt lgkmcnt(0)" ::: "memory");
#pragma unroll
    for (int r = 0; r < 16; ++r) rli[r] = __builtin_amdgcn_rcpf(wsf[32 + (r & 3) + 8 * (r >> 2) + 4 * hi]);
    asm volatile("s_waitcnt lgkmcnt(0)\n\ts_barrier" ::: "memory");
#undef SW_SRC
#undef SW_DMA_K
#undef SW_DMA_V
#undef SW_CMASK
#undef SW_START
#undef SW_RESC
#undef SW_ROT
#undef SW_PKW
#undef SW_PAF
#undef SW_VFR
#undef SW_PIN
#undef SW_MX3
#undef SW_GAPA
#undef SW_EX
#undef SW_GAPB
#undef SW_VRD
#undef SW_KRD
#undef SW_STEP
#undef SW_ENDW
}

__device__ __forceinline__ void item(Frame& F, int L, ArgsP a, int b, int c) {
    int lane, w, hf, rho, ql, h, tq, t, m;
    const float* PP; const f16* PH; const float* R; LAS float* impw; LAS unsigned* selm; LAS unsigned char* otw; LAS float* gtw; LAS float* wsf; f16* dst;
#define NSA_SECTION() do { refresh(F); asm volatile("" : "+s"(b), "+s"(c)); lane = F.lane; w = F.wave; hf = lane >> 5; rho = lane & 31; ql = rho >> 2; h = rho & 3; \
        tq = 8 * w + ql; t = 64 * c + tq; m = b * SEQ + t; \
        PP = (const float*)(F.ws + WS_PP); PH = (const f16*)(F.ws + WS_PH); R = (const float*)(F.ws + WS_ROPE); \
        impw = (LAS float*)(F.lds + IMP) + w * 512; selm = (LAS unsigned*)(F.lds + SELM) + w * 16; \
        otw = F.lds + OT + w * (32 * OTS); gtw = (LAS float*)(F.lds + GTAB) + w * 128; wsf = (LAS float*)(F.lds + WSF) + w * 64; \
        dst = (f16*)(F.ws + WS_XA) + (size_t)m * D + 512 + h * 64 + 4 * hf; } while (0)
    NSA_SECTION();
    const int ncv = (t < 31) ? 0 : min(255, ((t - 31) >> 4) + 1);
    const int ncv_max = min(255, 4 * c + 3), nblk_c = (ncv_max + 63) >> 6;
    int it = 0;
    float sq = 0.f;
    for (int g = 0; g < 2; ++g) {
        asm volatile("" : "+s"(g)); NSA_SECTION();
        h8 qh[4], qlw[4];
        {
            const float* qp = PP + (size_t)m * PP_LD + P_CQ + g * 256 + h * 64 + 8 * hf;
            f32x4 xq[8];
#pragma unroll
            for (int s = 0; s < 4; ++s) { xq[2 * s] = *(const f32x4*)(qp + 16 * s); xq[2 * s + 1] = *(const f32x4*)(qp + 16 * s + 4); }
            asm volatile("" : "+v"(xq[0]), "+v"(xq[1]), "+v"(xq[2]), "+v"(xq[3]), "+v"(xq[4]), "+v"(xq[5]), "+v"(xq[6]), "+v"(xq[7]));
#pragma unroll
            for (int s = 0; s < 4; ++s) {
                const f32x4 x0 = xq[2 * s], x1 = xq[2 * s + 1];
                const float xv[8] = {x0[0], x0[1], x0[2], x0[3], x1[0], x1[1], x1[2], x1[3]};
#pragma unroll
                for (int j = 0; j < 8; ++j) { const float xs = xv[j] * CQS; qh[s][j] = (f16)xs; if constexpr (SPLIT) qlw[s][j] = (f16)(xs - (float)qh[s][j]); else qlw[s][j] = (f16)0.f; }
            }
        }
        f32x16 O[2]; float mrun, lrun;
        f32x4 r0, r1, r2, r3;
        mrun = -1e30f; lrun = 0.f;
#pragma unroll
        for (int i = 0; i < 16; ++i) { O[0][i] = 0.f; O[1][i] = 0.f; }
        st_load<0>(F, b, g, 0, 0, 0, r0, r1, r2, r3);
        for (int blk = 0; blk < nblk_c; ++blk, ++it) {
            st_write<0>(F, it & 1, r0, r1, r2, r3);
            __syncthreads();
            if (blk + 1 < nblk_c) st_load<0>(F, b, g, blk + 1, 0, 0, r0, r1, r2, r3);
            f32x16 S0, S1; s_tiles<SPLIT>(F, it & 1, qh, qlw, S0, S1);
            const int lim = ncv - blk * 64 - 4 * hf;
#pragma unroll
            for (int i = 0; i < 16; ++i) { const int kc = (i & 3) + 8 * (i >> 2); S0[i] = (kc < lim) ? S0[i] : -INFINITY; S1[i] = (kc + 32 < lim) ? S1[i] : -INFINITY; }
            float mx = fmaxf(max16(S0), max16(S1)); mx = max_x32(mx) * CSC;
            const float mn = fmaxf(mrun, mx), alpha = __builtin_amdgcn_exp2f(mrun - mn); mrun = mn;
            float sm = 0.f;
#pragma unroll
            for (int i = 0; i < 16; ++i) { sm += __builtin_amdgcn_exp2f(__builtin_fmaf(S0[i], CSC, -mn)); sm += __builtin_amdgcn_exp2f(__builtin_fmaf(S1[i], CSC, -mn)); }
            lrun = lrun * alpha + sm;
        }
        lrun = add_x32(lrun);
        const float inv_lc = (lrun > 0.f) ? 1.f / lrun : 0.f, mfin = mrun;
        NSA_SECTION();
#pragma unroll
        for (int i = 0; i < 8; ++i) impw[lane * 8 + i] = 0.f;
        lds_fence();
        float prev_pc = 0.f;
        st_load<0>(F, b, g, 0, 0, 0, r0, r1, r2, r3);
        for (int blk = 0; blk < nblk_c; ++blk, ++it) {
            st_write<0>(F, it & 1, r0, r1, r2, r3);
            __syncthreads();
            if (blk + 1 < nblk_c) st_load<0>(F, b, g, blk + 1, 0, 0, r0, r1, r2, r3);
            f32x16 S0, S1; s_tiles<SPLIT>(F, it & 1, qh, qlw, S0, S1);
#pragma unroll
            for (int i = 0; i < 16; ++i) { const int n0 = blk * 64 + crow(i, hf);
                S0[i] = (n0 < ncv) ? __builtin_amdgcn_exp2f(S0[i] * CSC - mfin) * inv_lc : 0.f; S1[i] = (n0 + 32 < ncv) ? __builtin_amdgcn_exp2f(S1[i] * CSC - mfin) * inv_lc : 0.f; }
            pv_tiles(F, it & 1, S0, S1, O);
#pragma unroll
            for (int u = 0; u < 2; ++u)
#pragma unroll
                for (int r4 = 0; r4 < 4; ++r4) {
                    const float p0 = u ? S1[4 * r4] : S0[4 * r4], p1 = u ? S1[4 * r4 + 1] : S0[4 * r4 + 1], p2 = u ? S1[4 * r4 + 2] : S0[4 * r4 + 2], p3 = u ? S1[4 * r4 + 3] : S0[4 * r4 + 3];
                    float av = (p0 + p1 + p2) + 0.5f * p3, cvv = 0.5f * p3;
                    av += dpp_f<0xB1>(av); av += dpp_f<0x4E>(av); cvv += dpp_f<0xB1>(cvv); cvv += dpp_f<0x4E>(cvv);
                    const float pc = partner_x32(cvv, hf);
                    const float add = hf ? pc : prev_pc; prev_pc = pc;
                    const int mb = 16 * blk + 8 * u + 2 * r4 + hf;
                    if (h == 0) impw[ql * 64 + mb] = av + add;
                }
        }
        {
            const f16* gp = PH + (size_t)m * PH_LD + H_GATE + g * 12 + h * 3;
            const float g0 = (float)gp[0];
            if (hf == 0) *(LAS f32x4*)(gtw + rho * 4) = (f32x4){g0, (float)gp[1], (float)gp[2], 0.f};
#pragma unroll
            for (int cd = 0; cd < 2; ++cd)
#pragma unroll
                for (int r4 = 0; r4 < 4; ++r4) *(LAS f32x4*)(otw + rho * OTS + (32 * cd + 8 * r4 + 4 * hf) * 4) = (f32x4){O[cd][4 * r4] * g0, O[cd][4 * r4 + 1] * g0, O[cd][4 * r4 + 2] * g0, O[cd][4 * r4 + 3] * g0};
        }
        NSA_SECTION();
        unsigned sel_lo, sel_hi;
        if (c < 16) { sel_lo = (2u << c) - 1u; sel_hi = 0u; }
        else {
            lds_fence();
            const int q8 = lane >> 3, mg = lane & 7;
            float myv[8];
            {
                const f32x4 v0 = *(const LAS f32x4*)(impw + q8 * 64 + mg * 8), v1 = *(const LAS f32x4*)(impw + q8 * 64 + mg * 8 + 4);
                myv[0] = v0[0]; myv[1] = v0[1]; myv[2] = v0[2]; myv[3] = v0[3]; myv[4] = v1[0]; myv[5] = v1[1]; myv[6] = v1[2]; myv[7] = v1[3];
#pragma unroll
                for (int i = 0; i < 8; ++i) { const int mb = mg * 8 + i; if (mb == 0 || mb == c || mb == c - 1) myv[i] = 1e9f; if (mb > c) myv[i] = -INFINITY; }
                *(LAS f32x4*)(impw + q8 * 64 + mg * 8) = (f32x4){myv[0], myv[1], myv[2], myv[3]}; *(LAS f32x4*)(impw + q8 * 64 + mg * 8 + 4) = (f32x4){myv[4], myv[5], myv[6], myv[7]};
            }
            lds_fence();
            int rank[8];
#pragma unroll
            for (int i = 0; i < 8; ++i) rank[i] = 0;
            for (int j4 = 0; j4 < 16; ++j4) {
                const f32x4 o4 = *(const LAS f32x4*)(impw + q8 * 64 + j4 * 4);
#pragma unroll
                for (int e = 0; e < 4; ++e) { const float o = o4[e]; const int j = j4 * 4 + e;
#pragma unroll
                    for (int i = 0; i < 8; ++i) rank[i] += (o > myv[i] || (o == myv[i] && j < mg * 8 + i)) ? 1 : 0; }
            }
            unsigned bits = 0u;
#pragma unroll
            for (int i = 0; i < 8; ++i) bits |= (rank[i] < 16) ? (1u << i) : 0u;
            unsigned lo = (mg < 4) ? (bits << (8 * mg)) : 0u, hi = (mg >= 4) ? (bits << (8 * (mg - 4))) : 0u;
            lo |= __shfl_xor(lo, 1); lo |= __shfl_xor(lo, 2); lo |= __shfl_xor(lo, 4);
            hi |= __shfl_xor(hi, 1); hi |= __shfl_xor(hi, 2); hi |= __shfl_xor(hi, 4);
            if (mg == 0) { selm[q8 * 2] = lo; selm[q8 * 2 + 1] = hi; }
            lds_fence();
            sel_lo = selm[ql * 2]; sel_hi = selm[ql * 2 + 1];
            lds_fence();
        }
        NSA_SECTION();
        h8 qr[4];
        {
            const float* qp = PP + (size_t)m * PP_LD + P_CQ + g * 256 + h * 64 + 8 * hf;
            f32x4 xq[8];
#pragma unroll
            for (int s = 0; s < 4; ++s) { xq[2 * s] = *(const f32x4*)(qp + 16 * s); xq[2 * s + 1] = *(const f32x4*)(qp + 16 * s + 4); }
            const f32x4 c0 = *(const f32x4*)(R + (size_t)m * 8), c1 = *(const f32x4*)(R + (size_t)m * 8 + 4);
            const f32x4 s0 = *(const f32x4*)(R + (size_t)M * 8 + (size_t)m * 8), s1 = *(const f32x4*)(R + (size_t)M * 8 + (size_t)m * 8 + 4);
            asm volatile("" : "+v"(xq[0]), "+v"(xq[1]), "+v"(xq[2]), "+v"(xq[3]), "+v"(xq[4]), "+v"(xq[5]), "+v"(xq[6]), "+v"(xq[7]));
#pragma unroll
            for (int s = 0; s < 4; ++s) {
                const f32x4 x0 = xq[2 * s], x1 = xq[2 * s + 1];
                float xv[8] = {x0[0], x0[1], x0[2], x0[3], x1[0], x1[1], x1[2], x1[3]};
                if (s == 0) {
                    const float cs[8] = {c0[0], c0[1], c0[2], c0[3], c1[0], c1[1], c1[2], c1[3]}, sn[8] = {s0[0], s0[1], s0[2], s0[3], s1[0], s1[1], s1[2], s1[3]};
#pragma unroll
                    for (int j = 0; j < 8; ++j) { const float other = partner_x32(xv[j], hf); xv[j] = hf ? (xv[j] * cs[j] + other * sn[j]) : (xv[j] * cs[j] - other * sn[j]); }
                }
#pragma unroll
                for (int j = 0; j < 8; ++j) qr[s][j] = (f16)(xv[j] * QSC);
            }
        }
        lds_fence();
        __syncthreads();
        NSA_SECTION();
        {
            f32x16 os[2]; float rli[16];
            sweep<1, 8>(F, F.lds, wsf, PH + (size_t)(b * SEQ) * PH_LD + H_KS + g * 64, PH + (size_t)(b * SEQ) * PH_LD + H_VS + g * 64, c, c + 1, qr, tq, sel_lo, sel_hi, os, rli);
#pragma unroll
            for (int r = 0; r < 16; ++r) { const int row = (r & 3) + 8 * (r >> 2) + 4 * hf; const float gs = gtw[row * 4 + 1] * rli[r];
#pragma unroll
                for (int d0 = 0; d0 < 2; ++d0) { LAS float* p = (LAS float*)(otw + row * OTS) + 32 * d0 + rho; *p += os[d0][r] * gs; } }
            lds_fence();
            NSA_SECTION();
            sweep<2, 8>(F, F.lds, wsf, PH + (size_t)(b * SEQ) * PH_LD + H_KW + g * 64, PH + (size_t)(b * SEQ) * PH_LD + H_VW + g * 64, c, (c >= 8) ? 9 : c + 1, qr, tq, 0u, 0u, os, rli);
#pragma unroll
            for (int r = 0; r < 16; ++r) { const int row = (r & 3) + 8 * (r >> 2) + 4 * hf; const float gs = gtw[row * 4 + 2] * rli[r];
#pragma unroll
                for (int d0 = 0; d0 < 2; ++d0) { LAS float* p = (LAS float*)(otw + row * OTS) + 32 * d0 + rho; *p += os[d0][r] * gs; } }
            lds_fence();
        }
        NSA_SECTION();
#pragma unroll
        for (int cd = 0; cd < 2; ++cd)
#pragma unroll
            for (int r4 = 0; r4 < 4; ++r4) { const f32x4 v = *(const LAS f32x4*)(otw + rho * OTS + (32 * cd + 8 * r4 + 4 * hf) * 4);
                h4 o; o[0] = (f16)v[0]; o[1] = (f16)v[1]; o[2] = (f16)v[2]; o[3] = (f16)v[3];
                sq += ((float)o[0] * (float)o[0] + (float)o[1] * (float)o[1]) + ((float)o[2] * (float)o[2] + (float)o[3] * (float)o[3]);
                *(u32x2*)(dst + g * 256 + 32 * cd + 8 * r4) = __builtin_bit_cast(u32x2, o); }
        lds_fence();
    }
    NSA_SECTION();
    sq += dpp_f<0xB1>(sq); sq += dpp_f<0x4E>(sq); sq = add_x32(sq);
    const float rn = rsqrtf(sq * (1.f / 512.f) + EPS);
    const float* gc = gin(a, 25) + L * 512 + h * 64 + 4 * hf;
    dst = launder_g(dst); gc = launder_g(gc);
#pragma unroll
    for (int g = 0; g < 2; ++g)
#pragma unroll
        for (int cd = 0; cd < 2; ++cd)
#pragma unroll
            for (int r4 = 0; r4 < 4; ++r4) {
                const int col = g * 256 + 32 * cd + 8 * r4;
                const h4 v = __builtin_bit_cast(h4, *(const u32x2*)(dst + col)); const f32x4 gn = *(const f32x4*)(gc + col);
                h4 o; o[0] = (f16)((float)v[0] * rn * gn[0]); o[1] = (f16)((float)v[1] * rn * gn[1]); o[2] = (f16)((float)v[2] * rn * gn[2]); o[3] = (f16)((float)v[3] * rn * gn[3]);
                *(u32x2*)(dst + col) = __builtin_bit_cast(u32x2, o);
            }
    __syncthreads();
#undef NSA_SECTION
}
}

__device__ __forceinline__ float dpp_xor1(float v) { return __builtin_bit_cast(float, __builtin_amdgcn_mov_dpp(__builtin_bit_cast(int, v), 0xB1, 0xF, 0xF, true)); }
__device__ __forceinline__ float dpp_xor2(float v) { return __builtin_bit_cast(float, __builtin_amdgcn_mov_dpp(__builtin_bit_cast(int, v), 0x4E, 0xF, 0xF, true)); }
namespace dsa {
constexpr int KBUF = 16384;
constexpr int KRS = 304, VRS = 320, KTB = 64 * KRS, VTB = 64 * VRS;
constexpr int KT = 0, VT = 2 * KTB, SSQ = VT + 2 * VTB, LDS_END = SSQ + 1024;
static_assert(8 * KBUF + 8 * 1024 <= LDS_BYTES - 16 && LDS_END <= LDS_BYTES, "dsa LDS map");
constexpr float QSC = 0.125f * 1.4426950408889634f;

__device__ __forceinline__ unsigned row_or(unsigned v) { v |= (unsigned)__builtin_amdgcn_mov_dpp((int)v, 0xB1, 0xF, 0xF, true); v |= (unsigned)__builtin_amdgcn_mov_dpp((int)v, 0x4E, 0xF, 0xF, true);
    v |= (unsigned)__builtin_amdgcn_mov_dpp((int)v, 0x141, 0xF, 0xF, true); v |= (unsigned)__builtin_amdgcn_mov_dpp((int)v, 0x140, 0xF, 0xF, true); return v; }
__device__ __forceinline__ unsigned row_add(unsigned v) { v += (unsigned)__builtin_amdgcn_mov_dpp((int)v, 0xB1, 0xF, 0xF, true); v += (unsigned)__builtin_amdgcn_mov_dpp((int)v, 0x4E, 0xF, 0xF, true);
    v += (unsigned)__builtin_amdgcn_mov_dpp((int)v, 0x141, 0xF, 0xF, true); v += (unsigned)__builtin_amdgcn_mov_dpp((int)v, 0x140, 0xF, 0xF, true); return v; }
__device__ __forceinline__ unsigned wave_add_u(unsigned v) { v = row_add(v);
    return (unsigned)(__builtin_amdgcn_readlane((int)v, 0) + __builtin_amdgcn_readlane((int)v, 16)) + (unsigned)(__builtin_amdgcn_readlane((int)v, 32) + __builtin_amdgcn_readlane((int)v, 48)); }
__device__ __forceinline__ unsigned wave_max_u(unsigned v) {
    v = max(v, (unsigned)__builtin_amdgcn_mov_dpp((int)v, 0xB1, 0xF, 0xF, true)); v = max(v, (unsigned)__builtin_amdgcn_mov_dpp((int)v, 0x4E, 0xF, 0xF, true));
    v = max(v, (unsigned)__builtin_amdgcn_mov_dpp((int)v, 0x141, 0xF, 0xF, true)); v = max(v, (unsigned)__builtin_amdgcn_mov_dpp((int)v, 0x140, 0xF, 0xF, true));
    return max(max((unsigned)__builtin_amdgcn_readlane((int)v, 0), (unsigned)__builtin_amdgcn_readlane((int)v, 16)), max((unsigned)__builtin_amdgcn_readlane((int)v, 32), (unsigned)__builtin_amdgcn_readlane((int)v, 48))); }
__device__ __forceinline__ unsigned wave_min_u(unsigned v) { return ~wave_max_u(~v); }
__device__ __forceinline__ unsigned wave_or_u(unsigned v) { v = row_or(v);
    return (unsigned)(__builtin_amdgcn_readlane((int)v, 0) | __builtin_amdgcn_readlane((int)v, 16)) | (unsigned)(__builtin_amdgcn_readlane((int)v, 32) | __builtin_amdgcn_readlane((int)v, 48)); }

struct P1Ops { h8 bh[2], bl[2]; float wv[4][4]; h8 ah0, ah1, al0, al1; };
__device__ __forceinline__ void pass1_load(const Frame& F, int b, int t0, P1Ops& o) {
    const int lane = F.lane, w = F.wave, hf = lane >> 5, rho = lane & 31, q = rho >> 2, h = rho & 3;
    const float* PP = (const float*)(F.ws + WS_PP);
    const f16* qp = (const f16*)(PP + (size_t)(b * SEQ + t0 + q) * PP_LD + P_IQS) + h * 32 + 8 * hf;
    o.bh[0] = *(const h8*)qp; o.bh[1] = *(const h8*)(qp + 16); if constexpr (SPLIT) { o.bl[0] = *(const h8*)(qp + 128); o.bl[1] = *(const h8*)(qp + 144); }
#pragma unroll
    for (int r4 = 0; r4 < 4; ++r4) {
        const f32x4 w4 = *(const f32x4*)(PP + (size_t)(b * SEQ + t0 + 2 * r4 + hf) * PP_LD + P_IW);
#pragma unroll
        for (int e = 0; e < 4; ++e) o.wv[r4][e] = w4[e] * (0.17677669529663687f / (ISC * ISC));
    }
    const int ntiles = 2 * (((t0 + 7) >> 6) + 1);
    const f16* kp = (const f16*)(F.ws + WS_IKT) + ((size_t)(b * 128 + min(w, ntiles - 1)) * 256 + lane) * 8;
    o.ah0 = *(const h8*)kp; o.ah1 = *(const h8*)(kp + 512); if constexpr (SPLIT) { o.al0 = *(const h8*)(kp + 1024); o.al1 = *(const h8*)(kp + 1536); }
}
__device__ __forceinline__ void pass1_round(Frame& F, int b, int t0, P1Ops& ops, bool has_next) {
    const int lane = F.lane, w = F.wave, hf = lane >> 5, rho = lane & 31;
    const float* PP = (const float*)(F.ws + WS_PP);
    h8 bh[2] = {ops.bh[0], ops.bh[1]}, bl[2] = {ops.bl[0], ops.bl[1]};
    float wv[4][4];
#pragma unroll
    for (int r4 = 0; r4 < 4; ++r4)
#pragma unroll
        for (int e = 0; e < 4; ++e) wv[r4][e] = ops.wv[r4][e];
    const int ntiles = 2 * (((t0 + 7) >> 6) + 1);
    const f16* kp0 = (const f16*)(F.ws + WS_IKT) + ((size_t)(b * 128) * 256 + lane) * 8;
    const size_t tstride = (size_t)256 * 8;
    h8 ah0 = ops.ah0, ah1 = ops.ah1, al0 = ops.al0, al1 = ops.al1, nh0, nh1, nl0, nl1;
    for (int tt = w; tt < ntiles; tt += NWAVES) {
        { const f16* kp = kp0 + (size_t)min(tt + NWAVES, ntiles - 1) * tstride; nh0 = *(const h8*)kp; nh1 = *(const h8*)(kp + 512); if constexpr (SPLIT) { nl0 = *(const h8*)(kp + 1024); nl1 = *(const h8*)(kp + 1536); } }
        f32x16 S;
#pragma unroll
        for (int i = 0; i < 16; ++i) S[i] = 0.f;
        S = MFMA32(bh[0], ah0, S); S = MFMA32(bh[1], ah1, S);
        if constexpr (SPLIT) { S = MFMA32(bl[0], ah0, S); S = MFMA32(bh[0], al0, S); S = MFMA32(bl[1], ah1, S); S = MFMA32(bh[1], al1, S); }
        const int kidx = 32 * tt + rho;
#pragma unroll
        for (int r4 = 0; r4 < 4; ++r4) {
            float r = (fmaxf(S[4 * r4], 0.f) * wv[r4][0] + fmaxf(S[4 * r4 + 1], 0.f) * wv[r4][1]) + (fmaxf(S[4 * r4 + 2], 0.f) * wv[r4][2] + fmaxf(S[4 * r4 + 3], 0.f) * wv[r4][3]);
            const int qq = 2 * r4 + hf;
            ((LAS unsigned*)(F.lds + qq * KBUF))[kidx] = (kidx <= t0 + qq) ? mono_key(r) : 0u;
        }
        ah0 = nh0; ah1 = nh1; if constexpr (SPLIT) { al0 = nl0; al1 = nl1; }
    }
    __syncthreads();
    if (has_next) pass1_load(F, b, t0 + 8, ops);
    {
        const int t = t0 + w, nsteps = (t >> 6) + 1;
        LAS unsigned* kbuf = (LAS unsigned*)(F.lds + w * KBUF);
        LAS unsigned* hist = (LAS unsigned*)(F.lds + 8 * KBUF + w * 1024);
        unsigned kreg[64];
#pragma unroll
        for (int j8 = 0; j8 < 8; ++j8) {
            if (j8 * 8 < nsteps) {
#pragma unroll
                for (int j = j8 * 8; j < j8 * 8 + 8; ++j) { const unsigned kv_ = kbuf[j * 64 + lane]; kreg[j] = (j < nsteps) ? kv_ : 0u; }
            } else {
#pragma unroll
                for (int j = j8 * 8; j < j8 * 8 + 8; ++j) kreg[j] = 0u;
            }
        }
#define KLOOP(...) _Pragma("unroll") for (int j8 = 0; j8 < 8; ++j8) if (j8 * 8 < nsteps) { _Pragma("unroll") for (int j = j8 * 8; j < j8 * 8 + 8; ++j) { const unsigned k = kreg[j]; __VA_ARGS__ } }
        unsigned T = 0u; int scut = 4095;
        if (t >= 256) {
            constexpr int D1 = 11, BPL = (1 << D1) / 64;
            unsigned kmx = 0u, kmn1 = ~0u;
            KLOOP(kmx = max(kmx, k); kmn1 = min(kmn1, k - 1u);)
            kmx = wave_max_u(kmx); const unsigned kmn = wave_min_u(kmn1) + 1u;
            const unsigned range = kmx - kmn;
            unsigned above = 0u, ceq = 0u;
            if (range == 0u) T = kmn;
            else {
                const int msb = 31 - __builtin_clz(range), shift = (msb + 1 > D1) ? msb + 1 - D1 : 0;
                {
                    LAS u32x4* hz = (LAS u32x4*)(kbuf + BPL * lane);
#pragma unroll
                    for (int i = 0; i < BPL / 4; ++i) hz[i] = (u32x4){0u, 0u, 0u, 0u};
                }
                KLOOP(if (j < nsteps) { const unsigned d = __builtin_elementwise_sub_sat(k, kmn); __hip_atomic_fetch_add(kbuf + (d >> shift), 1u, __ATOMIC_RELAXED, __HIP_MEMORY_SCOPE_WORKGROUP); })
                lds_fence();
                unsigned h[BPL];
                {
                    const LAS u32x4* hr = (const LAS u32x4*)(kbuf + BPL * lane);
#pragma unroll
                    for (int i = 0; i < BPL / 4; ++i) { const u32x4 v = hr[i]; h[4 * i] = v[0]; h[4 * i + 1] = v[1]; h[4 * i + 2] = v[2]; h[4 * i + 3] = v[3]; }
                }
                if (lane == 0) h[0] -= (unsigned)(64 * nsteps - (t + 1));
                unsigned s4 = 0u;
#pragma unroll
                for (int i = 0; i < BPL; ++i) s4 += h[i];
                unsigned ps = s4;
                ps += (unsigned)__builtin_amdgcn_update_dpp(0, (int)ps, 0x111, 0xF, 0xF, true);
                ps += (unsigned)__builtin_amdgcn_update_dpp(0, (int)ps, 0x112, 0xF, 0xF, true);
                ps += (unsigned)__builtin_amdgcn_update_dpp(0, (int)ps, 0x114, 0xF, 0xF, true);
                ps += (unsigned)__builtin_amdgcn_update_dpp(0, (int)ps, 0x118, 0xF, 0xF, true);
                const unsigned r0t = (unsigned)__builtin_amdgcn_readlane((int)ps, 15), r1t = (unsigned)__builtin_amdgcn_readlane((int)ps, 31), r2t = (unsigned)__builtin_amdgcn_readlane((int)ps, 47), r3t = (unsigned)__builtin_amdgcn_readlane((int)ps, 63);
                ps += (lane >= 16 ? r0t : 0u) + (lane >= 32 ? r1t : 0u) + (lane >= 48 ? r2t : 0u);
                const unsigned total = (r0t + r1t) + (r2t + r3t);
                const unsigned sfx = total - ps;
                const bool mine = (sfx < 256u) && (sfx + s4 >= 256u);
                unsigned bsel = 0u, ab2 = 0u, cq = 0u;
                {
                    unsigned acc_ = sfx; bool found = false;
#pragma unroll
                    for (int i = BPL - 1; i >= 0; --i) { const bool hit = !found && (acc_ + h[i] >= 256u); if (hit) { bsel = (unsigned)i; ab2 = acc_; cq = h[i]; } found = found || hit; acc_ += h[i]; }
                    bsel += (unsigned)(BPL * lane);
                }
                const unsigned long long mm = __ballot(mine);
                const int src = __builtin_ctzll(mm);
                const unsigned b1 = (unsigned)__builtin_amdgcn_readlane((int)bsel, src); above = (unsigned)__builtin_amdgcn_readlane((int)ab2, src); ceq = (unsigned)__builtin_amdgcn_readlane((int)cq, src);
                const unsigned klo = kmn + (b1 << shift);
                unsigned Td = 0u;
                int rem = shift;
                if (rem > 0) {
                    const unsigned width = 1u << shift;
                    LAS unsigned* wp = kbuf + lane;
                    KLOOP(const unsigned d = k - klo; *wp = d; wp += (d < width) ? 64 : 0;)
                    const unsigned cnt = (unsigned)(wp - (kbuf + lane)) >> 6;
                    const int mcnt = (int)wave_max_u(cnt);
                    while (rem > 0) {
                        const int wd = (rem < 8) ? rem : 8, sh = rem - wd;
                        *(LAS u32x4*)(hist + 4 * lane) = (u32x4){0u, 0u, 0u, 0u};
                        lds_fence();
                        const unsigned pref = Td >> rem;
                        const unsigned dmask = (1u << wd) - 1u;
                        for (int i = 0; i < mcnt; ++i) {
                            const unsigned d = kbuf[i * 64 + lane];
                            if ((unsigned)i < cnt && (d >> rem) == pref) __hip_atomic_fetch_add(hist + ((d >> sh) & dmask), 1u, __ATOMIC_RELAXED, __HIP_MEMORY_SCOPE_WORKGROUP);
                        }
                        lds_fence();
                        const u32x4 h4 = *(const LAS u32x4*)(hist + 4 * lane);
                        const unsigned q4 = (h4[0] + h4[1]) + (h4[2] + h4[3]);
                        unsigned p2 = q4;
                        p2 += (unsigned)__builtin_amdgcn_update_dpp(0, (int)p2, 0x111, 0xF, 0xF, true);
                        p2 += (unsigned)__builtin_amdgcn_update_dpp(0, (int)p2, 0x112, 0xF, 0xF, true);
                        p2 += (unsigned)__builtin_amdgcn_update_dpp(0, (int)p2, 0x114, 0xF, 0xF, true);
                        p2 += (unsigned)__builtin_amdgcn_update_dpp(0, (int)p2, 0x118, 0xF, 0xF, true);
                        const unsigned u0 = (unsigned)__builtin_amdgcn_readlane((int)p2, 15), u1 = (unsigned)__builtin_amdgcn_readlane((int)p2, 31), u2 = (unsigned)__builtin_amdgcn_readlane((int)p2, 47), u3 = (unsigned)__builtin_amdgcn_readlane((int)p2, 63);
                        p2 += (lane >= 16 ? u0 : 0u) + (lane >= 32 ? u1 : 0u) + (lane >= 48 ? u2 : 0u);
                        const unsigned tot2 = (u0 + u1) + (u2 + u3);
                        const unsigned sfx2 = above + (tot2 - p2);
                        const bool mine2 = (sfx2 < 256u) && (sfx2 + q4 >= 256u);
                        unsigned bs2 = 0u, ab3 = 0u, cq2 = 0u;
                        if (mine2) {
                            unsigned acc_ = sfx2;
                            if (acc_ + h4[3] >= 256u) { bs2 = 3u; ab3 = acc_; cq2 = h4[3]; }
                            else { acc_ += h4[3];
                                if (acc_ + h4[2] >= 256u) { bs2 = 2u; ab3 = acc_; cq2 = h4[2]; }
                                else { acc_ += h4[2];
                                    if (acc_ + h4[1] >= 256u) { bs2 = 1u; ab3 = acc_; cq2 = h4[1]; }
                                    else { acc_ += h4[1]; bs2 = 0u; ab3 = acc_; cq2 = h4[0]; } } }
                            bs2 += 4u * (unsigned)lane;
                        }
                        const unsigned long long mm2 = __ballot(mine2);
                        const int src2 = __builtin_ctzll(mm2);
                        bs2 = (unsigned)__builtin_amdgcn_readlane((int)bs2, src2); above = (unsigned)__builtin_amdgcn_readlane((int)ab3, src2); ceq = (unsigned)__builtin_amdgcn_readlane((int)cq2, src2);
                        Td |= bs2 << sh;
                        rem = sh;
                    }
                }
                T = klo + Td;
            }
            if (range == 0u) {
                unsigned ce = 0u;
                KLOOP(ce += (k == T) ? 1u : 0u;)
                ceq = wave_add_u(ce); above = 0u;
            }
            const int need = 256 - (int)above;
            if ((int)ceq > need) {
                int accn = 0, jS = -1, kS = 0; unsigned long long emS = 0ull;
                KLOOP(const unsigned long long em = __ballot(k == T); const int c = __popcll(em); if (jS < 0 && accn + c >= need) { jS = j; emS = em; kS = need - accn; } accn += c;)
                if (jS >= 0) { while (kS > 1) { emS &= emS - 1ull; --kS; } scut = jS * 64 + __builtin_ctzll(emS); }
            }
        }
        unsigned* bm = (unsigned*)(F.ws + WS_BM) + (size_t)(b * SEQ + t) * 128;
        int mlo = 0, mhi = 0;
        const unsigned Tm = (T == 0u) ? 1u : T; const bool cut = (scut != 4095);
#define DSA_BMW(sm_) asm("s_nop 1\n\tv_writelane_b32 %0, %2, %4\n\tv_writelane_b32 %1, %3, %4" : "+v"(mlo), "+v"(mhi) : "s"((int)(unsigned)(sm_)), "s"((int)(unsigned)((sm_) >> 32)), "n"(j))
        if (!cut) { KLOOP(const unsigned long long sm = __ballot(k >= Tm); DSA_BMW(sm);) }
        else { KLOOP(const unsigned long long sm = __ballot(k > T || (k == T && T != 0u && (j * 64 + lane) <= scut)); DSA_BMW(sm);) }
#undef DSA_BMW
        if (lane < nsteps) *(u32x2*)(bm + 2 * lane) = (u32x2){(unsigned)mlo, (unsigned)mhi};
#undef KLOOP
    }
    __syncthreads();
}

__device__ __forceinline__ void pass2(Frame& F, int L, ArgsP a, int b, int c) {
    const int lane = F.lane, w = F.wave, hf = lane >> 5, rho = lane & 31, hd = w & 3, qh = w >> 2;
    const int tq = 32 * qh + rho, t = 64 * c + tq, m = b * SEQ + t;
    const f16* PH = (const f16*)(F.ws + WS_PH);
    h8 qf[9];
    {
        const f16* qp = PH + (size_t)m * PH_LD + H_QA + hd * 144 + 8 * hf;
        h8 qv[9];
#pragma unroll
        for (int s = 0; s < 9; ++s) qv[s] = *(const h8*)(qp + 16 * s);
        asm volatile("" : "+v"(qv[0]), "+v"(qv[1]), "+v"(qv[2]), "+v"(qv[3]), "+v"(qv[4]), "+v"(qv[5]), "+v"(qv[6]), "+v"(qv[7]), "+v"(qv[8]));
#pragma unroll
        for (int s = 0; s < 9; ++s) { const h8 v = qv[s];
#pragma unroll
            for (int j = 0; j < 8; ++j) qf[s][j] = (f16)((float)v[j] * QSC); }
    }
    f32x16 O[4]; float mrun = -1e30f, lrun = 0.f;
#pragma unroll
    for (int d = 0; d < 4; ++d)
#pragma unroll
        for (int i = 0; i < 16; ++i) O[d][i] = 0.f;
    const unsigned* bm = (const unsigned*)(F.ws + WS_BM) + (size_t)m * 128;
    const int srow = F.tid >> 3, sj = F.tid & 7;
    const f16* kb = PH + (size_t)(b * SEQ + srow) * PH_LD + H_KA + sj * 8;
    LAS unsigned char* kdst = F.lds + KT + srow * KRS + sj * 16; LAS unsigned char* vdst = F.lds + VT + srow * VRS + sj * 16;
    f32x4 r0, r1, r2;
#define DSA_LOAD(blk) do { const f16* kbb = kb + (size_t)((blk) * 64) * PH_LD; r0 = *(const f32x4*)kbb; r1 = *(const f32x4*)(kbb + 64); if (sj < 2) r2 = *(const f32x4*)(kbb + 128); } while (0)
#define DSA_WRITE(buf) do { LAS unsigned char* kd_ = kdst + (buf) * KTB; LAS unsigned char* vd_ = vdst + (buf) * VTB; \
        *(LAS f32x4*)kd_ = r0; *(LAS f32x4*)(kd_ + 128) = r1; if (sj < 2) *(LAS f32x4*)(kd_ + 256) = r2; *(LAS f32x4*)vd_ = r0; *(LAS f32x4*)(vd_ + 128) = r1; } while (0)
    DSA_LOAD(0);
    u32x2 mw = __builtin_nontemporal_load((const u32x2*)bm);
    for (int blk = 0; blk <= c; ++blk) {
        const int buf = blk & 1;
        DSA_WRITE(buf);
        __syncthreads();
        const u32x2 mcur = mw;
        if (blk + 1 <= c) { DSA_LOAD(blk + 1); mw = __builtin_nontemporal_load((const u32x2*)(bm + 2 * (blk + 1))); }
        f32x16 S0, S1;
#pragma unroll
        for (int i = 0; i < 16; ++i) { S0[i] = 0.f; S1[i] = 0.f; }
        {
            LAS const unsigned char* k0 = F.lds + KT + buf * KTB + rho * KRS + hf * 16;
            h8 ka0[3], ka1[3];
            ka0[0] = *(const LAS h8*)(k0); ka1[0] = *(const LAS h8*)(k0 + 32 * KRS); ka0[1] = *(const LAS h8*)(k0 + 32); ka1[1] = *(const LAS h8*)(k0 + 32 * KRS + 32);
            __builtin_amdgcn_sched_barrier(0);
#pragma unroll
            for (int s = 0; s < 9; ++s) {
                if (s + 2 < 9) { ka0[(s + 2) % 3] = *(const LAS h8*)(k0 + (s + 2) * 32); ka1[(s + 2) % 3] = *(const LAS h8*)(k0 + 32 * KRS + (s + 2) * 32); }
                __builtin_amdgcn_sched_barrier(0);
                S0 = MFMA32(ka0[s % 3], qf[s], S0); S1 = MFMA32(ka1[s % 3], qf[s], S1);
                __builtin_amdgcn_sched_barrier(0);
            }
        }
        {
            const unsigned m0 = mcur[0] >> (4 * hf), m1 = mcur[1] >> (4 * hf);
            const float ninf = -INFINITY;
            asm volatile("s_nop 15\n\ts_nop 7" : "+v"(S0), "+v"(S1));
#pragma unroll
            for (int i = 0; i < 16; ++i) {
                int k0, k1; float s0 = S0[i], s1 = S1[i];
                asm("v_bfe_i32 %0, %1, %2, 1" : "=v"(k0) : "v"(m0), "n"((i & 3) + 8 * (i >> 2)));
                asm("v_bfe_i32 %0, %1, %2, 1" : "=v"(k1) : "v"(m1), "n"((i & 3) + 8 * (i >> 2)));
                asm("v_bfi_b32 %0, %1, %2, %3" : "=v"(s0) : "v"(k0), "v"(s0), "v"(ninf));
                asm("v_bfi_b32 %0, %1, %2, %3" : "=v"(s1) : "v"(k1), "v"(s1), "v"(ninf));
                S0[i] = s0; S1[i] = s1;
            }
        }
        float mx = fmaxf(nsa::max16(S0), nsa::max16(S1)); mx = max_x32(mx);
        const float mold = mrun, mn = fmaxf(mrun, mx), alpha = __builtin_amdgcn_exp2f(mrun - mn); mrun = mn;
#pragma unroll
        for (int i = 0; i < 16; ++i) { S0[i] = __builtin_amdgcn_exp2f(S0[i] - mn); S1[i] = __builtin_amdgcn_exp2f(S1[i] - mn); }
        const float sm = nsa::sum16(S0) + nsa::sum16(S1);
        lrun = lrun * alpha + sm;
        {
            const int blk16 = (lane >> 4) & 1, q4 = (lane & 15) >> 2, p4 = lane & 3;
            LAS const unsigned char* vb = F.lds + VT + buf * VTB + (4 * hf + q4) * VRS + (16 * blk16 + 4 * p4) * 2;
            h4 vl[3], vh[3];
#define DSA_VRD(i) do { LAS const unsigned char* ad_ = vb + (16 * ((i) >> 2)) * VRS + 64 * ((i) & 3); vl[(i) % 3] = nsa::tr_read4(ad_); vh[(i) % 3] = nsa::tr_read4(ad_ + 8 * VRS); } while (0)
            DSA_VRD(0); DSA_VRD(1);
            h8 pf[4];
            const bool resc = __any(mn > mold);
            pf[0] = nsa::pack_step(S0, 0); if (resc) O[0] = O[0] * alpha;
            __builtin_amdgcn_sched_barrier(0);
#pragma unroll
            for (int i = 0; i < 16; ++i) {
                if (i + 2 < 16) DSA_VRD(i + 2);
                __builtin_amdgcn_sched_barrier(0);
                const h8 av = __builtin_shufflevector(vl[i % 3], vh[i % 3], 0, 1, 2, 3, 4, 5, 6, 7);
                O[i & 3] = MFMA32(av, pf[i >> 2], O[i & 3]);
                if (i < 3 && resc) O[i + 1] = O[i + 1] * alpha;
                if ((i & 3) == 1 && i < 12) pf[(i >> 2) + 1] = (i < 4) ? nsa::pack_step(S0, 1) : nsa::pack_step(S1, (i >> 2) - 1);
                __builtin_amdgcn_sched_barrier(0);
            }
#undef DSA_VRD
        }
    }
#undef DSA_LOAD
#undef DSA_WRITE
    lrun = add_x32(lrun);
    const float invl = (lrun > 0.f) ? 1.f / lrun : 0.f;
    f32x16 A2[2];
#pragma unroll
    for (int i = 0; i < 16; ++i) { A2[0][i] = 0.f; A2[1][i] = 0.f; }
    {
        const f16* wt = (const f16*)(F.ws + WS_WUVT) + (size_t)((L * 4 + hd) * 64 + rho) * 128 + 4 * hf;
        wt = launder_g(wt);
#pragma unroll
        for (int d = 0; d < 4; ++d) {
            O[d] = O[d] * invl;
#pragma unroll
            for (int s = 0; s < 2; ++s) {
                const h8 pf = nsa::pack_step(O[d], s);
#pragma unroll
                for (int vt = 0; vt < 2; ++vt) {
                    const f16* wp = wt + (size_t)(32 * vt) * 128 + 32 * d + 16 * s;
                    const h4 lo4 = *(const h4*)wp, hi4 = *(const h4*)(wp + 8);
                    const h8 av = __builtin_shufflevector(lo4, hi4, 0, 1, 2, 3, 4, 5, 6, 7);
                    A2[vt] = MFMA32(av, pf, A2[vt]);
                }
            }
        }
    }
    float sq = 0.f;
#pragma unroll
    for (int i = 0; i < 16; ++i) sq += A2[0][i] * A2[0][i] + A2[1][i] * A2[1][i];
    sq = add_x32(sq);
    LAS float* ssq = (LAS float*)(F.lds + SSQ);
    __syncthreads();
    if (hf == 0) ssq[w * 32 + rho] = sq;
    __syncthreads();
    const float tot = (ssq[(qh * 4 + 0) * 32 + rho] + ssq[(qh * 4 + 1) * 32 + rho]) + (ssq[(qh * 4 + 2) * 32 + rho] + ssq[(qh * 4 + 3) * 32 + rho]);
    const float rn = rsqrtf(tot * (1.f / 256.f) + EPS);
    const float* ga = gin(a, 23) + L * 256 + hd * 64 + 4 * hf;
    f16* dst = (f16*)(F.ws + WS_XA) + (size_t)m * D + hd * 64 + 4 * hf;
    dst = launder_g(dst); ga = launder_g(ga);
#pragma unroll
    for (int vt = 0; vt < 2; ++vt)
#pragma unroll
        for (int r4 = 0; r4 < 4; ++r4) {
            const int col = 32 * vt + 8 * r4; const f32x4 gn = *(const f32x4*)(ga + col);
            h4 o; o[0] = (f16)(A2[vt][4 * r4] * rn * gn[0]); o[1] = (f16)(A2[vt][4 * r4 + 1] * rn * gn[1]); o[2] = (f16)(A2[vt][4 * r4 + 2] * rn * gn[2]); o[3] = (f16)(A2[vt][4 * r4 + 3] * rn * gn[3]);
            *(u32x2*)(dst + col) = __builtin_bit_cast(u32x2, o);
        }
    __syncthreads();
}

__device__ __forceinline__ void item(Frame& F, int L, ArgsP a, int b, int c) {
    P1Ops ops; pass1_load(F, b, 64 * c, ops);
    for (int r = 0; r < 8; ++r) pass1_round(F, b, 64 * c + 8 * r, ops, r < 7);
    refresh(F); asm volatile("" : "+s"(b), "+s"(c));
    pass2(F, L, a, b, c);
    refresh(F);
}
}

__device__ __forceinline__ void p4_dsa_nsa(Frame& F, int L, ArgsP a) {
    for (int p = F.bx; p < BATCH * 32; p += F.G) {
        const int b = p & 7, c = p >> 3;
        dsa::item(F, L, a, b, 63 - c);
        dsa::item(F, L, a, b, c);
    }
    __syncthreads();
    refresh(F);
    for (int p = F.bx; p < BATCH * 32; p += F.G) {
        const int b = p & 7, c = p >> 3;
        nsa::item(F, L, a, b, 63 - c);
        nsa::item(F, L, a, b, c);
    }
    __syncthreads();
}

__device__ __forceinline__ void p_final(Frame& F, ArgsP a) {
    const float* ss = (const float*)(F.ws + WS_SS1); const float* fg = gin(a, 30); const f16* XB = (const f16*)(F.ws + WS_XB);
    for (int m = F.gw; m < M; m += F.ngw) {
        const float r = pg8::rstd_from_ss(ss, m) * (1.f / XSCALE);
#pragma unroll
        for (int j = 0; j < 2; ++j) {
            const size_t off = (size_t)m * D + j * 512 + F.lane * 8;
            const h8 xh = *(const h8*)(XB + off); const f32x4 g0 = *(const f32x4*)(fg + j * 512 + F.lane * 8), g1 = *(const f32x4*)(fg + j * 512 + F.lane * 8 + 4);
            const f32x4 v0 = (f32x4){(float)xh[0], (float)xh[1], (float)xh[2], (float)xh[3]} * r * g0, v1 = (f32x4){(float)xh[4], (float)xh[5], (float)xh[6], (float)xh[7]} * r * g1;
            *(f32x4*)(gout(a) + off) = v0; *(f32x4*)(gout(a) + off + 4) = v1;
        }
    }
}

constexpr int N_PHASES = 14;
__global__ void __launch_bounds__(NTHREADS, 2) fwd(Args a_) {
    extern __shared__ __attribute__((aligned(16))) unsigned char lds_raw[];
    cg::grid_group grid = cg::this_grid();
    ArgsP a = fresh_args();
    Frame F;
    F.lds = (LAS unsigned char*)lds_raw; F.ws = (GAS unsigned char*)a->ws;
    F.tid = threadIdx.x; F.lane = F.tid & 63; F.wave = __builtin_amdgcn_readfirstlane(F.tid >> 6);
    F.G = gridDim.x; F.bx = blockIdx.x; F.gw = blockIdx.x * NWAVES + F.wave; F.ngw = F.G * NWAVES;
    const int lo = a->ph_lo, hi = a->ph_hi;
    volatile LAS unsigned* xst = (volatile LAS unsigned*)(F.lds + LDS_BYTES - 16);
    if (threadIdx.x == 0) { xst[0] = 0u; xst[1] = 0u; }
    __syncthreads();
    XcdBarrier xbar = xcd_barrier_post((unsigned*)a->ws, xst);
#define IN(k) (lo <= (k) && (k) < hi)
#define SEAM(k) do { if (IN(k) && IN((k) + 1)) { if ((k) == 0) grid.sync(); else xcd_barrier(xbar); } } while (0)
    if (IN(0)) { refresh(F); a = fresh_args(); p0_prologue(F, a); }
    SEAM(0);
    for (int L = 0; L < DEPTH; ++L) {
        const int pb = 1 + 6 * L;
        GAS unsigned char* wl = F.ws + WS_W + (size_t)L * WL_STRIDE;
        if (IN(pb + 0)) {
            refresh(F); a = fresh_args();
            {
                pg8::Gemm g{(const f16*)(F.ws + (L == 0 ? WS_XA : WS_XB)), (const f16*)(wl + WL_INP), D, D, D, nullptr, nullptr, nullptr, nullptr, nullptr, 1.f, 1.f};
                pg8::StaticOrder S; S.init(M, NPREC + NPLAIN, F.G, F.bx);
                pg8::EpiInX E{(float*)(F.ws + WS_PP), (f16*)(F.ws + WS_PH), (const float*)(F.ws + WS_SS1), 1.f / (XSCALE * WSCALE), 1.f / XSCALE};
                pg8::gemm_phase<pg8::EpiInX, false>(F.lds, g, S, E);
            }
        }
        SEAM(pb + 0);
        if (IN(pb + 1)) { refresh(F); a = fresh_args(); p2_finalize(F, L, a); refresh(F); a = fresh_args(); p2_compress(F, L, a); refresh(F); a = fresh_args(); p2_s5_local(F, L); }
        SEAM(pb + 1);
        if (IN(pb + 2)) { refresh(F); a = fresh_args(); p4_s5_out(F, L, a); refresh(F); a = fresh_args(); p4_dsa_nsa(F, L, a); }
        SEAM(pb + 2);
        if (IN(pb + 3)) {
            refresh(F); a = fresh_args();
            pg8::Gemm g{(const f16*)(F.ws + WS_XA), (const f16*)(wl + WL_OUT), D, D, D, nullptr, nullptr, nullptr, nullptr, nullptr, 1.f, 1.f};
            pg8::StaticOrder S; S.init(M, D, F.G, F.bx);
            if (L == 0) { g.xin_f = gin(a, 0); g.XH = (f16*)(F.ws + WS_XB); g.ss = (float*)(F.ws + WS_SS2);
                pg8::EpiRes<false, false, true> E; pg8::gemm_phase<pg8::EpiRes<false, false, true>, false>(F.lds, g, S, E); }
            else { g.xin_h = (const f16*)(F.ws + WS_XB); g.rs = 1.f / XSCALE; g.XH = (f16*)(F.ws + WS_XB); g.ss = (float*)(F.ws + WS_SS2);
                pg8::EpiRes<true, false, true> E; pg8::gemm_phase<pg8::EpiRes<true, false, true>, false>(F.lds, g, S, E); }
        }
        SEAM(pb + 3);
        if (IN(pb + 4)) {
            refresh(F); a = fresh_args();
            pg8::Gemm g{(const f16*)(F.ws + WS_XB), (const f16*)(wl + WL_UP), D, D, D, nullptr, nullptr, nullptr, nullptr, nullptr, 1.f, 1.f};
            pg8::StaticOrder S; S.init(M, DFF, F.G, F.bx);
            pg8::EpiUp E{(f16*)(F.ws + WS_H), (const float*)(F.ws + WS_SS2)};
            pg8::gemm_phase<pg8::EpiUp, false>(F.lds, g, S, E);
        }
        SEAM(pb + 4);
        if (IN(pb + 5)) {
            refresh(F); a = fresh_args();
            pg8::Gemm g{(const f16*)(F.ws + WS_H), (const f16*)(wl + WL_DOWN), DFF, DFF, DFF, nullptr, nullptr, nullptr, nullptr, nullptr, 1.f, 1.f};
            pg8::StaticOrder S; S.init(M, D, F.G, F.bx, 1);
            g.xin_h = (const f16*)(F.ws + WS_XB); g.ss = (float*)(F.ws + WS_SS1);
            g.XH = (f16*)(F.ws + WS_XB); g.hs = XSCALE;
            { pg8::EpiRes<true, false, true> E; pg8::gemm_phase<pg8::EpiRes<true, false, true>, false>(F.lds, g, S, E); }
        }
        SEAM(pb + 5);
    }
    if (IN(13)) { refresh(F); a = fresh_args(); p_final(F, a); }
#undef IN
#undef SEAM
}

#ifndef MK_MULTI
#define MK_MULTI 0
#endif
extern "C" void kernel_launch(void* const* d_in, const int* in_sizes, int n_in, void* d_out, int out_size,
                              void* d_ws, size_t ws_size, hipStream_t stream) {
    static int grid = 0;
    if (grid == 0) {
        int dev = 0, cus = 0, per_cu = 0;
        (void)hipGetDevice(&dev);
        (void)hipDeviceGetAttribute(&cus, hipDeviceAttributeMultiprocessorCount, dev);
        (void)hipFuncSetAttribute((const void*)fwd, hipFuncAttributeMaxDynamicSharedMemorySize, LDS_BYTES);
        (void)hipOccupancyMaxActiveBlocksPerMultiprocessor(&per_cu, (const void*)fwd, NTHREADS, LDS_BYTES);
        if (per_cu < 1) per_cu = 1;
        grid = cus * per_cu;
        if (n_in != 31 || ws_size < WS_END) fprintf(stderr, "kernel_launch: unexpected n_in %d / ws %zu\n", n_in, ws_size);
        fprintf(stderr, "grid %d (cus %d per_cu %d) ws %zu\n", grid, cus, per_cu, ws_size);
    }
    (void)hipMemsetAsync(d_ws, 0, 16384, stream);
    Args a{};
    for (int i = 0; i < 31; ++i) a.in[i] = (const float*)d_in[i];
    a.out = (float*)d_out; a.ws = (unsigned char*)d_ws;
    for (int i = 0; i < 8; ++i) a.inv16[i] = (float)pow(500000.0, -(double)(2 * i) / 16.0);
    for (int i = 0; i < 4; ++i) a.inv8[i] = (float)pow(500000.0, -(double)(2 * i) / 8.0);
#if MK_MULTI
    for (int p = 0; p < N_PHASES; ++p) { a.ph_lo = p; a.ph_hi = p + 1; hipLaunchKernelGGL(fwd, dim3(grid), dim3(NTHREADS), LDS_BYTES, stream, a); }
#else
    a.ph_lo = 0; a.ph_hi = N_PHASES;
    void* args[] = {&a};
    hipError_t e = hipLaunchCooperativeKernel((const void*)fwd, dim3(grid), dim3(NTHREADS), args, LDS_BYTES, stream);
    if (e != hipSuccess) fprintf(stderr, "cooperative launch failed: %s (grid %d)\n", hipGetErrorString(e), grid);
#endif
}
```

```cpp
#include <hip/hip_runtime.h>
#include <hip/hip_cooperative_groups.h>
#include <cstdio>
#include <cmath>
namespace cg = cooperative_groups;

#define LAS __attribute__((address_space(3)))
#define GAS __attribute__((address_space(1)))
typedef _Float16 f16;
typedef _Float16 h8 __attribute__((ext_vector_type(8)));
typedef _Float16 h4 __attribute__((ext_vector_type(4)));
typedef _Float16 h2 __attribute__((ext_vector_type(2)));
typedef float f32x4 __attribute__((ext_vector_type(4)));
typedef float f32x2 __attribute__((ext_vector_type(2)));
typedef unsigned u32x4 __attribute__((ext_vector_type(4)));
typedef unsigned u32x2 __attribute__((ext_vector_type(2)));
typedef float f32x16 __attribute__((ext_vector_type(16)));
typedef short v4i16_t __attribute__((ext_vector_type(4)));
#define MFMA32(a, b, c) __builtin_amdgcn_mfma_f32_32x32x16_f16((a), (b), (c), 0, 0, 0)

constexpr int BATCH = 8, SEQ = 4096, M = BATCH * SEQ, D = 1024, NIN = 2124, DFF = 4096, DEPTH = 2;
constexpr float EPS = 1e-6f;
constexpr int NWAVES = 8, NTHREADS = 512;
constexpr int LDS_BYTES = 152 * 1024;
constexpr int C_AQ = 0, C_CKV = 256, C_KR = 384, C_IQ = 400, C_IK = 528, C_IW = 560, C_BU = 564, C_CQ = 820, C_CKVN = 1332, C_GATE = 2100;
constexpr int PH_LD = 1792;
constexpr int H_QA = 0, H_KA = 576, H_BU = 720, H_VC = 976, H_KS = 1104, H_VS = 1232, H_KW = 1360, H_VW = 1488, H_GATE = 1616, H_IK = 1640, H_IW = 1672, H_END = 1676;
constexpr int PP_LD = 1024;
constexpr int P_CQ = 0, P_KC = 512, P_IQ = 640, P_IK = 768, P_IW = 800, P_END = 804;
constexpr int P_IKS = 832, P_IQS = 864;
constexpr float ISC = 8.f;
constexpr bool SPLIT = false;
constexpr int NPREC = 768, NPLAIN = 1792;
constexpr float XSCALE = 16.f, WSCALE = 128.f;

constexpr size_t MiB = 1u << 20;
constexpr size_t WS_ROPE = 1 * MiB;
constexpr size_t WS_S5C = 4 * MiB;
constexpr int S5C_STRIDE = 196608;
constexpr int S5_AR = 0, S5_AI = 1024, S5_BBR = 2048, S5_BBI = 18432, S5_ATR = 34816, S5_ATI = 100352, S5_CB = 165888;
constexpr size_t WS_SS1 = 6 * MiB, WS_SS2 = 8 * MiB;
constexpr size_t WS_HLOC = 10 * MiB;
constexpr size_t WS_KCMP = 14 * MiB, WS_VCMP = 15 * MiB;
constexpr size_t WS_W = 16 * MiB, WL_STRIDE = 28 * MiB;
constexpr size_t WL_INP = 0, WL_INH = (size_t)768 * 1024 * 2,        WL_OUT = 10 * MiB, WL_UP = 12 * MiB, WL_DOWN = 20 * MiB;
constexpr size_t WS_XA = 72 * MiB, WS_XB = 136 * MiB, WS_PP = 200 * MiB, WS_PH = 328 * MiB, WS_H = 200 * MiB, WS_BM = 456 * MiB, WS_END = 484 * MiB;
constexpr size_t WS_WUVT = 5 * MiB + 768 * 1024;
constexpr size_t WS_GLUT = 472 * MiB;
constexpr size_t WS_W1T = 474 * MiB;
constexpr size_t WS_BBT = 476 * MiB;
constexpr size_t WS_CMT = 473 * MiB;
constexpr size_t WS_IKT = 480 * MiB;
constexpr size_t XPLANE = WS_XB - WS_XA;

struct Args {
    const float* in[31];
    float* out;
    unsigned char* ws;
    float inv16[8];
    float inv8[4];
    int ph_lo, ph_hi;
};

typedef const Args __attribute__((address_space(4)))* ArgsP;
__device__ __forceinline__ const float* gin(ArgsP a, int i) { return (const float*)(GAS const float*)a->in[i]; }
__device__ __forceinline__ float* gout(ArgsP a) { return (float*)(GAS float*)a->out; }
template <class T> __device__ __forceinline__ T* launder_g(T* p) { GAS T* q = (GAS T*)p; asm volatile("" : "+v"(q)); return (T*)q; }
__device__ __forceinline__ ArgsP fresh_args() { ArgsP p = (ArgsP)__builtin_amdgcn_kernarg_segment_ptr(); asm volatile("" : "+s"(p)); return p; }
template <int CTRL> __device__ __forceinline__ float dpp_mv(float v) { return __builtin_bit_cast(float, __builtin_amdgcn_mov_dpp(__builtin_bit_cast(int, v), CTRL, 0xF, 0xF, true)); }
__device__ __forceinline__ float wave_sum(float v) {
    v += dpp_mv<0xB1>(v); v += dpp_mv<0x4E>(v); v += dpp_mv<0x141>(v); v += dpp_mv<0x140>(v);
    const int vi = __builtin_bit_cast(int, v);
    return (__builtin_bit_cast(float, __builtin_amdgcn_readlane(vi, 0)) + __builtin_bit_cast(float, __builtin_amdgcn_readlane(vi, 16)))
         + (__builtin_bit_cast(float, __builtin_amdgcn_readlane(vi, 32)) + __builtin_bit_cast(float, __builtin_amdgcn_readlane(vi, 48)));
}
__device__ __forceinline__ float wave_max(float v) {
#pragma unroll
    for (int o = 1; o < 64; o <<= 1) v = fmaxf(v, __shfl_xor(v, o));
    return v;
}
__device__ __forceinline__ int wave_sum_i(int v) {
#pragma unroll
    for (int o = 1; o < 64; o <<= 1) v += __shfl_xor(v, o);
    return v;
}
__device__ __forceinline__ float max_x32(float v) { const auto rr = __builtin_amdgcn_permlane32_swap(__float_as_uint(v), __float_as_uint(v), false, false); return fmaxf(__uint_as_float(rr[0]), __uint_as_float(rr[1])); }
__device__ __forceinline__ float add_x32(float v) { const auto rr = __builtin_amdgcn_permlane32_swap(__float_as_uint(v), __float_as_uint(v), false, false); return __uint_as_float(rr[0]) + __uint_as_float(rr[1]); }
__device__ __forceinline__ float partner_x32(float v, int hf) { const auto rr = __builtin_amdgcn_permlane32_swap(__float_as_uint(v), __float_as_uint(v), false, false); return __uint_as_float(hf ? rr[0] : rr[1]); }
__device__ __forceinline__ float gelu_tanh(float x) {
    const float u = 0.7978845608028654f * (x + 0.044715f * x * x * x);
    const float e = __builtin_amdgcn_exp2f(2.885390081777927f * u);
    return x * (1.f - __builtin_amdgcn_rcpf(1.f + e));
}
__device__ __forceinline__ float sigmoidf(float x) { return __builtin_amdgcn_rcpf(1.f + __builtin_amdgcn_exp2f(-1.4426950408889634f * x)); }
__device__ __forceinline__ unsigned mono_key(float f) {
    unsigned u = __float_as_uint(f);
    return (u & 0x80000000u) ? ~u : (u | 0x80000000u);
}
__device__ __forceinline__ void lds_fence() { asm volatile("s_waitcnt lgkmcnt(0)" ::: "memory"); }
template <int CTRL> __device__ __forceinline__ float dpp_f(float v) { return __builtin_bit_cast(float, __builtin_amdgcn_mov_dpp(__builtin_bit_cast(int, v), CTRL, 0xF, 0xF, true)); }

namespace pg8 {
constexpr int BM = 256, BK = 64, HALF = 128, HTB = HALF * BK * 2, STAGE_BYTES = 8 * HTB, NXCD = 8, WGM = 8;
__device__ __forceinline__ int lds_byte(int r, int c) { const int st = (r >> 4) * 2 + (c >> 5), rr = r & 15, cc = c & 31, ob = rr * 64 + cc * 2; return st * 1024 + (ob ^ (((ob >> 9) & 1) << 5)); }
__device__ __forceinline__ void stage_rc(int b, int& R, int& C) { const int st = b / 1024, sb = b % 1024, swz = sb ^ (((sb >> 9) & 1) << 5); R = (st >> 1) * 16 + swz / 64; C = (st & 1) * 32 + (swz % 64) / 2; }
__device__ __forceinline__ int perm32(int rho) { const int n = rho >> 4, i = rho & 15; return 8 * (i >> 2) + 4 * n + (i & 3); }

struct Unit { int pm, pn; };
struct Gemm { const f16* A; const f16* Bt; int lda, ldb, K;
    const float* xin_f; const f16* xin_h; float* xout; f16* XH; float* ss; float rs, hs; };

struct StaticOrder {
    int nM, nN, nwg, G, c, rev;
    __device__ void init(int M_, int N_, int G_, int c_, int rev_ = 0) { nM = M_ / BM; nN = N_ / BM; nwg = nM * nN; G = G_; c = c_; rev = rev_; }
    __device__ bool next(int i, Unit& u) const {
        const long L = (long)i * G + c; if (L >= nwg) return false;
        int wgid = (int)L; { const int q = nwg / NXCD, r = nwg % NXCD, xcd = wgid % NXCD, off = wgid / NXCD; wgid = (xcd < r ? xcd * (q + 1) : r * (q + 1) + (xcd - r) * q) + off; }
        const int nig = WGM * nN, gid = wgid / nig, fm = gid * WGM, gsz = (nM - fm) < WGM ? (nM - fm) : WGM;
        u.pm = fm + ((wgid % nig) % gsz); u.pn = (wgid % nig) / gsz; if (rev) u.pm = nM - 1 - u.pm; return true;
    }
};

template <bool WRAPA>
__device__ __forceinline__ size_t koffA(int kt) {
    if constexpr (WRAPA) return (size_t)(kt & 15) * (BK * 2) + (((kt >> 4) == 1) ? XPLANE : 0);
    else return (size_t)kt * (BK * 2);
}

template <class Epi, bool WRAPA>
__device__ __forceinline__ void gemm_phase(LAS unsigned char* lds, const Gemm g, const StaticOrder& S, const Epi& E) {
    int tid = threadIdx.x; asm volatile("" : "+v"(tid));
    const int wid = __builtin_amdgcn_readfirstlane(tid >> 6), lane = tid & 63, wr = wid >> 2, wc = wid & 3, fr = lane & 15, fq = lane >> 4;
    const int nt = g.K / BK;
    unsigned voffA[2], voffB[2];
#pragma unroll
    for (int i = 0; i < 2; ++i) { int R, C; stage_rc(tid * 16 + i * 8192, R, C); const int Rb = (R & ~31) + perm32(R & 31);
        voffA[i] = (unsigned)(R * g.lda + C) * 2u; voffB[i] = (unsigned)(Rb * g.ldb + C) * 2u; }
    const size_t kstep = (size_t)(BK * 2);
    const size_t hstepA = (size_t)HALF * g.lda * 2, hstepB = (size_t)HALF * g.ldb * 2;
    const size_t tstepA = 2 * hstepA, tstepB = 2 * hstepB;
    const unsigned ldsw = (unsigned)wid * 1024u;
    const int aoff = lds_byte(wr * 64 + fr, fq * 8), boff = lds_byte(wc * 32 + fr, fq * 8);
#define PG8_SA(b, h) (((b) * 2 + (h)) * HTB)
#define PG8_SB(b, h) ((4 + (b) * 2 + (h)) * HTB)
#define PG8_STAGE(bufoff, gbase, voff) do { _Pragma("unroll") for (int _i = 0; _i < 2; ++_i) \
        __builtin_amdgcn_global_load_lds((const unsigned*)((const char*)(gbase) + (voff)[_i]), (LAS unsigned*)(lds + (bufoff) + ldsw + _i * 8192), 16, 0, 0); } while (0)
#define PG8_LDA(dst, b, h) do { _Pragma("unroll") for (int m = 0; m < 4; ++m) _Pragma("unroll") for (int k = 0; k < 2; ++k) dst[m][k] = *(const LAS h8*)(lds + PG8_SA(b, h) + aoff + m * 2048 + k * 1024); } while (0)
#define PG8_LDB(dst, b, h) do { _Pragma("unroll") for (int n = 0; n < 2; ++n) _Pragma("unroll") for (int k = 0; k < 2; ++k) dst[n][k] = *(const LAS h8*)(lds + PG8_SB(b, h) + boff + n * 2048 + k * 1024); } while (0)
#define PG8_MMA(ai, bj, At, Bt) do { __builtin_amdgcn_s_setprio(1); _Pragma("unroll") for (int m = 0; m < 4; ++m) _Pragma("unroll") for (int n = 0; n < 2; ++n) _Pragma("unroll") for (int k = 0; k < 2; ++k) \
        acc[ai][bj][m][n] = __builtin_amdgcn_mfma_f32_16x16x32_f16(Bt[n][k], At[m][k], acc[ai][bj][m][n], 0, 0, 0); __builtin_amdgcn_s_setprio(0); } while (0)
#define PG8_WAIT_V(n) asm volatile("s_waitcnt vmcnt(" #n ")" ::: "memory")
#define PG8_WAIT_L(n) asm volatile("s_waitcnt lgkmcnt(" #n ")" ::: "memory")
#define PG8_BAR __builtin_amdgcn_s_barrier()
#define PG8_SCHED __builtin_amdgcn_sched_barrier(0)
    Unit cur, nxt; int ui = 0;
    if (!S.next(0, cur)) return;
    f32x4 acc[2][2][4][2];
#pragma unroll
    for (int a = 0; a < 2; ++a)
#pragma unroll
        for (int b = 0; b < 2; ++b)
#pragma unroll
            for (int m = 0; m < 4; ++m)
#pragma unroll
                for (int n = 0; n < 2; ++n) acc[a][b][m][n] = (f32x4){0.f, 0.f, 0.f, 0.f};
    h8 At[4][2], B0[2][2], B1[2][2];
    const char* cA = (const char*)g.A + (size_t)cur.pm * tstepA; const char* cB = (const char*)g.Bt + (size_t)cur.pn * tstepB;
    PG8_STAGE(PG8_SB(0, 0), cB, voffB); PG8_STAGE(PG8_SB(0, 1), cB + hstepB, voffB); PG8_STAGE(PG8_SA(0, 0), cA + koffA<WRAPA>(0), voffA); PG8_STAGE(PG8_SA(0, 1), cA + koffA<WRAPA>(0) + hstepA, voffA);
    if (wr == 1) PG8_BAR;
    PG8_WAIT_V(2); PG8_BAR;
    PG8_STAGE(PG8_SB(1, 0), cB + kstep, voffB); PG8_STAGE(PG8_SA(1, 0), cA + koffA<WRAPA>(1), voffA); PG8_STAGE(PG8_SB(1, 1), cB + hstepB + kstep, voffB);
    PG8_WAIT_V(6); PG8_BAR;
    for (;;) {
        const bool has_next = S.next(ui + 1, nxt);
        const char* nA = has_next ? (const char*)g.A + (size_t)nxt.pm * tstepA : cA; const char* nB = has_next ? (const char*)g.Bt + (size_t)nxt.pn * tstepB : cB;
        for (int t = 0; t < nt; t += 2) {
            const bool last = (t == nt - 2);
            const char* a1 = cA + koffA<WRAPA>(t + 1);
            const char* a2 = last ? nA + koffA<WRAPA>(0) : cA + koffA<WRAPA>(t + 2); const char* b2 = last ? nB : cB + (size_t)(t + 2) * kstep;
            const char* a3 = last ? nA + koffA<WRAPA>(1) : cA + koffA<WRAPA>(t + 3); const char* b3 = b2 + kstep;
            PG8_LDB(B0, 0, 0); PG8_LDB(B1, 0, 1); PG8_SCHED; PG8_LDA(At, 0, 0); PG8_STAGE(PG8_SA(1, 1), a1 + hstepA, voffA);
            PG8_WAIT_V(8); PG8_WAIT_L(0); PG8_BAR; PG8_MMA(0, 0, At, B0); PG8_MMA(0, 1, At, B1); PG8_BAR; PG8_SCHED;
            PG8_LDA(At, 0, 1); PG8_STAGE(PG8_SB(0, 0), b2, voffB); PG8_STAGE(PG8_SB(0, 1), b2 + hstepB, voffB); PG8_STAGE(PG8_SA(0, 0), a2, voffA);
            PG8_WAIT_V(8); PG8_WAIT_L(0); PG8_BAR; PG8_MMA(1, 0, At, B0); PG8_MMA(1, 1, At, B1); PG8_BAR; PG8_SCHED;
            PG8_LDB(B0, 1, 0); PG8_LDB(B1, 1, 1); PG8_SCHED; PG8_LDA(At, 1, 0); PG8_STAGE(PG8_SA(0, 1), a2 + hstepA, voffA);
            PG8_WAIT_V(8); PG8_WAIT_L(0); PG8_BAR; PG8_MMA(0, 0, At, B0); PG8_MMA(0, 1, At, B1); PG8_BAR; PG8_SCHED;
            PG8_LDA(At, 1, 1); PG8_STAGE(PG8_SB(1, 0), b3, voffB); PG8_STAGE(PG8_SB(1, 1), b3 + hstepB, voffB); PG8_STAGE(PG8_SA(1, 0), a3, voffA);
            PG8_WAIT_V(8); PG8_WAIT_L(0); PG8_BAR; PG8_MMA(1, 0, At, B0); PG8_MMA(1, 1, At, B1); PG8_BAR; PG8_SCHED;
        }
        if (wr == 0) PG8_BAR;
        E(acc, cur, wr, wc, fr, fq, g);
        if (!has_next) break;
#pragma unroll
        for (int a = 0; a < 2; ++a)
#pragma unroll
            for (int b = 0; b < 2; ++b)
#pragma unroll
                for (int m = 0; m < 4; ++m)
#pragma unroll
                    for (int n = 0; n < 2; ++n) acc[a][b][m][n] = (f32x4){0.f, 0.f, 0.f, 0.f};
        cur = nxt; cA = nA; cB = nB; ++ui;
        if (wr == 1) PG8_BAR;
    }
    PG8_WAIT_V(0);
    PG8_BAR;
#undef PG8_SA
#undef PG8_SB
#undef PG8_STAGE
#undef PG8_LDA
#undef PG8_LDB
#undef PG8_MMA
#undef PG8_WAIT_V
#undef PG8_WAIT_L
#undef PG8_BAR
#undef PG8_SCHED
}

__device__ __forceinline__ float rstd_from_ss(const float* ss, int row) {
    const f32x4* p = (const f32x4*)(ss + (size_t)row * 16);
    const f32x4 a = p[0], b = p[1], c = p[2], d = p[3];
    const float s = ((a[0] + a[1]) + (a[2] + a[3])) + ((b[0] + b[1]) + (b[2] + b[3])) + ((c[0] + c[1]) + (c[2] + c[3])) + ((d[0] + d[1]) + (d[2] + d[3]));
    return rsqrtf(s * (1.f / 1024.f) + EPS);
}
__device__ __forceinline__ u32x4 pack8h(const f32x4 v0, const f32x4 v1) {
    h8 h; h[0] = (f16)v0[0]; h[1] = (f16)v0[1]; h[2] = (f16)v0[2]; h[3] = (f16)v0[3]; h[4] = (f16)v1[0]; h[5] = (f16)v1[1]; h[6] = (f16)v1[2]; h[7] = (f16)v1[3];
    return __builtin_bit_cast(u32x4, h);
}
template <bool F32OUT> struct EpiIn {
    void* O; int ldc; const float* ss; float sc;
    __device__ __forceinline__ void operator()(const f32x4 (&acc)[2][2][4][2], const Unit& u, int wr, int wc, int fr, int fq, const Gemm&) const {
        const int row0 = u.pm * BM + wr * 64 + fr, col0 = u.pn * BM + wc * 32 + 8 * fq;
#pragma unroll
        for (int ai = 0; ai < 2; ++ai)
#pragma unroll
            for (int m = 0; m < 4; ++m) {
                const int row = row0 + ai * HALF + m * 16;
                const float r = rstd_from_ss(ss, row) * sc;
#pragma unroll
                for (int bj = 0; bj < 2; ++bj) {
                    if (col0 + bj * HALF >= (F32OUT ? NPREC : H_END)) continue;
                    const f32x4 v0 = acc[ai][bj][m][0] * r, v1 = acc[ai][bj][m][1] * r;
                    if constexpr (F32OUT) { float* p = (float*)O + (size_t)row * ldc + col0 + bj * HALF; *(f32x4*)p = v0; *(f32x4*)(p + 4) = v1; }
                    else { f16* p = (f16*)O + (size_t)row * ldc + col0 + bj * HALF; *(u32x4*)p = pack8h(v0, v1); }
                }
            }
    }
};
struct EpiInX {
    float* PPo; f16* PHo; const float* ss; float sc1, sc2;
    __device__ __forceinline__ void operator()(const f32x4 (&acc)[2][2][4][2], const Unit& u, int wr, int wc, int fr, int fq, const Gemm&) const {
        const int row0 = u.pm * BM + wr * 64 + fr;
        const bool f32out = u.pn < NPREC / BM;
        const int col0 = (f32out ? u.pn : u.pn - NPREC / BM) * BM + wc * 32 + 8 * fq;
        const float sc = f32out ? sc1 : sc2;
#pragma unroll
        for (int ai = 0; ai < 2; ++ai)
#pragma unroll
            for (int m = 0; m < 4; ++m) {
                const int row = row0 + ai * HALF + m * 16;
                const float r = rstd_from_ss(ss, row) * sc;
#pragma unroll
                for (int bj = 0; bj < 2; ++bj) {
                    const int col = col0 + bj * HALF;
                    const f32x4 v0 = acc[ai][bj][m][0] * r, v1 = acc[ai][bj][m][1] * r;
                    if (f32out) { float* p = PPo + (size_t)row * PP_LD + col; *(f32x4*)p = v0; *(f32x4*)(p + 4) = v1; }
                    else if (col < H_END) *(u32x4*)(PHo + (size_t)row * PH_LD + col) = pack8h(v0, v1);
                }
            }
    }
};
template <bool RES_F16, bool OUT_F32, bool OUT_H> struct EpiRes {
    __device__ __forceinline__ void operator()(const f32x4 (&acc)[2][2][4][2], const Unit& u, int wr, int wc, int fr, int fq, const Gemm& G) const {
        const float* xin_f = G.xin_f; const f16* xin_h = G.xin_h; float* xout = G.xout; f16* XH = G.XH; float* ss = G.ss; const float rs = G.rs, hs = G.hs;
        const int row0 = u.pm * BM + wr * 64 + fr, col0 = u.pn * BM + wc * 32 + 8 * fq;
#pragma unroll
        for (int ai = 0; ai < 2; ++ai)
#pragma unroll
            for (int m = 0; m < 4; ++m) {
                const int row = row0 + ai * HALF + m * 16;
                float sq = 0.f;
#pragma unroll
                for (int bj = 0; bj < 2; ++bj) {
                    const size_t off = (size_t)row * D + col0 + bj * HALF;
                    f32x4 x0, x1;
                    if constexpr (RES_F16) { const h8 xh = *(const h8*)(xin_h + off);
                        x0 = (f32x4){(float)xh[0], (float)xh[1], (float)xh[2], (float)xh[3]} * rs; x1 = (f32x4){(float)xh[4], (float)xh[5], (float)xh[6], (float)xh[7]} * rs; }
                    else { x0 = *(const f32x4*)(xin_f + off); x1 = *(const f32x4*)(xin_f + off + 4); }
                    const f32x4 v0 = acc[ai][bj][m][0] + x0, v1 = acc[ai][bj][m][1] + x1;
                    if constexpr (OUT_F32) { *(f32x4*)(xout + off) = v0; *(f32x4*)(xout + off + 4) = v1; }
                    sq += (v0[0] * v0[0] + v0[1] * v0[1]) + (v0[2] * v0[2] + v0[3] * v0[3]) + (v1[0] * v1[0] + v1[1] * v1[1]) + (v1[2] * v1[2] + v1[3] * v1[3]);
                    if constexpr (OUT_H) *(u32x4*)(XH + off) = pack8h(v0 * hs, v1 * hs);
                }
                sq += __shfl_xor(sq, 16); sq += __shfl_xor(sq, 32);
                if (fq == 0) ss[(size_t)row * 16 + u.pn * 4 + wc] = sq;
            }
    }
};
struct EpiUp {
    f16* O; const float* ss;
    __device__ __forceinline__ void operator()(const f32x4 (&acc)[2][2][4][2], const Unit& u, int wr, int wc, int fr, int fq, const Gemm&) const {
        const int row0 = u.pm * BM + wr * 64 + fr, col0 = u.pn * BM + wc * 32 + 8 * fq;
#pragma unroll
        for (int ai = 0; ai < 2; ++ai)
#pragma unroll
            for (int m = 0; m < 4; ++m) {
                const int row = row0 + ai * HALF + m * 16;
                const float r = rstd_from_ss(ss, row);
#pragma unroll
                for (int bj = 0; bj < 2; ++bj) {
                    f32x4 v0 = acc[ai][bj][m][0] * r, v1 = acc[ai][bj][m][1] * r;
#pragma unroll
                    for (int j = 0; j < 4; ++j) { const float a = fmaxf(v0[j], 0.f), b = fmaxf(v1[j], 0.f); v0[j] = a * a; v1[j] = b * b; }
                    *(u32x4*)(O + (size_t)row * DFF + col0 + bj * HALF) = pack8h(v0, v1);
                }
            }
    }
};
}


#define XB_TMO      128
#define XB_XCNT(j)  (256  + 64 * (j))
#define XB_XSUB(j)  (1280 + 64 * (j))
#define XB_XGEN(j)  (2304 + 64 * (j))
#define XB_TOP      3328
#define XB_TOPGEN   3392
#define XCD_BAR_WORDS 3456
#define XB_SPIN_CAP (1u << 22)
__device__ __forceinline__ unsigned xb_ld(unsigned* p)              { return __hip_atomic_load(p, __ATOMIC_RELAXED, __HIP_MEMORY_SCOPE_AGENT); }
__device__ __forceinline__ unsigned xb_add(unsigned* p, unsigned v) { return __hip_atomic_fetch_add(p, v, __ATOMIC_RELAXED, __HIP_MEMORY_SCOPE_AGENT); }
__device__ __forceinline__ unsigned xb_xcc_id() { return (unsigned)__builtin_amdgcn_s_getreg((3 << 11) | 20) & 0xFu; }
#define XB_SPIN(cond, bar) do { unsigned _sp = 0; while (cond) { __builtin_amdgcn_s_sleep(1); \
    if ((++_sp & 255u) == 0u) { if (xb_ld(&(bar)[XB_TMO])) break; if (_sp > XB_SPIN_CAP) { atomicAdd(&(bar)[XB_TMO], 1u); break; } } } } while (0)
struct XcdBarrier { unsigned* bar; unsigned x; volatile LAS unsigned* st; };
__device__ __forceinline__ XcdBarrier xcd_barrier_post(unsigned* bar, volatile LAS unsigned* st) {
    XcdBarrier b; b.bar = bar; b.x = xb_xcc_id(); b.st = st;
    if (threadIdx.x == 0) (void)xb_add(&bar[XB_XCNT(b.x)], 1u);
    return b;
}
__device__ __forceinline__ void xcd_barrier_complete(unsigned* bar, unsigned x, unsigned& nloc, unsigned& nx) {
    const unsigned G = gridDim.x * gridDim.y * gridDim.z;
    unsigned sum, cnt, mine, sp = 0u;
    for (;;) {
        sum = 0u; cnt = 0u; mine = 0u;
#pragma unroll
        for (unsigned j = 0; j < 16; ++j) { const unsigned c = xb_ld(&bar[XB_XCNT(j)]); sum += c; cnt += (c > 0u) ? 1u : 0u; mine = (j == x) ? c : mine; }
        if (sum == G) break;
        __builtin_amdgcn_s_sleep(1);
        if ((++sp & 255u) == 0u) { if (xb_ld(&bar[XB_TMO])) break; if (sp > XB_SPIN_CAP) { atomicAdd(&bar[XB_TMO], 1u); break; } }
    }
    nloc = mine > 0u ? mine : 1u; nx = cnt > 0u ? cnt : 1u;
}
__device__ __forceinline__ void xcd_barrier(const XcdBarrier& b) {
    asm volatile("s_waitcnt vmcnt(0)" ::: "memory");
    __syncthreads();
    if (threadIdx.x == 0) {
        unsigned* bar = b.bar;
        __builtin_amdgcn_s_waitcnt(0);
        unsigned nloc = b.st[0], nx = b.st[1];
        if (nloc == 0u) { xcd_barrier_complete(bar, b.x, nloc, nx); b.st[0] = nloc; b.st[1] = nx; }
        const unsigned old = xb_add(&bar[XB_XSUB(b.x)], 1u);
        const unsigned gen = old / nloc;
        if (old + 1u == (gen + 1u) * nloc) {
            __builtin_amdgcn_fence(__ATOMIC_RELEASE, "agent");
            asm volatile("s_waitcnt vmcnt(0)" ::: "memory");
            const unsigned og = xb_add(&bar[XB_TOP], 1u);
            const unsigned tg = og / nx;
            if (og + 1u == (tg + 1u) * nx) xb_add(&bar[XB_TOPGEN], 1u);
            else XB_SPIN(xb_ld(&bar[XB_TOPGEN]) == tg, bar);
            __builtin_amdgcn_fence(__ATOMIC_ACQUIRE, "agent");
            xb_add(&bar[XB_XGEN(b.x)], 1u);
            asm volatile("s_waitcnt vmcnt(0)" ::: "memory");
        } else {
            XB_SPIN(xb_ld(&bar[XB_XGEN(b.x)]) == gen, bar);
            __builtin_amdgcn_fence(__ATOMIC_ACQUIRE, "agent");
            asm volatile("s_waitcnt vmcnt(0)" ::: "memory");
        }
    }
    __syncthreads();
}

struct Frame {
    LAS unsigned char* lds;
    GAS unsigned char* ws;
    int tid, lane, wave, gw, ngw, G, bx;
};
__device__ __forceinline__ void refresh(Frame& F) {
    int t = threadIdx.x; asm volatile("" : "+v"(t));
    F.tid = t; F.lane = t & 63; F.wave = __builtin_amdgcn_readfirstlane(t >> 6);
    int bx = blockIdx.x; asm volatile("" : "+s"(bx));
    F.bx = bx; F.gw = bx * NWAVES + F.wave;
    { GAS unsigned char* wsp = F.ws; asm volatile("" : "+s"(wsp)); F.ws = wsp; }
}

__device__ __forceinline__ float winh_val(const float* Win, const float* g1, const float* wuk, int k, int n) {
    int src = -1;
    if (n < H_KA) {
        const int h = n / 144, j = n % 144;
        if (j < 128) return 0.f;
        src = C_AQ + h * 64 + (j - 128);
    }
    else if (n < H_KA + 128) src = C_CKV + (n - H_KA);
    else if (n < H_BU) src = C_KR + (n - H_KA - 128);
    else if (n < H_VC) src = C_BU + (n - H_BU);
    else if (n < H_KS) src = C_CKVN + 128 + (n - H_VC);
    else if (n < H_VS) src = C_CKVN + 256 + (n - H_KS);
    else if (n < H_KW) src = C_CKVN + 384 + (n - H_VS);
    else if (n < H_VW) src = C_CKVN + 512 + (n - H_KW);
    else if (n < H_GATE) src = C_CKVN + 640 + (n - H_VW);
    else if (n < H_IK) src = C_GATE + (n - H_GATE);
    else if (n < H_IW) src = C_IK + (n - H_IK);
    else if (n < H_END) src = C_IW + (n - H_IW);
    if (src < 0) return 0.f;
    return Win[(size_t)k * NIN + src] * g1[k];
}
__device__ __forceinline__ float winp_val(const float* Win, const float* g1, int k, int n) {
    int src = -1;
    if (n < P_KC) src = C_CQ + n;
    else if (n < P_IQ) src = C_CKVN + (n - P_KC);
    else if (n < P_IK) src = C_IQ + (n - P_IQ);
    if (src < 0) return 0.f;
    return Win[(size_t)k * NIN + src] * g1[k];
}

__device__ __forceinline__ void tile_store(const LAS float* scr, f16* dst, int ldd, int k0, int n0, int lane, bool lo_part, bool skip_absorbed = false) {
    const int c = lane & 7;
#pragma unroll
    for (int j = 0; j < 4; ++j) {
        const int n = (lane >> 3) + 8 * j; const LAS float* s = scr + (8 * c) * 33 + n;
        if (skip_absorbed && (n0 + n) < H_KA && ((n0 + n) % 144) < 128) continue;
        h8 o;
#pragma unroll
        for (int e = 0; e < 8; ++e) { const float v = s[e * 33]; const f16 hi = (f16)v; o[e] = lo_part ? (f16)(v - (float)hi) : hi; }
        *(u32x4*)(dst + (size_t)(n0 + n) * ldd + k0 + 8 * c) = __builtin_bit_cast(u32x4, o);
    }
}

__device__ __forceinline__ void p0_prologue(Frame& F, ArgsP a) {
    LAS float* scr = (LAS float*)(F.lds + F.wave * 16384);
    const int lane = F.lane;
    constexpr int T_INP = (NPREC / 32) * (D / 64), T_INH = (NPLAIN / 32) * (D / 64), T_OUT = (D / 32) * (D / 64), T_UP = (DFF / 32) * (D / 64), T_DOWN = (D / 32) * (DFF / 64);
    constexpr int T_LAYER = T_INP + T_INH + T_OUT + T_UP + T_DOWN;
    for (int it = F.gw; it < DEPTH * T_LAYER; it += F.ngw) {
        const int L = it / T_LAYER; int r = it % T_LAYER;
        const float* Win = gin(a, 3) + (size_t)L * D * NIN; const float* g1 = gin(a, 2) + L * D;
        GAS unsigned char* wl = F.ws + WS_W + (size_t)L * WL_STRIDE;
        int kind, nkb;
        if (r < T_INP) { kind = 0; nkb = D / 64; }
        else if ((r -= T_INP) < T_INH) { kind = 1; nkb = D / 64; }
        else if ((r -= T_INH) < T_OUT) { kind = 2; nkb = D / 64; }
        else if ((r -= T_OUT) < T_UP) { kind = 3; nkb = D / 64; }
        else { r -= T_UP; kind = 4; nkb = DFF / 64; }
        const int nb = r / nkb, kb = r % nkb, n0 = nb * 32, k0 = kb * 64;
        const int kkb = lane >> 5, nn = lane & 31, n = n0 + nn;
        if (kind == 0) {
#pragma unroll 8
            for (int i = 0; i < 32; ++i) { const int kk = 2 * i + kkb; scr[kk * 33 + nn] = winp_val(Win, g1, k0 + kk, n) * WSCALE; }
        } else if (kind == 1) {
            for (int i = 0; i < 32; ++i) { const int kk = 2 * i + kkb; scr[kk * 33 + nn] = winh_val(Win, g1, gin(a, 5) + (size_t)L * 128 * 192, k0 + kk, n); }
        } else if (kind == 2) {
            const float* src = gin(a, 26) + (size_t)L * D * D + n;
#pragma unroll 8
            for (int i = 0; i < 32; ++i) { const int kk = 2 * i + kkb; scr[kk * 33 + nn] = src[(size_t)(k0 + kk) * D]; }
        } else if (kind == 3) {
            const float* src = gin(a, 28) + (size_t)L * D * DFF + n; const float* g2 = gin(a, 27) + L * D;
#pragma unroll 8
            for (int i = 0; i < 32; ++i) { const int kk = 2 * i + kkb; scr[kk * 33 + nn] = src[(size_t)(k0 + kk) * DFF] * g2[k0 + kk]; }
        } else {
            const float* src = gin(a, 29) + (size_t)L * DFF * D + n;
#pragma unroll 8
            for (int i = 0; i < 32; ++i) { const int kk = 2 * i + kkb; scr[kk * 33 + nn] = src[(size_t)(k0 + kk) * D]; }
        }
        lds_fence();
        if (kind == 0) tile_store(scr, (f16*)(wl + WL_INP), D, k0, n0, lane, false);
        else if (kind == 1) tile_store(scr, (f16*)(wl + WL_INH), D, k0, n0, lane, false, true);
        else if (kind == 2) tile_store(scr, (f16*)(wl + WL_OUT), D, k0, n0, lane, false);
        else if (kind == 3) tile_store(scr, (f16*)(wl + WL_UP), D, k0, n0, lane, false);
        else tile_store(scr, (f16*)(wl + WL_DOWN), DFF, k0, n0, lane, false);
        lds_fence();
    }
    for (int it = F.gw; it < DEPTH * 4 * 64; it += F.ngw) {
        const int L = it >> 8, h = (it >> 6) & 3, kb = it & 63, k0 = kb * 16;
        const float* Win = gin(a, 3) + (size_t)L * D * NIN + C_AQ + h * 64 + 16; const float* g1 = gin(a, 2) + L * D;
        const float* wuk = gin(a, 5) + (size_t)L * 128 * 192 + h * 48;
        float wa[48], wb[48];
#pragma unroll
        for (int q4 = 0; q4 < 12; ++q4) { const f32x4 va = *(const f32x4*)(wuk + (size_t)lane * 192 + 4 * q4), vb = *(const f32x4*)(wuk + (size_t)(lane + 64) * 192 + 4 * q4);
#pragma unroll
            for (int e = 0; e < 4; ++e) { wa[4 * q4 + e] = va[e]; wb[4 * q4 + e] = vb[e]; } }
        f16* dst = (f16*)(F.ws + WS_W + (size_t)L * WL_STRIDE + WL_INH) + (size_t)(h * 144) * D + k0;
#pragma unroll
        for (int kh = 0; kh < 2; ++kh) {
            h8 oa, ob;
#pragma unroll
            for (int kk = 0; kk < 8; ++kk) {
                const int k = k0 + kh * 8 + kk; const float* wr_ = Win + (size_t)k * NIN; float sa = 0.f, sb = 0.f;
#pragma unroll
                for (int q4 = 0; q4 < 12; ++q4) { const f32x4 x4 = *(const f32x4*)(wr_ + 4 * q4);
#pragma unroll
                    for (int e = 0; e < 4; ++e) { sa += x4[e] * wa[4 * q4 + e]; sb += x4[e] * wb[4 * q4 + e]; } }
                const float gk = g1[k]; oa[kk] = (f16)(sa * gk); ob[kk] = (f16)(sb * gk);
            }
            *(u32x4*)(dst + (size_t)lane * D + kh * 8) = __builtin_bit_cast(u32x4, oa);
            *(u32x4*)(dst + (size_t)(lane + 64) * D + kh * 8) = __builtin_bit_cast(u32x4, ob);
        }
    }
    {
        const float* x = gin(a, 0); f16* XA = (f16*)(F.ws + WS_XA); float* ss = (float*)(F.ws + WS_SS1);
        for (int m0 = F.gw; m0 < M; m0 += 4 * F.ngw) {
            f32x4 v[4][4];
#pragma unroll
            for (int r = 0; r < 4; ++r)
#pragma unroll
                for (int j = 0; j < 4; ++j) v[r][j] = *(const f32x4*)(x + (size_t)min(m0 + r * F.ngw, M - 1) * D + j * 256 + lane * 4);
#pragma unroll
            for (int r = 0; r < 4; ++r) {
                const int m = m0 + r * F.ngw;
                if (m < M) {
                    float sq = 0.f;
#pragma unroll
                    for (int j = 0; j < 4; ++j) {
                        const f32x4 vv = v[r][j];
                        sq += (vv[0] * vv[0] + vv[1] * vv[1]) + (vv[2] * vv[2] + vv[3] * vv[3]);
                        h4 hi;
#pragma unroll
                        for (int e = 0; e < 4; ++e) hi[e] = (f16)(vv[e] * XSCALE);
                        *(u32x2*)(XA + (size_t)m * D + j * 256 + lane * 4) = __builtin_bit_cast(u32x2, hi);
                    }
                    sq = wave_sum(sq);
                    if (lane < 16) ss[(size_t)m * 16 + lane] = (lane == 0) ? sq : 0.f;
                }
            }
        }
    }
    {
        const int* pos = (const int*)gin(a, 1); float* R = (float*)(F.ws + WS_ROPE);
        for (int m = F.bx * NTHREADS + F.tid; m < M; m += F.G * NTHREADS) {
            const float p = (float)pos[m];
#pragma unroll
            for (int i = 0; i < 8; ++i) { const float ang = p * a->inv16[i]; R[(size_t)m * 8 + i] = (float)cos((double)ang); R[(size_t)M * 8 + (size_t)m * 8 + i] = (float)sin((double)ang); }
#pragma unroll
            for (int i = 0; i < 4; ++i) { const float ang = p * a->inv8[i]; R[(size_t)M * 16 + (size_t)m * 4 + i] = (float)cos((double)ang); R[(size_t)M * 20 + (size_t)m * 4 + i] = (float)sin((double)ang); }
        }
    }
    for (int idx = F.bx * NTHREADS + F.tid; idx < DEPTH * 1024; idx += F.G * NTHREADS) {
        const int L = idx >> 10, gp = idx & 1023, g = gp >> 6;
        float* C = (float*)(F.ws + WS_S5C) + (size_t)L * S5C_STRIDE;
        const double lr = gin(a, 7)[L * 1024 + gp], li = gin(a, 8)[L * 1024 + gp], step = exp((double)gin(a, 9)[L * 16 + g]);
        const double mag = exp(lr * step), th = li * step, ar = mag * cos(th), ai = mag * sin(th);
        const double den = lr * lr + li * li, zr = ((ar - 1.0) * lr + ai * li) / den, zi = (ai * lr - (ar - 1.0) * li) / den;
        C[S5_AR + gp] = (float)ar; C[S5_AI + gp] = (float)ai;
        for (int h = 0; h < 16; ++h) {
            const double br = gin(a, 10)[(size_t)L * 16384 + gp * 16 + h], bi = gin(a, 11)[(size_t)L * 16384 + gp * 16 + h];
            C[S5_BBR + gp * 16 + h] = (float)(zr * br - zi * bi); C[S5_BBI + gp * 16 + h] = (float)(zr * bi + zi * br);
        }
    }
    for (int idx = F.bx * NTHREADS + F.tid; idx < DEPTH * 1024 * 64; idx += F.G * NTHREADS) {
        const int k = idx & 63, gp = (idx >> 6) & 1023, L = idx >> 16, g = gp >> 6;
        float* C = (float*)(F.ws + WS_S5C) + (size_t)L * S5C_STRIDE;
        const double lr = gin(a, 7)[L * 1024 + gp], li = gin(a, 8)[L * 1024 + gp], step = exp((double)gin(a, 9)[L * 16 + g]);
        const double e = 64.0 * k, mg = exp(lr * step * e), an = li * step * e;
        C[S5_ATR + k * 1024 + gp] = (float)(mg * cos(an)); C[S5_ATI + k * 1024 + gp] = (float)(mg * sin(an));
    }
    for (int idx = F.bx * NTHREADS + F.tid; idx < DEPTH * 16 * 128 * 16; idx += F.G * NTHREADS) {
        const int ch = idx & 15, col = (idx >> 4) & 127, g = (idx >> 11) & 15, L = idx >> 15, p = col & 63, gp = g * 64 + p;
        const double lr = gin(a, 7)[L * 1024 + gp], li = gin(a, 8)[L * 1024 + gp], step = exp((double)gin(a, 9)[L * 16 + g]);
        const double mag = exp(lr * step), th = li * step, ar = mag * cos(th), ai = mag * sin(th);
        const double den = lr * lr + li * li, zr = ((ar - 1.0) * lr + ai * li) / den, zi = (ai * lr - (ar - 1.0) * li) / den;
        const double br = gin(a, 10)[(size_t)L * 16384 + gp * 16 + ch], bi = gin(a, 11)[(size_t)L * 16384 + gp * 16 + ch];
        ((f16*)(F.ws + WS_BBT))[idx] = (f16)(256.0 * ((col < 64) ? (zr * br - zi * bi) : (zr * bi + zi * br)));
    }
    for (int idx = F.bx * NTHREADS + F.tid; idx < DEPTH * 2 * 64 * 2048; idx += F.G * NTHREADS) {
        const int col = idx & 63, k = (idx >> 6) & 2047, kv = (idx >> 17) & 1, L = idx >> 18;
        const float v = gin(a, kv ? 21 : 19)[(size_t)L * 2048 * 64 + (size_t)k * 64 + col] * WSCALE;
        const f16 hi = (f16)v;
        f16* d = (f16*)(F.ws + WS_W1T) + ((((size_t)((L * 2 + kv) * 2) * 2 + (col >> 5)) * 128 + (k >> 4)) * 64 + (col & 31) + 32 * ((k >> 3) & 1)) * 8 + (k & 7);
        d[0] = hi; d[(size_t)2 * 128 * 512] = (f16)(v - (float)hi);
    }
    for (int idx = F.bx * NTHREADS + F.tid; idx < DEPTH * 16 * 32 * 128; idx += F.G * NTHREADS) {
        const int k = idx & 127, ho = (idx >> 7) & 31, g = (idx >> 12) & 15, L = idx >> 16;
        float v = 0.f;
        if (ho < 16) v = (k < 64) ? gin(a, 12)[(size_t)L * 16384 + (g * 16 + ho) * 64 + k] : -gin(a, 13)[(size_t)L * 16384 + (g * 16 + ho) * 64 + (k - 64)];
        ((f16*)(F.ws + WS_CMT))[((((size_t)(L * 16 + g) * 8 + (k >> 4)) * 64 + ho + 32 * ((k >> 3) & 1)) * 8) + (k & 7)] = (f16)v;
    }
    for (int idx = F.bx * NTHREADS + F.tid; idx < DEPTH * 65536; idx += F.G * NTHREADS) {
        const int col = idx & 255, k = (idx >> 8) & 255, L = idx >> 16;
        ((f16*)(F.ws + WS_GLUT))[((((size_t)(L * 8 + (col >> 5)) * 16 + (k >> 4)) * 64 + (col & 31) + 32 * ((k >> 3) & 1)) * 8) + (k & 7)] = (f16)gin(a, 15)[(size_t)L * 65536 + k * 256 + col];
    }
    for (int idx = F.bx * NTHREADS + F.tid; idx < DEPTH * 4 * 64 * 128; idx += F.G * NTHREADS) {
        const int r = idx & 127, v = (idx >> 7) & 63, h = (idx >> 13) & 3, L = idx >> 15;
        ((f16*)(F.ws + WS_WUVT))[idx] = (f16)gin(a, 6)[(size_t)L * 128 * 256 + r * 256 + h * 64 + v];
    }
    for (int it = F.gw; it < DEPTH * 2 * 32; it += F.ngw) {
        const int L = it >> 6, kv = (it >> 5) & 1, part = it & 31;
        const float* pos = gin(a, 17 + kv) + (size_t)L * 2048 + part * 64; const float* w1 = gin(a, kv ? 21 : 19) + (size_t)L * 2048 * 64 + (size_t)part * 64 * 64;
        float s = 0.f;
#pragma unroll 16
        for (int i = 0; i < 64; ++i) s += pos[i] * w1[(size_t)i * 64 + lane];
        ((float*)(F.ws + WS_S5C) + (size_t)L * S5C_STRIDE + S5_CB)[(part * 2 + kv) * 64 + lane] = s;
    }
}

__device__ __forceinline__ void rope_f16(f16* q, int i, int half, float c, float s) {
    const float x1 = (float)q[i], x2 = (float)q[i + half];
    q[i] = (f16)(x1 * c - x2 * s); q[i + half] = (f16)(x2 * c + x1 * s);
}
__device__ __forceinline__ void rope16h(f16* p, const float* cs, const float* sn) {
    const h8 a = *(const h8*)p, b = *(const h8*)(p + 8);
    const f32x4 c0 = *(const f32x4*)cs, c1 = *(const f32x4*)(cs + 4), s0 = *(const f32x4*)sn, s1 = *(const f32x4*)(sn + 4);
    const float c[8] = {c0[0], c0[1], c0[2], c0[3], c1[0], c1[1], c1[2], c1[3]}, s[8] = {s0[0], s0[1], s0[2], s0[3], s1[0], s1[1], s1[2], s1[3]};
    h8 oa, ob;
#pragma unroll
    for (int i = 0; i < 8; ++i) { const float x1 = (float)a[i], x2 = (float)b[i]; oa[i] = (f16)(x1 * c[i] - x2 * s[i]); ob[i] = (f16)(x2 * c[i] + x1 * s[i]); }
    *(h8*)p = oa; *(h8*)(p + 8) = ob;
}
__device__ __forceinline__ void rope8f(float* p, const float* cs, const float* sn) {
    const f32x4 a = *(const f32x4*)p, b = *(const f32x4*)(p + 4), c = *(const f32x4*)cs, s = *(const f32x4*)sn;
    *(f32x4*)p = a * c - b * s; *(f32x4*)(p + 4) = b * c + a * s;
}
__device__ __forceinline__ void p2_finalize(Frame& F, int L, ArgsP a) {
    const int lane = F.lane, l = lane & 15;
    float* PP = (float*)(F.ws + WS_PP); f16* PH = (f16*)(F.ws + WS_PH); const float* R = (const float*)(F.ws + WS_ROPE);
    const float* kvg = gin(a, 4) + L * 128 + 8 * l;
    const f32x4 kg0 = *(const f32x4*)kvg, kg1 = *(const f32x4*)(kvg + 4);
    for (int m0 = F.gw * 4; m0 < M; m0 += F.ngw * 4) {
        const int m = m0 + (lane >> 4);
        float* pp = PP + (size_t)m * PP_LD; f16* ph = PH + (size_t)m * PH_LD;
        const float* c16 = R + (size_t)m * 8; const float* s16 = R + (size_t)M * 8 + (size_t)m * 8;
        const float* c8 = R + (size_t)M * 16 + (size_t)m * 4; const float* s8 = R + (size_t)M * 20 + (size_t)m * 4;
        const h8 cv = *(const h8*)(ph + H_KA + 8 * l);
        float cf[8]; float sq = 0.f;
#pragma unroll
        for (int i = 0; i < 8; ++i) { cf[i] = (float)cv[i]; sq += cf[i] * cf[i]; }
        sq += dpp_f<0xB1>(sq); sq += dpp_f<0x4E>(sq); sq += dpp_f<0x141>(sq); sq += dpp_f<0x140>(sq);
        if (l < 4) rope16h(ph + H_QA + l * 144 + 128, c16, s16);
        else if (l == 4) rope16h(ph + H_KA + 128, c16, s16);
        else if (l < 7) rope16h(ph + H_KS + (l - 5) * 64, c16, s16);
        else if (l < 9) rope16h(ph + H_KW + (l - 7) * 64, c16, s16);
        else if (l < 14) {
            float* src = (l == 13) ? pp + P_IK : pp + P_IQ + (l - 9) * 32;
            if (l == 13) {
#pragma unroll
                for (int c4 = 0; c4 < 4; ++c4) { const h8 kh = *(const h8*)(ph + H_IK + 8 * c4);
                    *(f32x4*)(src + 8 * c4) = (f32x4){(float)kh[0], (float)kh[1], (float)kh[2], (float)kh[3]}; *(f32x4*)(src + 8 * c4 + 4) = (f32x4){(float)kh[4], (float)kh[5], (float)kh[6], (float)kh[7]}; }
            }
            f16* dh = (f16*)(pp + P_IQS) + (l - 9) * 32; f16* dl = dh + 128;
            f16* kt = (f16*)(F.ws + WS_IKT) + ((size_t)(m >> 5) * 256 + (m & 31)) * 8;
            rope8f(src, c8, s8);
#pragma unroll
            for (int c4 = 0; c4 < 4; ++c4) {
                const f32x4 x0 = *(const f32x4*)(src + 8 * c4), x1 = *(const f32x4*)(src + 8 * c4 + 4);
                h8 hi, lo;
#pragma unroll
                for (int e = 0; e < 4; ++e) { const float a0 = x0[e] * ISC, a1 = x1[e] * ISC; hi[e] = (f16)a0; lo[e] = (f16)(a0 - (float)hi[e]); hi[4 + e] = (f16)a1; lo[4 + e] = (f16)(a1 - (float)hi[4 + e]); }
                if (l == 13) { *(h8*)(kt + ((c4 >> 1) * 64 + 32 * (c4 & 1)) * 8) = hi; *(h8*)(kt + ((2 + (c4 >> 1)) * 64 + 32 * (c4 & 1)) * 8) = lo; }
                else { *(h8*)(dh + 8 * c4) = hi; *(h8*)(dl + 8 * c4) = lo; }
            }
        }
        else if (l == 14) { const h4 wh = *(const h4*)(ph + H_IW); *(f32x4*)(pp + P_IW) = (f32x4){(float)wh[0], (float)wh[1], (float)wh[2], (float)wh[3]} * 0.5f; }
        else {
#pragma unroll
            for (int j = 0; j < 3; ++j) { h8 g = *(const h8*)(ph + H_GATE + 8 * j);
#pragma unroll
                for (int i = 0; i < 8; ++i) g[i] = (f16)sigmoidf((float)g[i]);
                *(h8*)(ph + H_GATE + 8 * j) = g; }
        }
        const float rk = rsqrtf(sq * (1.f / 128.f) + EPS);
        h8 co;
#pragma unroll
        for (int i = 0; i < 4; ++i) { co[i] = (f16)(cf[i] * rk * kg0[i]); co[4 + i] = (f16)(cf[4 + i] * rk * kg1[i]); }
        *(h8*)(ph + H_KA + 8 * l) = co;
    }
}

__device__ __forceinline__ void p2_compress(Frame& F, int L, ArgsP a) {
    const int lane = F.lane, w = F.wave, hf = lane >> 5, r31 = lane & 31;
    const float* PP = (const float*)(F.ws + WS_PP); const f16* PH = (const f16*)(F.ws + WS_PH);
    constexpr int TRS = 144, TSZ = 272 * TRS;
    LAS unsigned char* TH = F.lds; LAS unsigned char* TL = F.lds + TSZ;
    LAS float* part = (LAS float*)(F.lds + 2 * TSZ);
    const float* CB = (const float*)(F.ws + WS_S5C) + (size_t)L * S5C_STRIDE + S5_CB;
    constexpr float ASC = 8.f;
    for (int it = F.bx; it < 512; it += F.G) {
        const int kv = it >> 8, b = (it >> 5) & 7, g = (it >> 4) & 1, nb = it & 15, n0 = nb * 16, tok0 = n0 * 16;
        __syncthreads();
        for (int e = F.tid; e < 272 * 8; e += NTHREADS) {
            const int tl = e >> 3, c8 = e & 7, tok = tok0 + tl; h8 hi, lo;
#pragma unroll
            for (int i = 0; i < 8; ++i) { hi[i] = (f16)0.f; lo[i] = (f16)0.f; }
            if (tok < SEQ) {
                if (kv == 0) {
                    const float* p = PP + (size_t)(b * SEQ + tok) * PP_LD + P_KC + g * 64 + c8 * 8;
                    const f32x4 x0 = *(const f32x4*)p, x1 = *(const f32x4*)(p + 4);
#pragma unroll
                    for (int i = 0; i < 4; ++i) { const float a0 = x0[i] * ASC, a1 = x1[i] * ASC; hi[i] = (f16)a0; lo[i] = (f16)(a0 - (float)hi[i]); hi[4 + i] = (f16)a1; lo[4 + i] = (f16)(a1 - (float)hi[4 + i]); }
                } else {
                    const h8 hv = *(const h8*)(PH + (size_t)(b * SEQ + tok) * PH_LD + H_VC + g * 64 + c8 * 8);
#pragma unroll
                    for (int i = 0; i < 8; ++i) hi[i] = (f16)((float)hv[i] * ASC);
                }
            }
            *(LAS h8*)(TH + tl * TRS + c8 * 16) = hi; *(LAS h8*)(TL + tl * TRS + c8 * 16) = lo;
        }
        __syncthreads();
        f32x16 A0, A1;
#pragma unroll
        for (int i = 0; i < 16; ++i) { A0[i] = 0.f; A1[i] = 0.f; }
        {
            const int nl = (r31 < 16) ? r31 : 15;
            const f16* wt = (const f16*)(F.ws + WS_W1T) + (((size_t)((L * 2 + kv) * 2) * 2 * 128 + 16 * w) * 64 + lane) * 8;
#pragma unroll 8
            for (int s_ = 0; s_ < 16; ++s_) {
                const int kg0 = 256 * w + 16 * s_, l = kg0 >> 6, d0 = (kg0 & 63) + 8 * hf;
                const int off = (16 * nl + l) * TRS + d0 * 2;
                const h8 ah = *(const LAS h8*)(TH + off);
                const h8 bh0 = *(const h8*)(wt + (size_t)s_ * 512), bh1 = *(const h8*)(wt + (size_t)(128 + s_) * 512);
                A0 = MFMA32(ah, bh0, A0); A1 = MFMA32(ah, bh1, A1);
                if (SPLIT && kv == 0) {
                    const h8 al = *(const LAS h8*)(TL + off);
                    const h8 bl0 = *(const h8*)(wt + (size_t)(256 + s_) * 512), bl1 = *(const h8*)(wt + (size_t)(384 + s_) * 512);
                    A0 = MFMA32(ah, bl0, A0); A1 = MFMA32(ah, bl1, A1);
                    A0 = MFMA32(al, bh0, A0); A1 = MFMA32(al, bh1, A1);
                }
            }
        }
#pragma unroll
        for (int i = 0; i < 8; ++i) { const int row = (i & 3) + 8 * (i >> 2) + 4 * hf; part[(w * 16 + row) * 64 + r31] = A0[i]; part[(w * 16 + row) * 64 + 32 + r31] = A1[i]; }
        __syncthreads();
        float acc0 = 0.f, acc1 = 0.f;
#pragma unroll
        for (int ww = 0; ww < 8; ++ww) { acc0 += part[(ww * 16 + 2 * w) * 64 + lane]; acc1 += part[(ww * 16 + 2 * w + 1) * 64 + lane]; }
        float cb = 0.f;
#pragma unroll 8
        for (int part = 0; part < 32; ++part) cb += CB[(part * 2 + kv) * 64 + lane];
        const float osc = 1.f / (ASC * WSCALE);
        const float h0 = gelu_tanh(acc0 * osc + cb), h1 = gelu_tanh(acc1 * osc + cb);
        const float* w2 = gin(a, kv ? 22 : 20) + (size_t)L * 64 * 64;
        float o0 = 0.f, o1 = 0.f;
#pragma unroll
        for (int i0 = 0; i0 < 64; i0 += 16) {
            float wv[16];
#pragma unroll
            for (int i = 0; i < 16; ++i) wv[i] = w2[(i0 + i) * 64 + lane];
#pragma unroll
            for (int i = 0; i < 16; ++i) {
                o0 += __builtin_bit_cast(float, __builtin_amdgcn_readlane(__builtin_bit_cast(int, h0), i0 + i)) * wv[i];
                o1 += __builtin_bit_cast(float, __builtin_amdgcn_readlane(__builtin_bit_cast(int, h1), i0 + i)) * wv[i];
            }
        }
        float* dst = (float*)(F.ws + (kv ? WS_VCMP : WS_KCMP));
        const int na = n0 + 2 * w, nb2 = na + 1;
        if (na < 255) dst[((size_t)(b * 256 + na) * 2 + g) * 64 + lane] = o0;
        if (nb2 < 255) dst[((size_t)(b * 256 + nb2) * 2 + g) * 64 + lane] = o1;
    }
    __syncthreads();
}

__device__ __forceinline__ void s5_load_u(Frame& F, LAS float* ul, int b, int g, int c) {
    const f16* PH = (const f16*)(F.ws + WS_PH);
    const f16* p = PH + (size_t)(b * SEQ + c * 64 + F.lane) * PH_LD + H_BU + g * 16;
    const h8 u0 = *(const h8*)p, u1 = *(const h8*)(p + 8);
    LAS float* d = ul + F.lane * 16;
    *(LAS f32x4*)(d) = (f32x4){(float)u0[0], (float)u0[1], (float)u0[2], (float)u0[3]};
    *(LAS f32x4*)(d + 4) = (f32x4){(float)u0[4], (float)u0[5], (float)u0[6], (float)u0[7]};
    *(LAS f32x4*)(d + 8) = (f32x4){(float)u1[0], (float)u1[1], (float)u1[2], (float)u1[3]};
    *(LAS f32x4*)(d + 12) = (f32x4){(float)u1[4], (float)u1[5], (float)u1[6], (float)u1[7]};
    lds_fence();
}
__device__ __forceinline__ void p2_s5_local(Frame& F, int L) {
    const int lane = F.lane, hf = lane >> 5, r31 = lane & 31;
    const float* C = (const float*)(F.ws + WS_S5C) + (size_t)L * S5C_STRIDE;
    constexpr int HRS = 272;
    LAS unsigned char* ht = F.lds + F.wave * (32 * HRS);
    f32x2* HL = (f32x2*)(F.ws + WS_HLOC);
    for (int it = F.gw; it < 8 * 16 * 64; it += F.ngw) {
        const int b = it >> 10, g = (it >> 6) & 15, c = it & 63, gp = g * 64 + lane;
        const float ar = C[S5_AR + gp], ai = C[S5_AI + gp];
        h8 bb[4];
        {
            const f16* bp_ = (const f16*)(F.ws + WS_BBT) + ((size_t)((L * 16 + g) * 128 + r31)) * 16 + 8 * hf;
#pragma unroll
            for (int ct = 0; ct < 4; ++ct) bb[ct] = *(const h8*)(bp_ + (size_t)ct * 32 * 16);
        }
        const f16* up = (const f16*)(F.ws + WS_PH) + (size_t)(b * SEQ + c * 64 + r31) * PH_LD + H_BU + g * 16 + 8 * hf;
        const h8 uf0 = *(const h8*)up, uf1 = *(const h8*)(up + (size_t)32 * PH_LD);
        float hr = 0.f, hi = 0.f;
#pragma unroll
        for (int half = 0; half < 2; ++half) {
#pragma unroll
            for (int ct = 0; ct < 4; ++ct) {
                f32x16 X;
#pragma unroll
                for (int i = 0; i < 16; ++i) X[i] = 0.f;
                X = MFMA32(half ? uf1 : uf0, bb[ct], X);
#pragma unroll
                for (int i = 0; i < 16; ++i) *(LAS f16*)(ht + ((i & 3) + 8 * (i >> 2) + 4 * hf) * HRS + (32 * ct + r31) * 2) = (f16)X[i];
            }
            lds_fence();
#pragma unroll 8
            for (int jj = 0; jj < 32; ++jj) {
                const float xr = (float)*(const LAS f16*)(ht + jj * HRS + lane * 2) * (1.f / 256.f), xi = (float)*(const LAS f16*)(ht + jj * HRS + 128 + lane * 2) * (1.f / 256.f);
                const float nr = ar * hr - ai * hi + xr, ni = ar * hi + ai * hr + xi; hr = nr; hi = ni;
            }
            lds_fence();
        }
        HL[(size_t)it * 64 + lane] = (f32x2){hr, hi};
    }
}

__device__ __forceinline__ void p4_s5_out(Frame& F, int L, ArgsP a) {
    const int lane = F.lane, w = F.wave, tid = F.tid;
    const float* C = (const float*)(F.ws + WS_S5C) + (size_t)L * S5C_STRIDE;
    LAS f16* yh = (LAS f16*)F.lds;
    LAS float* ul = (LAS float*)(F.lds + 34816 + w * 4096);
    constexpr int HRS = 272;
    LAS unsigned char* ht = F.lds + 67584 + w * (32 * HRS);
    LAS float* bo = (LAS float*)(F.lds + 34816);
    const f32x2* HL = (const f32x2*)(F.ws + WS_HLOC);
    f16* MIX = (f16*)(F.ws + WS_XA);
    const float* dvec = gin(a, 14) + L * 256;
    const float* glub = gin(a, 16) + L * 256; const float* gainb = gin(a, 24) + L * 256;
    const int hf = lane >> 5, r31 = lane & 31;
    for (int it = F.bx; it < 512; it += F.G) {
        const int b = it & 7, cc = (it >> 3) & 31, c = (it < 256) ? cc : 63 - cc;
        __syncthreads();
        for (int gi = 0; gi < 2; ++gi) {
            const int g = 2 * w + gi, gp = g * 64 + lane;
            const float ar = C[S5_AR + gp], ai = C[S5_AI + gp];
            float hr = 0.f, hi = 0.f;
#pragma unroll 16
            for (int cp = 0; cp < c; ++cp) {
                const int k = c - 1 - cp; const float tr = C[S5_ATR + k * 1024 + gp], ti = C[S5_ATI + k * 1024 + gp];
                const f32x2 hl = HL[((size_t)((b * 16 + g) * 64 + cp)) * 64 + lane];
                hr += tr * hl[0] - ti * hl[1]; hi += tr * hl[1] + ti * hl[0];
            }
            h8 bb[4];
            {
                const f16* bp_ = (const f16*)(F.ws + WS_BBT) + ((size_t)((L * 16 + g) * 128 + r31)) * 16 + 8 * hf;
#pragma unroll
                for (int ct = 0; ct < 4; ++ct) bb[ct] = *(const h8*)(bp_ + (size_t)ct * 32 * 16);
            }
            h8 cm[8];
            {
                const f16* cp_ = (const f16*)(F.ws + WS_CMT) + ((size_t)(L * 16 + g) * 8 * 64 + lane) * 8;
#pragma unroll
                for (int s = 0; s < 8; ++s) cm[s] = *(const h8*)(cp_ + (size_t)s * 512);
            }
            s5_load_u(F, ul, b, g, c);
            const float dho = (r31 < 16) ? dvec[g * 16 + r31] : 0.f;
            const f16* up = (const f16*)(F.ws + WS_PH) + (size_t)(b * SEQ + c * 64 + r31) * PH_LD + H_BU + g * 16 + 8 * hf;
            for (int half = 0; half < 2; ++half) {
                {
                    const h8 uf = *(const h8*)(up + (size_t)(half * 32) * PH_LD);
#pragma unroll
                    for (int ct = 0; ct < 4; ++ct) {
                        f32x16 X;
#pragma unroll
                        for (int i = 0; i < 16; ++i) X[i] = 0.f;
                        X = MFMA32(uf, bb[ct], X);
#pragma unroll
                        for (int i = 0; i < 16; ++i) *(LAS f16*)(ht + ((i & 3) + 8 * (i >> 2) + 4 * hf) * HRS + (32 * ct + r31) * 2) = (f16)X[i];
                    }
                }
                lds_fence();
#pragma unroll 8
                for (int jj = 0; jj < 32; ++jj) {
                    LAS f16* pr = (LAS f16*)(ht + jj * HRS + lane * 2); LAS f16* pi = (LAS f16*)(ht + jj * HRS + 128 + lane * 2);
                    const float xr = (float)*pr * (1.f / 256.f), xi = (float)*pi * (1.f / 256.f);
                    const float nr = ar * hr - ai * hi + xr, ni = ar * hi + ai * hr + xi; hr = nr; hi = ni;
                    *pr = (f16)hr; *pi = (f16)hi;
                }
                lds_fence();
                f32x16 Y;
#pragma unroll
                for (int i = 0; i < 16; ++i) Y[i] = 0.f;
#pragma unroll
                for (int s = 0; s < 8; ++s) { const h8 af = *(const LAS h8*)(ht + r31 * HRS + (16 * s + 8 * hf) * 2); Y = MFMA32(af, cm[s], Y); }
                if (r31 < 16) {
#pragma unroll
                    for (int i = 0; i < 16; ++i) {
                        const int tok = half * 32 + (i & 3) + 8 * (i >> 2) + 4 * hf;
                        const float y = Y[i] + dho * ul[tok * 16 + r31];
                        yh[tok * 264 + g * 16 + r31] = (f16)gelu_tanh(y);
                    }
                }
                lds_fence();
            }
        }
        __syncthreads();
        {
            const int hf = lane >> 5, r31 = lane & 31, col = 32 * w + r31;
            f32x16 G0, G1;
#pragma unroll
            for (int i = 0; i < 16; ++i) { G0[i] = 0.f; G1[i] = 0.f; }
            const f16* bp = (const f16*)(F.ws + WS_GLUT) + ((size_t)(L * 8 + w) * 16 * 64 + lane) * 8;
            LAS const f16* ap = yh + r31 * 264 + 8 * hf;
#pragma unroll 8
            for (int s = 0; s < 16; ++s) {
                const h8 bf = *(const h8*)(bp + (size_t)s * 512);
                const h8 a0 = *(const LAS h8*)(ap + 16 * s), a1 = *(const LAS h8*)(ap + 32 * 264 + 16 * s);
                G0 = MFMA32(a0, bf, G0); G1 = MFMA32(a1, bf, G1);
            }
            const float gb = glub[col];
#pragma unroll
            for (int i = 0; i < 16; ++i) {
                const int t0_ = (i & 3) + 8 * (i >> 2) + 4 * hf, t1_ = t0_ + 32;
                bo[t0_ * 256 + col] = (float)yh[t0_ * 264 + col] * sigmoidf(G0[i] + gb);
                bo[t1_ * 256 + col] = (float)yh[t1_ * 264 + col] * sigmoidf(G1[i] + gb);
            }
        }
        __syncthreads();
        for (int i = 0; i < 8; ++i) {
            const int tok = w * 8 + i; const f32x4 v = *(const LAS f32x4*)(bo + tok * 256 + lane * 4);
            float sq = (v[0] * v[0] + v[1] * v[1]) + (v[2] * v[2] + v[3] * v[3]); sq = wave_sum(sq);
            const float r = rsqrtf(sq * (1.f / 256.f) + EPS); const f32x4 gn = *(const f32x4*)(gainb + lane * 4);
            h4 o; o[0] = (f16)(v[0] * r * gn[0]); o[1] = (f16)(v[1] * r * gn[1]); o[2] = (f16)(v[2] * r * gn[2]); o[3] = (f16)(v[3] * r * gn[3]);
            *(u32x2*)(MIX + (size_t)(b * SEQ + c * 64 + tok) * D + 256 + lane * 4) = __builtin_bit_cast(u32x2, o);
        }
    }
    __syncthreads();
}

constexpr int NSA_WSTRIDE = 10240;
struct OS { float m[4], l[4], o[4]; };
__device__ __forceinline__ void nsa_block(Frame& F, OS& st, const LAS float* qr, LAS float* pl, const f16* rowbase  , int tok0, bool valid, int kcol, int vcol) {
    const int lane = F.lane;
    const f16* kp = rowbase + (size_t)(tok0 + lane) * PH_LD + kcol;
    float s0 = 0.f, s1 = 0.f, s2 = 0.f, s3 = 0.f;
#pragma unroll 2
    for (int c8 = 0; c8 < 8; ++c8) {
        const h8 k8 = *(const h8*)(kp + c8 * 8);
#pragma unroll
        for (int q4 = 0; q4 < 2; ++q4) {
            const int d = c8 * 8 + q4 * 4;
            const f32x4 a0 = *(const LAS f32x4*)(qr + d), a1 = *(const LAS f32x4*)(qr + 64 + d), a2 = *(const LAS f32x4*)(qr + 128 + d), a3 = *(const LAS f32x4*)(qr + 192 + d);
#pragma unroll
            for (int e = 0; e < 4; ++e) { const float kf = (float)k8[q4 * 4 + e]; s0 += a0[e] * kf; s1 += a1[e] * kf; s2 += a2[e] * kf; s3 += a3[e] * kf; }
        }
    }
    float sv[4] = {s0, s1, s2, s3}; float al[4]; f32x4 pv;
#pragma unroll
    for (int h = 0; h < 4; ++h) {
        const float s = valid ? sv[h] : -1e30f;
        const float bm = wave_max(s), mn = fmaxf(st.m[h], bm);
        al[h] = __expf(st.m[h] - mn);
        const float p = valid ? __expf(s - mn) : 0.f;
        st.l[h] = st.l[h] * al[h] + wave_sum(p); st.m[h] = mn; st.o[h] *= al[h]; pv[h] = p;
    }
    *(LAS f32x4*)(pl + lane * 4) = pv;
    lds_fence();
    const f16* vp = rowbase + (size_t)tok0 * PH_LD + vcol + lane;
#pragma unroll 8
    for (int i = 0; i < 64; ++i) {
        const float v = (float)vp[(size_t)i * PH_LD]; const f32x4 p4 = *(const LAS f32x4*)(pl + i * 4);
        st.o[0] += p4[0] * v; st.o[1] += p4[1] * v; st.o[2] += p4[2] * v; st.o[3] += p4[3] * v;
    }
    lds_fence();
}
__device__ __forceinline__ void nsa_token(Frame& F, int L, ArgsP a, int b, int t, LAS unsigned char* wl) {
    const int lane = F.lane;
    const float* PP = (const float*)(F.ws + WS_PP); const f16* PH = (const f16*)(F.ws + WS_PH); const float* R = (const float*)(F.ws + WS_ROPE);
    LAS float* qs = (LAS float*)wl; LAS float* qr = (LAS float*)(wl + 1024); LAS float* pc = (LAS float*)(wl + 2048); LAS float* pl = (LAS float*)(wl + 6144); LAS float* cvl = (LAS float*)(wl + 7168);
    const int m = b * SEQ + t, cur = t >> 6;
    const f16* rowbase = PH + (size_t)(b * SEQ) * PH_LD;
    const float* KC = (const float*)(F.ws + WS_KCMP); const float* VC = (const float*)(F.ws + WS_VCMP);
    const f16* gatep = PH + (size_t)m * PH_LD + H_GATE;
    for (int g = 0; g < 2; ++g) {
        {
            const float* qp = PP + (size_t)m * PP_LD + P_CQ + g * 256;
            const float c = (lane < 16) ? R[(size_t)m * 8 + (lane & 7)] : 1.f, s = (lane < 16) ? R[(size_t)M * 8 + (size_t)m * 8 + (lane & 7)] : 0.f;
#pragma unroll
            for (int h = 0; h < 4; ++h) {
                const float x = qp[h * 64 + lane];
                const float other = __shfl_xor(x, 8);
                float xr = x;
                if (lane < 8) xr = x * c - other * s; else if (lane < 16) xr = x * c + other * s;
                qs[h * 64 + lane] = x * 0.125f; qr[h * 64 + lane] = xr * 0.125f;
            }
        }
        lds_fence();
        const int ncv = (t < 31) ? 0 : min(255, ((t - 31) >> 4) + 1);
        float sc[4][4];
#pragma unroll
        for (int j = 0; j < 4; ++j) {
            const int n = j * 64 + lane;
#pragma unroll
            for (int h = 0; h < 4; ++h) sc[j][h] = -1e30f;
            if (j * 64 < ncv) {
                const float* kp = KC + ((size_t)(b * 256 + n) * 2 + g) * 64;
                float s0 = 0.f, s1 = 0.f, s2 = 0.f, s3 = 0.f;
#pragma unroll 4
                for (int d4 = 0; d4 < 16; ++d4) {
                    const f32x4 k4 = *(const f32x4*)(kp + d4 * 4);
                    const f32x4 a0 = *(const LAS f32x4*)(qs + d4 * 4), a1 = *(const LAS f32x4*)(qs + 64 + d4 * 4), a2 = *(const LAS f32x4*)(qs + 128 + d4 * 4), a3 = *(const LAS f32x4*)(qs + 192 + d4 * 4);
#pragma unroll
                    for (int e = 0; e < 4; ++e) { s0 += a0[e] * k4[e]; s1 += a1[e] * k4[e]; s2 += a2[e] * k4[e]; s3 += a3[e] * k4[e]; }
                }
                if (n < ncv) { sc[j][0] = s0; sc[j][1] = s1; sc[j][2] = s2; sc[j][3] = s3; }
            }
        }
#pragma unroll
        for (int h = 0; h < 4; ++h) {
            float mx = fmaxf(fmaxf(sc[0][h], sc[1][h]), fmaxf(sc[2][h], sc[3][h])); mx = wave_max(mx);
            float sm = 0.f;
#pragma unroll
            for (int j = 0; j < 4; ++j) { const float p = ((j * 64 + lane) < ncv) ? __expf(sc[j][h] - mx) : 0.f; sc[j][h] = p; sm += p; }
            sm = wave_sum(sm);
            const float inv = (ncv > 0) ? 1.f / sm : 0.f;
#pragma unroll
            for (int j = 0; j < 4; ++j) pc[h * 256 + j * 64 + lane] = sc[j][h] * inv;
        }
        lds_fence();
        float oc[4] = {0.f, 0.f, 0.f, 0.f};
        {
            const float* vp = VC + ((size_t)(b * 256) * 2 + g) * 64 + lane;
#pragma unroll 4
            for (int n = 0; n < ncv; ++n) {
                const float v = vp[(size_t)n * 128];
                oc[0] += pc[n] * v; oc[1] += pc[256 + n] * v; oc[2] += pc[512 + n] * v; oc[3] += pc[768 + n] * v;
            }
        }
        unsigned long long selmask;
        if (cur < 16) selmask = (1ull << (cur + 1)) - 1ull;
        else {
            float imp = 0.f;
#pragma unroll
            for (int h = 0; h < 4; ++h) {
                const LAS float* p = pc + h * 256 + 4 * lane;
                const f32x4 p4 = *(const LAS f32x4*)p;
                const float pm1 = (lane > 0) ? p[-1] : 0.f;
                imp += (p4[0] + p4[1] + p4[2]) + 0.5f * p4[3] + 0.5f * pm1;
            }
            float val = imp;
            if (lane == 0 || lane == cur || lane == cur - 1) val = 1e9f;
            if (lane > cur) val = -INFINITY;
            int rank = 0;
            for (int j = 0; j < 64; ++j) { const float o = __shfl(val, j); rank += (o > val || (o == val && j < lane)) ? 1 : 0; }
            selmask = __ballot(rank < 16);
        }
        OS ss;
#pragma unroll
        for (int h = 0; h < 4; ++h) { ss.m[h] = -1e30f; ss.l[h] = 0.f; ss.o[h] = 0.f; }
        {
            unsigned long long mk = selmask;
            while (mk) {
                const int mb = __builtin_ctzll(mk); mk &= mk - 1ull;
                const int tok0 = mb * 64;
                nsa_block(F, ss, qr, pl, rowbase, tok0, (tok0 + lane) <= t, H_KS + g * 64, H_VS + g * 64);
            }
        }
        OS sw;
#pragma unroll
        for (int h = 0; h < 4; ++h) { sw.m[h] = -1e30f; sw.l[h] = 0.f; sw.o[h] = 0.f; }
        {
            const int lo = (t - 511 > 0) ? (t - 511) : 0;
            for (int mb = lo >> 6; mb <= cur; ++mb) {
                const int tok = mb * 64 + lane;
                nsa_block(F, sw, qr, pl, rowbase, mb * 64, (tok <= t) && (tok > t - 512), H_KW + g * 64, H_VW + g * 64);
            }
        }
#pragma unroll
        for (int h = 0; h < 4; ++h) {
            const float g0 = (float)gatep[g * 12 + h * 3 + 0], g1 = (float)gatep[g * 12 + h * 3 + 1], g2 = (float)gatep[g * 12 + h * 3 + 2];
            const float os_ = (ss.l[h] > 0.f) ? ss.o[h] / ss.l[h] : 0.f, ow_ = (sw.l[h] > 0.f) ? sw.o[h] / sw.l[h] : 0.f;
            cvl[(g * 4 + h) * 64 + lane] = g0 * oc[h] + g1 * os_ + g2 * ow_;
        }
        lds_fence();
    }
    float cv[8]; float sq = 0.f;
#pragma unroll
    for (int i = 0; i < 8; ++i) { cv[i] = cvl[i * 64 + lane]; sq += cv[i] * cv[i]; }
    sq = wave_sum(sq);
    const float r = rsqrtf(sq * (1.f / 512.f) + EPS);
    const float* gc = gin(a, 25) + L * 512;
    f16* dst = (f16*)(F.ws + WS_XA) + (size_t)m * D + 512;
#pragma unroll
    for (int i = 0; i < 8; ++i) dst[i * 64 + lane] = (f16)(cv[i] * r * gc[i * 64 + lane]);
}


namespace nsa {
constexpr int KRS = 144, VRS = 192, KTB = 64 * KRS, VTB = 64 * VRS;
constexpr int KT = 0, KL = 2 * KTB, VT = 4 * KTB, WSF = VT + 2 * VTB, IMP = WSF + 2048, SELM = IMP + 16384, GTAB = SELM + 512, OTS = 272, OT = GTAB + 4096, LDS_END = OT + 8 * 32 * OTS;
static_assert(LDS_END <= LDS_BYTES, "nsa LDS map");
constexpr float LOG2E = 1.4426950408889634f;
constexpr float QSC = 0.125f * LOG2E;
constexpr float CQS = 8.f, CKS = 64.f, CSC = 0.125f * LOG2E / (CQS * CKS);
__device__ __forceinline__ h4 tr_read4(LAS const unsigned char* p) { return __builtin_bit_cast(h4, __builtin_amdgcn_ds_read_tr16_b64_v4i16((LAS v4i16_t*)p)); }
__device__ __forceinline__ int crow(int i, int hf) { return (i & 3) + 8 * (i >> 2) + 4 * hf; }

template <int MODE> __device__ __forceinline__ void st_load(const Frame& F, int b, int g, int blk, int kcol, int vcol, f32x4& r0, f32x4& r1, f32x4& r2, f32x4& r3) {
    const int key = F.tid >> 3, ch = F.tid & 7;
    if constexpr (MODE == 0) {
        const size_t off = ((size_t)(b * 256 + blk * 64 + key) * 2 + g) * 64 + ch * 8;
        const float* kp = (const float*)(F.ws + WS_KCMP) + off; const float* vp = (const float*)(F.ws + WS_VCMP) + off;
        r0 = *(const f32x4*)kp; r1 = *(const f32x4*)(kp + 4); r2 = *(const f32x4*)vp; r3 = *(const f32x4*)(vp + 4);
    } else {
        const f16* rowp = (const f16*)(F.ws + WS_PH) + (size_t)(b * SEQ + blk * 64 + key) * PH_LD;
        r0 = *(const f32x4*)(rowp + kcol + ch * 8); r2 = *(const f32x4*)(rowp + vcol + ch * 8);
    }
}
template <int MODE> __device__ __forceinline__ void st_write(const Frame& F, int buf, const f32x4& r0, const f32x4& r1, const f32x4& r2, const f32x4& r3) {
    const int key = F.tid >> 3, ch = F.tid & 7;
    LAS unsigned char* kd = F.lds + KT + buf * KTB + key * KRS + ch * 16; LAS unsigned char* vd = F.lds + VT + buf * VTB + key * VRS + ch * 16;
    if constexpr (MODE == 0) {
        h8 hi, lo;
#pragma unroll
        for (int e = 0; e < 4; ++e) { const float x0 = r0[e] * CKS, x1 = r1[e] * CKS; hi[e] = (f16)x0; lo[e] = (f16)(x0 - (float)hi[e]); hi[4 + e] = (f16)x1; lo[4 + e] = (f16)(x1 - (float)hi[4 + e]); }
        *(LAS u32x4*)kd = __builtin_bit_cast(u32x4, hi); if constexpr (SPLIT) *(LAS u32x4*)(kd + (KL - KT)) = __builtin_bit_cast(u32x4, lo);
        *(LAS u32x4*)vd = pg8::pack8h(r2, r3);
    } else {
        *(LAS f32x4*)kd = r0; *(LAS f32x4*)vd = r2;
    }
}
template <bool PREC> __device__ __forceinline__ void s_tiles(const Frame& F, int buf, const h8 (&qa)[4], const h8 (&qb)[4], f32x16& S0, f32x16& S1) {
    const int r = F.lane & 31, hf = F.lane >> 5;
    LAS const unsigned char* k0 = F.lds + KT + buf * KTB + r * KRS + hf * 16;
#pragma unroll
    for (int i = 0; i < 16; ++i) { S0[i] = 0.f; S1[i] = 0.f; }
    h8 a0[2], a1[2], l0[2], l1[2];
#define NSA_KRD(s) do { a0[(s) & 1] = *(const LAS h8*)(k0 + (s) * 32); a1[(s) & 1] = *(const LAS h8*)(k0 + 32 * KRS + (s) * 32); \
        if constexpr (PREC) { l0[(s) & 1] = *(const LAS h8*)(k0 + (KL - KT) + (s) * 32); l1[(s) & 1] = *(const LAS h8*)(k0 + (KL - KT) + 32 * KRS + (s) * 32); } } while (0)
    NSA_KRD(0);
    __builtin_amdgcn_sched_barrier(0);
#pragma unroll
    for (int s = 0; s < 4; ++s) {
        if (s + 1 < 4) NSA_KRD(s + 1);
        __builtin_amdgcn_sched_barrier(0);
        S0 = MFMA32(a0[s & 1], qa[s], S0); S1 = MFMA32(a1[s & 1], qa[s], S1);
        if constexpr (PREC) {
            S0 = MFMA32(a0[s & 1], qb[s], S0); S1 = MFMA32(a1[s & 1], qb[s], S1);
            S0 = MFMA32(l0[s & 1], qa[s], S0); S1 = MFMA32(l1[s & 1], qa[s], S1);
        }
        __builtin_amdgcn_sched_barrier(0);
    }
#undef NSA_KRD
}
__device__ __forceinline__ h8 pack_step(const f32x16& x, int s) {
    h8 r;
#pragma unroll
    for (int j = 0; j < 8; ++j) r[j] = (f16)x[8 * s + j];
    return r;
}
__device__ __forceinline__ void pv_tiles(const Frame& F, int buf, const f32x16& P0, const f32x16& P1, f32x16 (&O)[2]) {
    const int lane = F.lane, hf = lane >> 5, blk = (lane >> 4) & 1, q = (lane & 15) >> 2, p = lane & 3;
    LAS const unsigned char* vb = F.lds + VT + buf * VTB + (4 * hf + q) * VRS + (16 * blk + 4 * p) * 2;
    h4 vl[3], vh[3];
#define NSA_VRD(i) do { LAS const unsigned char* ad_ = vb + (16 * ((i) >> 1)) * VRS + 64 * ((i) & 1); vl[(i) % 3] = tr_read4(ad_); vh[(i) % 3] = tr_read4(ad_ + 8 * VRS); } while (0)
    NSA_VRD(0); NSA_VRD(1);
    h8 pf[4];
    pf[0] = pack_step(P0, 0);
    __builtin_amdgcn_sched_barrier(0);
#pragma unroll
    for (int i = 0; i < 8; ++i) {
        if (i + 2 < 8) NSA_VRD(i + 2);
        __builtin_amdgcn_sched_barrier(0);
        const h8 av = __builtin_shufflevector(vl[i % 3], vh[i % 3], 0, 1, 2, 3, 4, 5, 6, 7);
        O[i & 1] = MFMA32(av, pf[i >> 1], O[i & 1]);
        if ((i & 1) == 0 && i < 6) pf[(i >> 1) + 1] = (i < 2) ? pack_step(P0, 1) : pack_step(P1, (i >> 1) - 1);
        __builtin_amdgcn_sched_barrier(0);
    }
#undef NSA_VRD
}
__device__ __forceinline__ float max16(const f32x16& x) {
    float m = fmaxf(fmaxf(fmaxf(x[0], x[1]), fmaxf(x[2], x[3])), fmaxf(fmaxf(x[4], x[5]), fmaxf(x[6], x[7])));
    return fmaxf(m, fmaxf(fmaxf(fmaxf(x[8], x[9]), fmaxf(x[10], x[11])), fmaxf(fmaxf(x[12], x[13]), fmaxf(x[14], x[15]))));
}
__device__ __forceinline__ float sum16(const f32x16& x) {
    return (((x[0] + x[1]) + (x[2] + x[3])) + ((x[4] + x[5]) + (x[6] + x[7]))) + (((x[8] + x[9]) + (x[10] + x[11])) + ((x[12] + x[13]) + (x[14] + x[15])));
}
__device__ __forceinline__ void osm_step(f32x16& S0, f32x16& S1, float& mrun, float& lrun, f32x16 (&O)[2]) {
    float mx = fmaxf(max16(S0), max16(S1)); mx = max_x32(mx);
    const float mn = fmaxf(mrun, mx), alpha = __builtin_amdgcn_exp2f(mrun - mn); mrun = mn;
#pragma unroll
    for (int i = 0; i < 16; ++i) { S0[i] = __builtin_amdgcn_exp2f(S0[i] - mn); S1[i] = __builtin_amdgcn_exp2f(S1[i] - mn); }
    float sm = sum16(S0) + sum16(S1); sm = add_x32(sm);
    lrun = lrun * alpha + sm;
    O[0] = O[0] * alpha; O[1] = O[1] * alpha;
}

__device__ __forceinline__ float max3f(float a, float b, float c) { float r; asm("v_max3_f32 %0, %1, %2, %3" : "=v"(r) : "v"(a), "v"(b), "v"(c)); return r; }
__device__ __forceinline__ float max2f(float a, float b) { float r; asm("v_max_f32_e32 %0, %1, %2" : "=v"(r) : "v"(a), "v"(b)); return r; }
constexpr int SW_SLOTB = 8192, SW_K = 0, SW_V = 3 * SW_SLOTB;
typedef LAS const char* lds_cptr;
__device__ __forceinline__ void sw_glds16(const void* gsrc, unsigned lds_dst) { unsigned keep;
    asm volatile("s_mov_b32 %0, m0\n\ts_mov_b32 m0, %2\n\ts_nop 0\n\tglobal_load_lds_dwordx4 %1, off\n\ts_mov_b32 m0, %0" : "=&s"(keep) : "v"(gsrc), "s"(lds_dst) : "memory"); }
#define SW_WAIT_BAR(N) asm volatile("s_waitcnt vmcnt(" #N ") lgkmcnt(0)\n\ts_barrier" ::: "memory")
#define SW_SBAR() __builtin_amdgcn_sched_barrier(0)
__device__ __forceinline__ float sw_fadd(float a, float b) { float r; asm("v_add_f32_e32 %0, %1, %2" : "=v"(r) : "v"(a), "v"(b)); return r; }
__device__ __forceinline__ float sw_fsub(float a, float b) { float r; asm("v_sub_f32_e32 %0, %1, %2" : "=v"(r) : "v"(a), "v"(b)); return r; }
__device__ __forceinline__ unsigned sw_cvtpk(float lo, float hi) { f32x2 v = {lo, hi}; h2 b = __builtin_convertvector(v, h2); return __builtin_bit_cast(unsigned, b); }
__device__ __forceinline__ void sw_kload8(h8* kf, lds_cptr kp) {
    kf[0] = *(const LAS h8*)(kp);        kf[1] = *(const LAS h8*)(kp + 512);  kf[2] = *(const LAS h8*)(kp + 2048); kf[3] = *(const LAS h8*)(kp + 2560);
    kf[4] = *(const LAS h8*)(kp + 4096); kf[5] = *(const LAS h8*)(kp + 4608); kf[6] = *(const LAS h8*)(kp + 6144); kf[7] = *(const LAS h8*)(kp + 6656); }
__device__ __forceinline__ void sw_kload2(h8* kf, lds_cptr kp, int j) { kf[2 * j] = *(const LAS h8*)(kp + j * 2048); kf[2 * j + 1] = *(const LAS h8*)(kp + j * 2048 + 512); }
__device__ __forceinline__ h4 sw_vtr(lds_cptr p) { return __builtin_bit_cast(h4, __builtin_amdgcn_ds_read_tr16_b64_v4i16((LAS v4i16_t*)p)); }
__device__ __forceinline__ float sw_rowmax(const f32x16& p0, const f32x16& p1) {
    float a = max3f(p0[0], p0[1], p1[0]), b = max3f(p0[2], p0[3], p1[1]); a = max3f(a, p1[2], p1[3]);
#pragma unroll
    for (int r = 4; r < 16; r += 4) { a = max3f(a, p0[r], p0[r + 1]); b = max3f(b, p0[r + 2], p0[r + 3]); a = max3f(a, p1[r], p1[r + 1]); b = max3f(b, p1[r + 2], p1[r + 3]); }
    const float m = max2f(a, b);
    auto rr = __builtin_amdgcn_permlane32_swap(__float_as_uint(m), __float_as_uint(m), false, false);
    return max2f(__uint_as_float(rr[0]), __uint_as_float(rr[1]));
}
template <int MODE> __device__ __forceinline__ void sw_mask(f32x16& p0, f32x16& p1, int t, int c, int NTr, int tq, int hi, unsigned sel_lo, unsigned sel_hi) {
    const float NEG = -INFINITY;
    if (t >= NTr) {
#pragma unroll
        for (int r = 0; r < 16; ++r) { p0[r] = NEG; p1[r] = NEG; }
        return;
    }
    if (MODE == 1) {
        const bool bit = ((t < 32) ? (sel_lo >> t) : (sel_hi >> (t - 32))) & 1u;
        if (t == c) {
#pragma unroll
            for (int r = 0; r < 16; ++r) { const int kk = (r & 3) + 8 * (r >> 2) + 4 * hi; if (!(bit && kk <= tq)) p0[r] = NEG; if (!(bit && kk + 32 <= tq)) p1[r] = NEG; }
        } else if (!__all(bit)) {
#pragma unroll
            for (int r = 0; r < 16; ++r) { if (!bit) { p0[r] = NEG; p1[r] = NEG; } }
        }
    } else {
        if (t == 0) {
#pragma unroll
            for (int r = 0; r < 16; ++r) { const int kk = (r & 3) + 8 * (r >> 2) + 4 * hi; if (kk > tq) p0[r] = NEG; if (kk + 32 > tq) p1[r] = NEG; }
        } else if (t == 8) {
#pragma unroll
            for (int r = 0; r < 16; ++r) { const int kk = (r & 3) + 8 * (r >> 2) + 4 * hi; if (kk <= tq) p0[r] = NEG; if (kk + 32 <= tq) p1[r] = NEG; }
        }
    }
}
template <int MODE, int THRL>
__device__ __forceinline__ void sweep(Frame& F, LAS unsigned char* ring, LAS float* wsf, const f16* Kg, const f16* Vg, int c, int NTr, const h8 (&qr)[4], int tq, unsigned sel_lo, unsigned sel_hi, f32x16 (&o)[2], float (&rli)[16]) {
    const int lane = F.lane, r32 = lane & 31, hi = lane >> 5, wid = F.wave;
    const int NT = (NTr < 4) ? 4 : ((NTr + 1) & ~1);
#define SW_SRC(t) ((MODE == 1) ? (((t) < c) ? (t) : c) : (c - (((t) < NTr) ? (t) : (NTr - 1))))
    const unsigned lds0 = (unsigned)(unsigned long)ring;
    const f16* ksrc = Kg + (size_t)lane * PH_LD + wid * 8;
    const f16* vsrc = Vg + (size_t)(16 * (wid & 3) + (lane >> 2)) * PH_LD + (wid >> 2) * 32 + (lane & 3) * 8;
    const unsigned kdst = lds0 + SW_K + wid * 1024, vdst = lds0 + SW_V + wid * 1024;
#define SW_DMA_K(t, slot) sw_glds16(ksrc + (size_t)SW_SRC(t) * 64 * PH_LD, (unsigned)__builtin_amdgcn_readfirstlane((int)(kdst + (slot))))
#define SW_DMA_V(t, slot) sw_glds16(vsrc + (size_t)SW_SRC(t) * 64 * PH_LD, (unsigned)__builtin_amdgcn_readfirstlane((int)(vdst + (slot))))
    h8 kf[8];
    const lds_cptr shm3 = (lds_cptr)ring; const lds_cptr kp0 = shm3 + SW_K + hi * 1024 + r32 * 16;
    const lds_cptr vp0 = shm3 + SW_V + ((lane >> 4) & 1) * 32 + (lane & 3) * 8 + (4 * hi + ((lane & 15) >> 2)) * 64;
    SW_DMA_K(0, 0); SW_DMA_V(0, 0); SW_DMA_K(1, SW_SLOTB);
    float mhat = 0.f, l_reg = 0.f; o[0] = f32x16{}; o[1] = f32x16{}; f32x16 negm = f32x16{}; asm volatile("" : "+v"(negm));
#define SW_CMASK(P0, P1, t) sw_mask<MODE>(P0, P1, (t), c, NTr, tq, hi, sel_lo, sel_hi)
    bool resc = false;
#define SW_START(P0, P1) do { const float rm = sw_rowmax(P0, P1); resc = false; \
    { const float dl = rm; mhat = sw_fadd(mhat, dl); \
      _Pragma("unroll") for (int r = 0; r < 16; ++r) { P0[r] = sw_fsub(P0[r], dl); P1[r] = sw_fsub(P1[r], dl); } \
      _Pragma("unroll") for (int r = 0; r < 16; ++r) negm[r] = -mhat; asm volatile("" : "+v"(negm)); } \
    _Pragma("unroll") for (int r = 0; r < 16; ++r) P0[r] = __builtin_amdgcn_exp2f(P0[r]); } while (0)
#define SW_RESC() do { if (resc) { asm volatile("s_waitcnt lgkmcnt(0)" ::: "memory"); \
      _Pragma("unroll") for (int d_ = 0; d_ < 2; ++d_) _Pragma("unroll") for (int r = 0; r < 16; ++r) o[d_][r] *= wsf[(r & 3) + 8 * (r >> 2) + 4 * hi]; } } while (0)
    f32x16 pA0, pA1, pB0, pB1;
    int sl_prev = 0, sl_cur = 0, sl_next = SW_SLOTB;
#define SW_ROT() do { sl_prev = sl_cur; sl_cur = sl_next; sl_next = (sl_next == 2 * SW_SLOTB) ? 0 : sl_next + SW_SLOTB; } while (0)
    SW_DMA_K(2, 2 * SW_SLOTB);
    SW_WAIT_BAR(3);
    {
        const lds_cptr kb = kp0;
#pragma unroll
        for (int d0 = 0; d0 < 4; ++d0) {
            const h8 b0 = *(const LAS h8*)(kb + d0 * 2048), b1 = *(const LAS h8*)(kb + d0 * 2048 + 512);
            if (d0 == 0) { pA0 = MFMA32(b0, qr[0], negm); pA1 = MFMA32(b1, qr[0], negm); }
            else { pA0 = MFMA32(b0, qr[d0], pA0); pA1 = MFMA32(b1, qr[d0], pA1); }
        }
    }
    asm volatile("s_nop 15\n\ts_nop 7" : "+v"(pA0), "+v"(pA1)); SW_CMASK(pA0, pA1, 0);
    SW_START(pA0, pA1);
#pragma unroll
    for (int r = 0; r < 16; ++r) pA1[r] = __builtin_amdgcn_exp2f(pA1[r]);
    SW_WAIT_BAR(0);
    SW_DMA_K(3, 0); SW_DMA_V(1, SW_SLOTB);
    SW_ROT();
    sw_kload8(kf, kp0 + sl_cur);
    SW_WAIT_BAR(2);
    h4 vlo[8], vhi[8]; u32x4 pw0, pw1, pw2, pw3;
#define SW_PKW(P, B) sw_cvtpk(P[B], P[B + 1])
#define SW_PAF(k) __builtin_bit_cast(h8, pw##k)
#define SW_VFR(i) (h8){vlo[i][0], vlo[i][1], vlo[i][2], vlo[i][3], vhi[i][0], vhi[i][1], vhi[i][2], vhi[i][3]}
#define SW_PIN(x) asm volatile("" : "+v"(x))
#define SW_MX3(a, b, c_) __builtin_fmaxf(__builtin_fmaxf((a), (b)), (c_))
#define SW_GAPA(MF, A0, A1, A2, A3, W0, W1, PW) do { MF; sacc += A0; sacc += A1; sacc += A2; sacc += A3; SW_PIN(sacc); W0; W1; SW_PIN(PW); SW_SBAR(); } while (0)
#define SW_EX(v) __builtin_amdgcn_exp2f(v)
#define SW_GAPB(MF, X, B) do { MF; X[B] = SW_EX(X[B]); X[B + 1] = SW_EX(X[B + 1]); X[B + 2] = SW_EX(X[B + 2]); X[B + 3] = SW_EX(X[B + 3]); SW_PIN(X); SW_SBAR(); } while (0)
#define SW_VRD(i) do { vlo[i] = sw_vtr(vp_ + (((i) >> 2) * 4096 + ((i) & 3) * 1024)); vhi[i] = sw_vtr(vp_ + (((i) >> 2) * 4096 + ((i) & 3) * 1024 + 512)); } while (0)
#define SW_KRD(G, j) do { if (G) { sw_kload2(kf, kp0 + sl_next, j); SW_SBAR(); } } while (0)
#define SW_STEP(C0, C1, P0, P1, t, GK, GV, GL) do { SW_SBAR(); \
    const lds_cptr vp_ = vp0 + sl_prev; \
    SW_VRD(0); SW_SBAR(); float sacc = (P0[0] + P0[1]); \
    SW_GAPA(C0 = MFMA32(kf[0], qr[0], negm), P0[2], P0[3], P0[4], P0[5],     pw0[0] = SW_PKW(P0, 0), pw0[1] = SW_PKW(P0, 2), pw0); \
    SW_VRD(4); SW_SBAR(); SW_GAPA(C1 = MFMA32(kf[1], qr[0], negm), P0[6], P0[7], P0[8], P0[9],     pw0[2] = SW_PKW(P0, 4), pw0[3] = SW_PKW(P0, 6), pw0); \
    SW_VRD(1); SW_SBAR(); SW_GAPA(C0 = MFMA32(kf[2], qr[1], C0),   P0[10], P0[11], P0[12], P0[13], pw1[0] = SW_PKW(P0, 8), pw1[1] = SW_PKW(P0, 10), pw1); \
    SW_VRD(5); SW_SBAR(); SW_GAPA(C1 = MFMA32(kf[3], qr[1], C1),   P0[14], P0[15], P1[0], P1[1],   pw1[2] = SW_PKW(P0, 12), pw1[3] = SW_PKW(P0, 14), pw1); \
    SW_VRD(2); SW_SBAR(); SW_GAPA(C0 = MFMA32(kf[4], qr[2], C0),   P1[2], P1[3], P1[4], P1[5],     pw2[0] = SW_PKW(P1, 0), pw2[1] = SW_PKW(P1, 2), pw2); \
    SW_VRD(6); SW_SBAR(); SW_GAPA(C1 = MFMA32(kf[5], qr[2], C1),   P1[6], P1[7], P1[8], P1[9],     pw2[2] = SW_PKW(P1, 4), pw2[3] = SW_PKW(P1, 6), pw2); \
    SW_VRD(3); SW_SBAR(); SW_GAPA(C0 = MFMA32(kf[6], qr[3], C0),   P1[10], P1[11], P1[12], P1[13], pw3[0] = SW_PKW(P1, 8), pw3[1] = SW_PKW(P1, 10), pw3); \
    SW_VRD(7); SW_SBAR(); SW_GAPA(C1 = MFMA32(kf[7], qr[3], C1),   P1[14], P1[15], 0.f, 0.f,       pw3[2] = SW_PKW(P1, 12), pw3[3] = SW_PKW(P1, 14), pw3); \
    l_reg += sacc; \
    if (GK) { SW_DMA_K((t) + 3, sl_cur); } if (GV) { SW_DMA_V((t) + 1, sl_next); } \
    SW_CMASK(C0, C1, t); \
    { float a = SW_MX3(C0[0], C0[1], C1[0]), b = SW_MX3(C0[2], C0[3], C1[1]); a = SW_MX3(a, C1[2], C1[3]); \
      _Pragma("unroll") for (int r = 4; r < 16; r += 4) { a = SW_MX3(a, C0[r], C0[r + 1]); b = SW_MX3(b, C0[r + 2], C0[r + 3]); a = SW_MX3(a, C1[r], C1[r + 1]); b = SW_MX3(b, C1[r + 2], C1[r + 3]); } \
      float rm = __builtin_fmaxf(a, b); { auto rr = __builtin_amdgcn_permlane32_swap(__float_as_uint(rm), __float_as_uint(rm), false, false); rm = __builtin_fmaxf(__uint_as_float(rr[0]), __uint_as_float(rr[1])); } \
      resc = false; \
      if (__builtin_expect(__any(rm > (float)THRL), 0)) { const float dl = __builtin_fmaxf(rm, 0.f); mhat += dl; \
        _Pragma("unroll") for (int r = 0; r < 16; ++r) { C0[r] -= dl; C1[r] -= dl; } \
        _Pragma("unroll") for (int r = 0; r < 16; ++r) negm[r] = -mhat; asm volatile("" : "+v"(negm)); \
        const float f = __builtin_amdgcn_exp2f(-dl); l_reg *= f; if (hi == 0) wsf[r32] = f; resc = true; } } \
    SW_SBAR(); \
    SW_GAPB(o[0] = MFMA32(SW_PAF(0), SW_VFR(0), o[0]), C0, 0); \
    SW_GAPB(o[1] = MFMA32(SW_PAF(0), SW_VFR(4), o[1]), C0, 4); \
    SW_KRD(GL, 0); SW_GAPB(o[0] = MFMA32(SW_PAF(1), SW_VFR(1), o[0]), C0, 8); \
    SW_KRD(GL, 1); SW_GAPB(o[1] = MFMA32(SW_PAF(1), SW_VFR(5), o[1]), C0, 12); \
    SW_KRD(GL, 2); SW_GAPB(o[0] = MFMA32(SW_PAF(2), SW_VFR(2), o[0]), C1, 0); \
    SW_KRD(GL, 3); SW_GAPB(o[1] = MFMA32(SW_PAF(2), SW_VFR(6), o[1]), C1, 4); \
    SW_GAPB(o[0] = MFMA32(SW_PAF(3), SW_VFR(3), o[0]), C1, 8); \
    SW_GAPB(o[1] = MFMA32(SW_PAF(3), SW_VFR(7), o[1]), C1, 12); \
    } while (0)
    int t = 1;
#define SW_ENDW(tt) do { if ((tt) + 3 < NT) { SW_WAIT_BAR(2); } else if ((tt) + 2 < NT) { SW_WAIT_BAR(1); } else { SW_WAIT_BAR(0); } } while (0)
    for (; t + 1 < NT; t += 2) {
        SW_STEP(pB0, pB1, pA0, pA1, t, (t + 3 < NT), (t + 1 < NT), (t + 1 < NT));         SW_ENDW(t);     SW_RESC(); SW_ROT();
        SW_STEP(pA0, pA1, pB0, pB1, t + 1, (t + 4 < NT), (t + 2 < NT), (t + 2 < NT));     SW_ENDW(t + 1); SW_RESC(); SW_ROT();
    }
    SW_STEP(pB0, pB1, pA0, pA1, NT - 1, false, false, false); SW_RESC();
    {
        float sacc = pB0[0] + pB0[1];
#pragma unroll
        for (int r = 2; r < 16; ++r) sacc += pB0[r];
#pragma unroll
        for (int r = 0; r < 16; ++r) sacc += pB1[r];
        l_reg += sacc;
        pw0 = (u32x4){SW_PKW(pB0, 0), SW_PKW(pB0, 2), SW_PKW(pB0, 4), SW_PKW(pB0, 6)}; pw1 = (u32x4){SW_PKW(pB0, 8), SW_PKW(pB0, 10), SW_PKW(pB0, 12), SW_PKW(pB0, 14)};
        pw2 = (u32x4){SW_PKW(pB1, 0), SW_PKW(pB1, 2), SW_PKW(pB1, 4), SW_PKW(pB1, 6)}; pw3 = (u32x4){SW_PKW(pB1, 8), SW_PKW(pB1, 10), SW_PKW(pB1, 12), SW_PKW(pB1, 14)};
        SW_SBAR();
        const lds_cptr vq = vp0 + sl_cur;
#pragma unroll
        for (int d0 = 0; d0 < 2; ++d0) {
            h4 lo_[4], hi_[4];
#pragma unroll
            for (int ks = 0; ks < 4; ++ks) { lo_[ks] = sw_vtr(vq + d0 * 4096 + ks * 1024); hi_[ks] = sw_vtr(vq + d0 * 4096 + ks * 1024 + 512); }
#define SW_PK(k) (h8){lo_[k][0], lo_[k][1], lo_[k][2], lo_[k][3], hi_[k][0], hi_[k][1], hi_[k][2], hi_[k][3]}
            o[d0] = MFMA32(SW_PAF(0), SW_PK(0), o[d0]); o[d0] = MFMA32(SW_PAF(1), SW_PK(1), o[d0]); o[d0] = MFMA32(SW_PAF(2), SW_PK(2), o[d0]); o[d0] = MFMA32(SW_PAF(3), SW_PK(3), o[d0]);
#undef SW_PK
        }
    }
    { auto rr = __builtin_amdgcn_permlane32_swap(__float_as_uint(l_reg), __float_as_uint(l_reg), false, false); l_reg = __uint_as_float(rr[0]) + __uint_as_float(rr[1]); }
    if (hi == 0) wsf[32 + r32] = l_reg;
    asm volatile("s_waitcnt lgkmcnt(0)" ::: "memory");
#pragma unroll
    for (int r = 0; r < 16; ++r) rli[r] = __builtin_amdgcn_rcpf(wsf[32 + (r & 3) + 8 * (r >> 2) + 4 * hi]);
    asm volatile("s_waitcnt lgkmcnt(0)\n\ts_barrier" ::: "memory");
#undef SW_SRC
#undef SW_DMA_K
#undef SW_DMA_V
#undef SW_CMASK
#undef SW_START
#undef SW_RESC
#undef SW_ROT
#undef SW_PKW
#undef SW_PAF
#undef SW_VFR
#undef SW_PIN
#undef SW_MX3
#undef SW_GAPA
#undef SW_EX
#undef SW_GAPB
#undef SW_VRD
#undef SW_KRD
#undef SW_STEP
#undef SW_ENDW
}

__device__ __forceinline__ void item(Frame& F, int L, ArgsP a, int b, int c) {
    int lane, w, hf, rho, ql, h, tq, t, m;
    const float* PP; const f16* PH; const float* R; LAS float* impw; LAS unsigned* selm; LAS unsigned char* otw; LAS float* gtw; LAS float* wsf; f16* dst;
#define NSA_SECTION() do { refresh(F); asm volatile("" : "+s"(b), "+s"(c)); lane = F.lane; w = F.wave; hf = lane >> 5; rho = lane & 31; ql = rho >> 2; h = rho & 3; \
        tq = 8 * w + ql; t = 64 * c + tq; m = b * SEQ + t; \
        PP = (const float*)(F.ws + WS_PP); PH = (const f16*)(F.ws + WS_PH); R = (const float*)(F.ws + WS_ROPE); \
        impw = (LAS float*)(F.lds + IMP) + w * 512; selm = (LAS unsigned*)(F.lds + SELM) + w * 16; \
        otw = F.lds + OT + w * (32 * OTS); gtw = (LAS float*)(F.lds + GTAB) + w * 128; wsf = (LAS float*)(F.lds + WSF) + w * 64; \
        dst = (f16*)(F.ws + WS_XA) + (size_t)m * D + 512 + h * 64 + 4 * hf; } while (0)
    NSA_SECTION();
    const int ncv = (t < 31) ? 0 : min(255, ((t - 31) >> 4) + 1);
    const int ncv_max = min(255, 4 * c + 3), nblk_c = (ncv_max + 63) >> 6;
    int it = 0;
    float sq = 0.f;
    for (int g = 0; g < 2; ++g) {
        asm volatile("" : "+s"(g)); NSA_SECTION();
        h8 qh[4], qlw[4];
        {
            const float* qp = PP + (size_t)m * PP_LD + P_CQ + g * 256 + h * 64 + 8 * hf;
            f32x4 xq[8];
#pragma unroll
            for (int s = 0; s < 4; ++s) { xq[2 * s] = *(const f32x4*)(qp + 16 * s); xq[2 * s + 1] = *(const f32x4*)(qp + 16 * s + 4); }
            asm volatile("" : "+v"(xq[0]), "+v"(xq[1]), "+v"(xq[2]), "+v"(xq[3]), "+v"(xq[4]), "+v"(xq[5]), "+v"(xq[6]), "+v"(xq[7]));
#pragma unroll
            for (int s = 0; s < 4; ++s) {
                const f32x4 x0 = xq[2 * s], x1 = xq[2 * s + 1];
                const float xv[8] = {x0[0], x0[1], x0[2], x0[3], x1[0], x1[1], x1[2], x1[3]};
#pragma unroll
                for (int j = 0; j < 8; ++j) { const float xs = xv[j] * CQS; qh[s][j] = (f16)xs; if constexpr (SPLIT) qlw[s][j] = (f16)(xs - (float)qh[s][j]); else qlw[s][j] = (f16)0.f; }
            }
        }
        f32x16 O[2]; float mrun, lrun;
        f32x4 r0, r1, r2, r3;
        mrun = -1e30f; lrun = 0.f;
#pragma unroll
        for (int i = 0; i < 16; ++i) { O[0][i] = 0.f; O[1][i] = 0.f; }
        st_load<0>(F, b, g, 0, 0, 0, r0, r1, r2, r3);
        for (int blk = 0; blk < nblk_c; ++blk, ++it) {
            st_write<0>(F, it & 1, r0, r1, r2, r3);
            __syncthreads();
            if (blk + 1 < nblk_c) st_load<0>(F, b, g, blk + 1, 0, 0, r0, r1, r2, r3);
            f32x16 S0, S1; s_tiles<SPLIT>(F, it & 1, qh, qlw, S0, S1);
            const int lim = ncv - blk * 64 - 4 * hf;
#pragma unroll
            for (int i = 0; i < 16; ++i) { const int kc = (i & 3) + 8 * (i >> 2); S0[i] = (kc < lim) ? S0[i] : -INFINITY; S1[i] = (kc + 32 < lim) ? S1[i] : -INFINITY; }
            float mx = fmaxf(max16(S0), max16(S1)); mx = max_x32(mx) * CSC;
            const float mn = fmaxf(mrun, mx), alpha = __builtin_amdgcn_exp2f(mrun - mn); mrun = mn;
            float sm = 0.f;
#pragma unroll
            for (int i = 0; i < 16; ++i) { sm += __builtin_amdgcn_exp2f(__builtin_fmaf(S0[i], CSC, -mn)); sm += __builtin_amdgcn_exp2f(__builtin_fmaf(S1[i], CSC, -mn)); }
            lrun = lrun * alpha + sm;
        }
        lrun = add_x32(lrun);
        const float inv_lc = (lrun > 0.f) ? 1.f / lrun : 0.f, mfin = mrun;
        NSA_SECTION();
#pragma unroll
        for (int i = 0; i < 8; ++i) impw[lane * 8 + i] = 0.f;
        lds_fence();
        float prev_pc = 0.f;
        st_load<0>(F, b, g, 0, 0, 0, r0, r1, r2, r3);
        for (int blk = 0; blk < nblk_c; ++blk, ++it) {
            st_write<0>(F, it & 1, r0, r1, r2, r3);
            __syncthreads();
            if (blk + 1 < nblk_c) st_load<0>(F, b, g, blk + 1, 0, 0, r0, r1, r2, r3);
            f32x16 S0, S1; s_tiles<SPLIT>(F, it & 1, qh, qlw, S0, S1);
#pragma unroll
            for (int i = 0; i < 16; ++i) { const int n0 = blk * 64 + crow(i, hf);
                S0[i] = (n0 < ncv) ? __builtin_amdgcn_exp2f(S0[i] * CSC - mfin) * inv_lc : 0.f; S1[i] = (n0 + 32 < ncv) ? __builtin_amdgcn_exp2f(S1[i] * CSC - mfin) * inv_lc : 0.f; }
            pv_tiles(F, it & 1, S0, S1, O);
#pragma unroll
            for (int u = 0; u < 2; ++u)
#pragma unroll
                for (int r4 = 0; r4 < 4; ++r4) {
                    const float p0 = u ? S1[4 * r4] : S0[4 * r4], p1 = u ? S1[4 * r4 + 1] : S0[4 * r4 + 1], p2 = u ? S1[4 * r4 + 2] : S0[4 * r4 + 2], p3 = u ? S1[4 * r4 + 3] : S0[4 * r4 + 3];
                    float av = (p0 + p1 + p2) + 0.5f * p3, cvv = 0.5f * p3;
                    av += dpp_f<0xB1>(av); av += dpp_f<0x4E>(av); cvv += dpp_f<0xB1>(cvv); cvv += dpp_f<0x4E>(cvv);
                    const float pc = partner_x32(cvv, hf);
                    const float add = hf ? pc : prev_pc; prev_pc = pc;
                    const int mb = 16 * blk + 8 * u + 2 * r4 + hf;
                    if (h == 0) impw[ql * 64 + mb] = av + add;
                }
        }
        {
            const f16* gp = PH + (size_t)m * PH_LD + H_GATE + g * 12 + h * 3;
            const float g0 = (float)gp[0];
            if (hf == 0) *(LAS f32x4*)(gtw + rho * 4) = (f32x4){g0, (float)gp[1], (float)gp[2], 0.f};
#pragma unroll
            for (int cd = 0; cd < 2; ++cd)
#pragma unroll
                for (int r4 = 0; r4 < 4; ++r4) *(LAS f32x4*)(otw + rho * OTS + (32 * cd + 8 * r4 + 4 * hf) * 4) = (f32x4){O[cd][4 * r4] * g0, O[cd][4 * r4 + 1] * g0, O[cd][4 * r4 + 2] * g0, O[cd][4 * r4 + 3] * g0};
        }
        NSA_SECTION();
        unsigned sel_lo, sel_hi;
        if (c < 16) { sel_lo = (2u << c) - 1u; sel_hi = 0u; }
        else {
            lds_fence();
            const int q8 = lane >> 3, mg = lane & 7;
            unsigned long long mk[8];
            {
                const f32x4 v0 = *(const LAS f32x4*)(impw + q8 * 64 + mg * 8), v1 = *(const LAS f32x4*)(impw + q8 * 64 + mg * 8 + 4);
                const float myv[8] = {v0[0], v0[1], v0[2], v0[3], v1[0], v1[1], v1[2], v1[3]};
                unsigned k32[8];
#pragma unroll
                for (int i = 0; i < 8; ++i) { const int mb = mg * 8 + i;
                    k32[i] = (mb > c) ? 0u : ((mb == 0 || mb == c || mb == c - 1) ? __float_as_uint(1e9f) + 1u : __float_as_uint(fmaxf(myv[i], 0.f)) + 1u);
                    mk[i] = ((unsigned long long)k32[i] << 6) | (unsigned)(63 - mb); }
                *(LAS u32x4*)(impw + q8 * 64 + mg * 8) = (u32x4){k32[0], k32[1], k32[2], k32[3]}; *(LAS u32x4*)(impw + q8 * 64 + mg * 8 + 4) = (u32x4){k32[4], k32[5], k32[6], k32[7]};
            }
            lds_fence();
            int rank[8];
#pragma unroll
            for (int i = 0; i < 8; ++i) rank[i] = 0;
            for (int j4 = 0; j4 < 16; ++j4) {
                const u32x4 o4 = *(const LAS u32x4*)(impw + q8 * 64 + j4 * 4);
#pragma unroll
                for (int e = 0; e < 4; ++e) { const unsigned long long ko = ((unsigned long long)o4[e] << 6) | (unsigned)(63 - (j4 * 4 + e));
#pragma unroll
                    for (int i = 0; i < 8; ++i) rank[i] += (ko > mk[i]) ? 1 : 0; }
            }
            unsigned bits = 0u;
#pragma unroll
            for (int i = 0; i < 8; ++i) bits |= (rank[i] < 16) ? (1u << i) : 0u;
            unsigned lo = (mg < 4) ? (bits << (8 * mg)) : 0u, hi = (mg >= 4) ? (bits << (8 * (mg - 4))) : 0u;
            lo |= __shfl_xor(lo, 1); lo |= __shfl_xor(lo, 2); lo |= __shfl_xor(lo, 4);
            hi |= __shfl_xor(hi, 1); hi |= __shfl_xor(hi, 2); hi |= __shfl_xor(hi, 4);
            if (mg == 0) { selm[q8 * 2] = lo; selm[q8 * 2 + 1] = hi; }
            lds_fence();
            sel_lo = selm[ql * 2]; sel_hi = selm[ql * 2 + 1];
            lds_fence();
        }
        NSA_SECTION();
        h8 qr[4];
        {
            const float* qp = PP + (size_t)m * PP_LD + P_CQ + g * 256 + h * 64 + 8 * hf;
            f32x4 xq[8];
#pragma unroll
            for (int s = 0; s < 4; ++s) { xq[2 * s] = *(const f32x4*)(qp + 16 * s); xq[2 * s + 1] = *(const f32x4*)(qp + 16 * s + 4); }
            const f32x4 c0 = *(const f32x4*)(R + (size_t)m * 8), c1 = *(const f32x4*)(R + (size_t)m * 8 + 4);
            const f32x4 s0 = *(const f32x4*)(R + (size_t)M * 8 + (size_t)m * 8), s1 = *(const f32x4*)(R + (size_t)M * 8 + (size_t)m * 8 + 4);
            asm volatile("" : "+v"(xq[0]), "+v"(xq[1]), "+v"(xq[2]), "+v"(xq[3]), "+v"(xq[4]), "+v"(xq[5]), "+v"(xq[6]), "+v"(xq[7]));
#pragma unroll
            for (int s = 0; s < 4; ++s) {
                const f32x4 x0 = xq[2 * s], x1 = xq[2 * s + 1];
                float xv[8] = {x0[0], x0[1], x0[2], x0[3], x1[0], x1[1], x1[2], x1[3]};
                if (s == 0) {
                    const float cs[8] = {c0[0], c0[1], c0[2], c0[3], c1[0], c1[1], c1[2], c1[3]}, sn[8] = {s0[0], s0[1], s0[2], s0[3], s1[0], s1[1], s1[2], s1[3]};
#pragma unroll
                    for (int j = 0; j < 8; ++j) { const float other = partner_x32(xv[j], hf); xv[j] = hf ? (xv[j] * cs[j] + other * sn[j]) : (xv[j] * cs[j] - other * sn[j]); }
                }
#pragma unroll
                for (int j = 0; j < 8; ++j) qr[s][j] = (f16)(xv[j] * QSC);
            }
        }
        lds_fence();
        __syncthreads();
        NSA_SECTION();
        {
            f32x16 os[2]; float rli[16];
            sweep<1, 8>(F, F.lds, wsf, PH + (size_t)(b * SEQ) * PH_LD + H_KS + g * 64, PH + (size_t)(b * SEQ) * PH_LD + H_VS + g * 64, c, c + 1, qr, tq, sel_lo, sel_hi, os, rli);
#pragma unroll
            for (int r = 0; r < 16; ++r) { const int row = (r & 3) + 8 * (r >> 2) + 4 * hf; const float gs = gtw[row * 4 + 1] * rli[r];
#pragma unroll
                for (int d0 = 0; d0 < 2; ++d0) { LAS float* p = (LAS float*)(otw + row * OTS) + 32 * d0 + rho; *p += os[d0][r] * gs; } }
            lds_fence();
            NSA_SECTION();
            sweep<2, 8>(F, F.lds, wsf, PH + (size_t)(b * SEQ) * PH_LD + H_KW + g * 64, PH + (size_t)(b * SEQ) * PH_LD + H_VW + g * 64, c, (c >= 8) ? 9 : c + 1, qr, tq, 0u, 0u, os, rli);
#pragma unroll
            for (int r = 0; r < 16; ++r) { const int row = (r & 3) + 8 * (r >> 2) + 4 * hf; const float gs = gtw[row * 4 + 2] * rli[r];
#pragma unroll
                for (int d0 = 0; d0 < 2; ++d0) { LAS float* p = (LAS float*)(otw + row * OTS) + 32 * d0 + rho; *p += os[d0][r] * gs; } }
            lds_fence();
        }
        NSA_SECTION();
#pragma unroll
        for (int cd = 0; cd < 2; ++cd)
#pragma unroll
            for (int r4 = 0; r4 < 4; ++r4) { const f32x4 v = *(const LAS f32x4*)(otw + rho * OTS + (32 * cd + 8 * r4 + 4 * hf) * 4);
                h4 o; o[0] = (f16)v[0]; o[1] = (f16)v[1]; o[2] = (f16)v[2]; o[3] = (f16)v[3];
                sq += ((float)o[0] * (float)o[0] + (float)o[1] * (float)o[1]) + ((float)o[2] * (float)o[2] + (float)o[3] * (float)o[3]);
                *(u32x2*)(dst + g * 256 + 32 * cd + 8 * r4) = __builtin_bit_cast(u32x2, o); }
        lds_fence();
    }
    NSA_SECTION();
    sq += dpp_f<0xB1>(sq); sq += dpp_f<0x4E>(sq); sq = add_x32(sq);
    const float rn = rsqrtf(sq * (1.f / 512.f) + EPS);
    const float* gc = gin(a, 25) + L * 512 + h * 64 + 4 * hf;
    dst = launder_g(dst); gc = launder_g(gc);
#pragma unroll
    for (int g = 0; g < 2; ++g)
#pragma unroll
        for (int cd = 0; cd < 2; ++cd)
#pragma unroll
            for (int r4 = 0; r4 < 4; ++r4) {
                const int col = g * 256 + 32 * cd + 8 * r4;
                const h4 v = __builtin_bit_cast(h4, *(const u32x2*)(dst + col)); const f32x4 gn = *(const f32x4*)(gc + col);
                h4 o; o[0] = (f16)((float)v[0] * rn * gn[0]); o[1] = (f16)((float)v[1] * rn * gn[1]); o[2] = (f16)((float)v[2] * rn * gn[2]); o[3] = (f16)((float)v[3] * rn * gn[3]);
                *(u32x2*)(dst + col) = __builtin_bit_cast(u32x2, o);
            }
    __syncthreads();
#undef NSA_SECTION
}
}

__device__ __forceinline__ float dpp_xor1(float v) { return __builtin_bit_cast(float, __builtin_amdgcn_mov_dpp(__builtin_bit_cast(int, v), 0xB1, 0xF, 0xF, true)); }
__device__ __forceinline__ float dpp_xor2(float v) { return __builtin_bit_cast(float, __builtin_amdgcn_mov_dpp(__builtin_bit_cast(int, v), 0x4E, 0xF, 0xF, true)); }
namespace dsa {
constexpr int KBUF = 16384;
constexpr int KRS = 304, VRS = 320, KTB = 64 * KRS, VTB = 64 * VRS;
constexpr int KT = 0, VT = 2 * KTB, SSQ = VT + 2 * VTB, LDS_END = SSQ + 1024;
static_assert(8 * KBUF + 8 * 1024 <= LDS_BYTES - 16 && LDS_END <= LDS_BYTES, "dsa LDS map");
constexpr float QSC = 0.125f * 1.4426950408889634f;

__device__ __forceinline__ unsigned row_or(unsigned v) { v |= (unsigned)__builtin_amdgcn_mov_dpp((int)v, 0xB1, 0xF, 0xF, true); v |= (unsigned)__builtin_amdgcn_mov_dpp((int)v, 0x4E, 0xF, 0xF, true);
    v |= (unsigned)__builtin_amdgcn_mov_dpp((int)v, 0x141, 0xF, 0xF, true); v |= (unsigned)__builtin_amdgcn_mov_dpp((int)v, 0x140, 0xF, 0xF, true); return v; }
__device__ __forceinline__ unsigned row_add(unsigned v) { v += (unsigned)__builtin_amdgcn_mov_dpp((int)v, 0xB1, 0xF, 0xF, true); v += (unsigned)__builtin_amdgcn_mov_dpp((int)v, 0x4E, 0xF, 0xF, true);
    v += (unsigned)__builtin_amdgcn_mov_dpp((int)v, 0x141, 0xF, 0xF, true); v += (unsigned)__builtin_amdgcn_mov_dpp((int)v, 0x140, 0xF, 0xF, true); return v; }
__device__ __forceinline__ unsigned wave_add_u(unsigned v) { v = row_add(v);
    return (unsigned)(__builtin_amdgcn_readlane((int)v, 0) + __builtin_amdgcn_readlane((int)v, 16)) + (unsigned)(__builtin_amdgcn_readlane((int)v, 32) + __builtin_amdgcn_readlane((int)v, 48)); }
__device__ __forceinline__ unsigned wave_max_u(unsigned v) {
    v = max(v, (unsigned)__builtin_amdgcn_mov_dpp((int)v, 0xB1, 0xF, 0xF, true)); v = max(v, (unsigned)__builtin_amdgcn_mov_dpp((int)v, 0x4E, 0xF, 0xF, true));
    v = max(v, (unsigned)__builtin_amdgcn_mov_dpp((int)v, 0x141, 0xF, 0xF, true)); v = max(v, (unsigned)__builtin_amdgcn_mov_dpp((int)v, 0x140, 0xF, 0xF, true));
    return max(max((unsigned)__builtin_amdgcn_readlane((int)v, 0), (unsigned)__builtin_amdgcn_readlane((int)v, 16)), max((unsigned)__builtin_amdgcn_readlane((int)v, 32), (unsigned)__builtin_amdgcn_readlane((int)v, 48))); }
__device__ __forceinline__ unsigned wave_min_u(unsigned v) { return ~wave_max_u(~v); }
__device__ __forceinline__ unsigned wave_or_u(unsigned v) { v = row_or(v);
    return (unsigned)(__builtin_amdgcn_readlane((int)v, 0) | __builtin_amdgcn_readlane((int)v, 16)) | (unsigned)(__builtin_amdgcn_readlane((int)v, 32) | __builtin_amdgcn_readlane((int)v, 48)); }

struct P1Ops { h8 bh[2], bl[2]; float wv[4][4]; h8 ah0, ah1, al0, al1; };
__device__ __forceinline__ void pass1_load(const Frame& F, int b, int t0, P1Ops& o) {
    const int lane = F.lane, w = F.wave, hf = lane >> 5, rho = lane & 31, q = rho >> 2, h = rho & 3;
    const float* PP = (const float*)(F.ws + WS_PP);
    const f16* qp = (const f16*)(PP + (size_t)(b * SEQ + t0 + q) * PP_LD + P_IQS) + h * 32 + 8 * hf;
    o.bh[0] = *(const h8*)qp; o.bh[1] = *(const h8*)(qp + 16); if constexpr (SPLIT) { o.bl[0] = *(const h8*)(qp + 128); o.bl[1] = *(const h8*)(qp + 144); }
#pragma unroll
    for (int r4 = 0; r4 < 4; ++r4) {
        const f32x4 w4 = *(const f32x4*)(PP + (size_t)(b * SEQ + t0 + 2 * r4 + hf) * PP_LD + P_IW);
#pragma unroll
        for (int e = 0; e < 4; ++e) o.wv[r4][e] = w4[e] * (0.17677669529663687f / (ISC * ISC));
    }
    const int ntiles = 2 * (((t0 + 7) >> 6) + 1);
    const f16* kp = (const f16*)(F.ws + WS_IKT) + ((size_t)(b * 128 + min(w, ntiles - 1)) * 256 + lane) * 8;
    o.ah0 = *(const h8*)kp; o.ah1 = *(const h8*)(kp + 512); if constexpr (SPLIT) { o.al0 = *(const h8*)(kp + 1024); o.al1 = *(const h8*)(kp + 1536); }
}
__device__ __forceinline__ void pass1_round(Frame& F, int b, int t0, P1Ops& ops, bool has_next) {
    const int lane = F.lane, w = F.wave, hf = lane >> 5, rho = lane & 31;
    const float* PP = (const float*)(F.ws + WS_PP);
    h8 bh[2] = {ops.bh[0], ops.bh[1]}, bl[2] = {ops.bl[0], ops.bl[1]};
    float wv[4][4];
#pragma unroll
    for (int r4 = 0; r4 < 4; ++r4)
#pragma unroll
        for (int e = 0; e < 4; ++e) wv[r4][e] = ops.wv[r4][e];
    const int ntiles = 2 * (((t0 + 7) >> 6) + 1);
    const f16* kp0 = (const f16*)(F.ws + WS_IKT) + ((size_t)(b * 128) * 256 + lane) * 8;
    const size_t tstride = (size_t)256 * 8;
    h8 ah0 = ops.ah0, ah1 = ops.ah1, al0 = ops.al0, al1 = ops.al1, nh0, nh1, nl0, nl1;
    for (int tt = w; tt < ntiles; tt += NWAVES) {
        { const f16* kp = kp0 + (size_t)min(tt + NWAVES, ntiles - 1) * tstride; nh0 = *(const h8*)kp; nh1 = *(const h8*)(kp + 512); if constexpr (SPLIT) { nl0 = *(const h8*)(kp + 1024); nl1 = *(const h8*)(kp + 1536); } }
        f32x16 S;
#pragma unroll
        for (int i = 0; i < 16; ++i) S[i] = 0.f;
        S = MFMA32(bh[0], ah0, S); S = MFMA32(bh[1], ah1, S);
        if constexpr (SPLIT) { S = MFMA32(bl[0], ah0, S); S = MFMA32(bh[0], al0, S); S = MFMA32(bl[1], ah1, S); S = MFMA32(bh[1], al1, S); }
        const int kidx = 32 * tt + rho;
#pragma unroll
        for (int r4 = 0; r4 < 4; ++r4) {
            float r = (fmaxf(S[4 * r4], 0.f) * wv[r4][0] + fmaxf(S[4 * r4 + 1], 0.f) * wv[r4][1]) + (fmaxf(S[4 * r4 + 2], 0.f) * wv[r4][2] + fmaxf(S[4 * r4 + 3], 0.f) * wv[r4][3]);
            const int qq = 2 * r4 + hf;
            ((LAS unsigned*)(F.lds + qq * KBUF))[kidx] = (kidx <= t0 + qq) ? mono_key(r) : 0u;
        }
        ah0 = nh0; ah1 = nh1; if constexpr (SPLIT) { al0 = nl0; al1 = nl1; }
    }
    __syncthreads();
    if (has_next) pass1_load(F, b, t0 + 8, ops);
    {
        const int t = t0 + w, nsteps = (t >> 6) + 1;
        LAS unsigned* kbuf = (LAS unsigned*)(F.lds + w * KBUF);
        LAS unsigned* hist = (LAS unsigned*)(F.lds + 8 * KBUF + w * 1024);
        unsigned kreg[64];
#pragma unroll
        for (int j8 = 0; j8 < 8; ++j8) {
            if (j8 * 8 < nsteps) {
#pragma unroll
                for (int j = j8 * 8; j < j8 * 8 + 8; ++j) { const unsigned kv_ = kbuf[j * 64 + lane]; kreg[j] = (j < nsteps) ? kv_ : 0u; }
            } else {
#pragma unroll
                for (int j = j8 * 8; j < j8 * 8 + 8; ++j) kreg[j] = 0u;
            }
        }
#define KLOOP(...) _Pragma("unroll") for (int j8 = 0; j8 < 8; ++j8) if (j8 * 8 < nsteps) { _Pragma("unroll") for (int j = j8 * 8; j < j8 * 8 + 8; ++j) { const unsigned k = kreg[j]; __VA_ARGS__ } }
        unsigned T = 0u; int scut = 4095;
        if (t >= 256) {
            constexpr int D1 = 11, BPL = (1 << D1) / 64;
            unsigned kmx = 0u, kmn1 = ~0u;
            KLOOP(kmx = max(kmx, k); kmn1 = min(kmn1, k - 1u);)
            kmx = wave_max_u(kmx); const unsigned kmn = wave_min_u(kmn1) + 1u;
            const unsigned range = kmx - kmn;
            unsigned above = 0u, ceq = 0u;
            if (range == 0u) T = kmn;
            else {
                const int msb = 31 - __builtin_clz(range), shift = (msb + 1 > D1) ? msb + 1 - D1 : 0;
                {
                    LAS u32x4* hz = (LAS u32x4*)(kbuf + BPL * lane);
#pragma unroll
                    for (int i = 0; i < BPL / 4; ++i) hz[i] = (u32x4){0u, 0u, 0u, 0u};
                }
                KLOOP(if (j < nsteps) { const unsigned d = __builtin_elementwise_sub_sat(k, kmn); __hip_atomic_fetch_add(kbuf + (d >> shift), 1u, __ATOMIC_RELAXED, __HIP_MEMORY_SCOPE_WORKGROUP); })
                lds_fence();
                unsigned h[BPL];
                {
                    const LAS u32x4* hr = (const LAS u32x4*)(kbuf + BPL * lane);
#pragma unroll
                    for (int i = 0; i < BPL / 4; ++i) { const u32x4 v = hr[i]; h[4 * i] = v[0]; h[4 * i + 1] = v[1]; h[4 * i + 2] = v[2]; h[4 * i + 3] = v[3]; }
                }
                if (lane == 0) h[0] -= (unsigned)(64 * nsteps - (t + 1));
                unsigned s4 = 0u;
#pragma unroll
                for (int i = 0; i < BPL; ++i) s4 += h[i];
                unsigned ps = s4;
                ps += (unsigned)__builtin_amdgcn_update_dpp(0, (int)ps, 0x111, 0xF, 0xF, true);
                ps += (unsigned)__builtin_amdgcn_update_dpp(0, (int)ps, 0x112, 0xF, 0xF, true);
                ps += (unsigned)__builtin_amdgcn_update_dpp(0, (int)ps, 0x114, 0xF, 0xF, true);
                ps += (unsigned)__builtin_amdgcn_update_dpp(0, (int)ps, 0x118, 0xF, 0xF, true);
                const unsigned r0t = (unsigned)__builtin_amdgcn_readlane((int)ps, 15), r1t = (unsigned)__builtin_amdgcn_readlane((int)ps, 31), r2t = (unsigned)__builtin_amdgcn_readlane((int)ps, 47), r3t = (unsigned)__builtin_amdgcn_readlane((int)ps, 63);
                ps += (lane >= 16 ? r0t : 0u) + (lane >= 32 ? r1t : 0u) + (lane >= 48 ? r2t : 0u);
                const unsigned total = (r0t + r1t) + (r2t + r3t);
                const unsigned sfx = total - ps;
                const bool mine = (sfx < 256u) && (sfx + s4 >= 256u);
                unsigned bsel = 0u, ab2 = 0u, cq = 0u;
                {
                    unsigned acc_ = sfx; bool found = false;
#pragma unroll
                    for (int i = BPL - 1; i >= 0; --i) { const bool hit = !found && (acc_ + h[i] >= 256u); if (hit) { bsel = (unsigned)i; ab2 = acc_; cq = h[i]; } found = found || hit; acc_ += h[i]; }
                    bsel += (unsigned)(BPL * lane);
                }
                const unsigned long long mm = __ballot(mine);
                const int src = __builtin_ctzll(mm);
                const unsigned b1 = (unsigned)__builtin_amdgcn_readlane((int)bsel, src); above = (unsigned)__builtin_amdgcn_readlane((int)ab2, src); ceq = (unsigned)__builtin_amdgcn_readlane((int)cq, src);
                const unsigned klo = kmn + (b1 << shift);
                unsigned Td = 0u;
                int rem = shift;
                if (rem > 0) {
                    const unsigned width = 1u << shift;
                    LAS unsigned* wp = kbuf + lane;
                    KLOOP(const unsigned d = k - klo; *wp = d; wp += (d < width) ? 64 : 0;)
                    const unsigned cnt = (unsigned)(wp - (kbuf + lane)) >> 6;
                    const int mcnt = (int)wave_max_u(cnt);
                    while (rem > 0) {
                        const int wd = (rem < 8) ? rem : 8, sh = rem - wd;
                        *(LAS u32x4*)(hist + 4 * lane) = (u32x4){0u, 0u, 0u, 0u};
                        lds_fence();
                        const unsigned pref = Td >> rem;
                        const unsigned dmask = (1u << wd) - 1u;
                        for (int i = 0; i < mcnt; ++i) {
                            const unsigned d = kbuf[i * 64 + lane];
                            if ((unsigned)i < cnt && (d >> rem) == pref) __hip_atomic_fetch_add(hist + ((d >> sh) & dmask), 1u, __ATOMIC_RELAXED, __HIP_MEMORY_SCOPE_WORKGROUP);
                        }
                        lds_fence();
                        const u32x4 h4 = *(const LAS u32x4*)(hist + 4 * lane);
                        const unsigned q4 = (h4[0] + h4[1]) + (h4[2] + h4[3]);
                        unsigned p2 = q4;
                        p2 += (unsigned)__builtin_amdgcn_update_dpp(0, (int)p2, 0x111, 0xF, 0xF, true);
                        p2 += (unsigned)__builtin_amdgcn_update_dpp(0, (int)p2, 0x112, 0xF, 0xF, true);
                        p2 += (unsigned)__builtin_amdgcn_update_dpp(0, (int)p2, 0x114, 0xF, 0xF, true);
                        p2 += (unsigned)__builtin_amdgcn_update_dpp(0, (int)p2, 0x118, 0xF, 0xF, true);
                        const unsigned u0 = (unsigned)__builtin_amdgcn_readlane((int)p2, 15), u1 = (unsigned)__builtin_amdgcn_readlane((int)p2, 31), u2 = (unsigned)__builtin_amdgcn_readlane((int)p2, 47), u3 = (unsigned)__builtin_amdgcn_readlane((int)p2, 63);
                        p2 += (lane >= 16 ? u0 : 0u) + (lane >= 32 ? u1 : 0u) + (lane >= 48 ? u2 : 0u);
                        const unsigned tot2 = (u0 + u1) + (u2 + u3);
                        const unsigned sfx2 = above + (tot2 - p2);
                        const bool mine2 = (sfx2 < 256u) && (sfx2 + q4 >= 256u);
                        unsigned bs2 = 0u, ab3 = 0u, cq2 = 0u;
                        if (mine2) {
                            unsigned acc_ = sfx2;
                            if (acc_ + h4[3] >= 256u) { bs2 = 3u; ab3 = acc_; cq2 = h4[3]; }
                            else { acc_ += h4[3];
                                if (acc_ + h4[2] >= 256u) { bs2 = 2u; ab3 = acc_; cq2 = h4[2]; }
                                else { acc_ += h4[2];
                                    if (acc_ + h4[1] >= 256u) { bs2 = 1u; ab3 = acc_; cq2 = h4[1]; }
                                    else { acc_ += h4[1]; bs2 = 0u; ab3 = acc_; cq2 = h4[0]; } } }
                            bs2 += 4u * (unsigned)lane;
                        }
                        const unsigned long long mm2 = __ballot(mine2);
                        const int src2 = __builtin_ctzll(mm2);
                        bs2 = (unsigned)__builtin_amdgcn_readlane((int)bs2, src2); above = (unsigned)__builtin_amdgcn_readlane((int)ab3, src2); ceq = (unsigned)__builtin_amdgcn_readlane((int)cq2, src2);
                        Td |= bs2 << sh;
                        rem = sh;
                    }
                }
                T = klo + Td;
            }
            if (range == 0u) {
                unsigned ce = 0u;
                KLOOP(ce += (k == T) ? 1u : 0u;)
                ceq = wave_add_u(ce); above = 0u;
            }
            const int need = 256 - (int)above;
            if ((int)ceq > need) {
                int accn = 0, jS = -1, kS = 0; unsigned long long emS = 0ull;
                KLOOP(const unsigned long long em = __ballot(k == T); const int c = __popcll(em); if (jS < 0 && accn + c >= need) { jS = j; emS = em; kS = need - accn; } accn += c;)
                if (jS >= 0) { while (kS > 1) { emS &= emS - 1ull; --kS; } scut = jS * 64 + __builtin_ctzll(emS); }
            }
        }
        unsigned* bm = (unsigned*)(F.ws + WS_BM) + (size_t)(b * SEQ + t) * 128;
        int mlo = 0, mhi = 0;
        const unsigned Tm = (T == 0u) ? 1u : T; const bool cut = (scut != 4095);
#define DSA_BMW(sm_) asm("s_nop 1\n\tv_writelane_b32 %0, %2, %4\n\tv_writelane_b32 %1, %3, %4" : "+v"(mlo), "+v"(mhi) : "s"((int)(unsigned)(sm_)), "s"((int)(unsigned)((sm_) >> 32)), "n"(j))
        if (!cut) { KLOOP(const unsigned long long sm = __ballot(k >= Tm); DSA_BMW(sm);) }
        else { KLOOP(const unsigned long long sm = __ballot(k > T || (k == T && T != 0u && (j * 64 + lane) <= scut)); DSA_BMW(sm);) }
#undef DSA_BMW
        if (lane < nsteps) *(u32x2*)(bm + 2 * lane) = (u32x2){(unsigned)mlo, (unsigned)mhi};
#undef KLOOP
    }
    __syncthreads();
}

__device__ __forceinline__ void pass2(Frame& F, int L, ArgsP a, int b, int c) {
    const int lane = F.lane, w = F.wave, hf = lane >> 5, rho = lane & 31, hd = w & 3, qh = w >> 2;
    const int tq = 32 * qh + rho, t = 64 * c + tq, m = b * SEQ + t;
    const f16* PH = (const f16*)(F.ws + WS_PH);
    h8 qf[9];
    {
        const f16* qp = PH + (size_t)m * PH_LD + H_QA + hd * 144 + 8 * hf;
        h8 qv[9];
#pragma unroll
        for (int s = 0; s < 9; ++s) qv[s] = *(const h8*)(qp + 16 * s);
        asm volatile("" : "+v"(qv[0]), "+v"(qv[1]), "+v"(qv[2]), "+v"(qv[3]), "+v"(qv[4]), "+v"(qv[5]), "+v"(qv[6]), "+v"(qv[7]), "+v"(qv[8]));
#pragma unroll
        for (int s = 0; s < 9; ++s) { const h8 v = qv[s];
#pragma unroll
            for (int j = 0; j < 8; ++j) qf[s][j] = (f16)((float)v[j] * QSC); }
    }
    f32x16 O[4]; float mrun = -1e30f, lrun = 0.f;
#pragma unroll
    for (int d = 0; d < 4; ++d)
#pragma unroll
        for (int i = 0; i < 16; ++i) O[d][i] = 0.f;
    const unsigned* bm = (const unsigned*)(F.ws + WS_BM) + (size_t)m * 128;
    const int srow = F.tid >> 3, sj = F.tid & 7;
    const f16* kb = PH + (size_t)(b * SEQ + srow) * PH_LD + H_KA + sj * 8;
    LAS unsigned char* kdst = F.lds + KT + srow * KRS + sj * 16; LAS unsigned char* vdst = F.lds + VT + srow * VRS + sj * 16;
    f32x4 r0, r1, r2;
#define DSA_LOAD(blk) do { const f16* kbb = kb + (size_t)((blk) * 64) * PH_LD; r0 = *(const f32x4*)kbb; r1 = *(const f32x4*)(kbb + 64); if (sj < 2) r2 = *(const f32x4*)(kbb + 128); } while (0)
#define DSA_WRITE(buf) do { LAS unsigned char* kd_ = kdst + (buf) * KTB; LAS unsigned char* vd_ = vdst + (buf) * VTB; \
        *(LAS f32x4*)kd_ = r0; *(LAS f32x4*)(kd_ + 128) = r1; if (sj < 2) *(LAS f32x4*)(kd_ + 256) = r2; *(LAS f32x4*)vd_ = r0; *(LAS f32x4*)(vd_ + 128) = r1; } while (0)
    DSA_LOAD(0);
    u32x2 mw = __builtin_nontemporal_load((const u32x2*)bm);
    for (int blk = 0; blk <= c; ++blk) {
        const int buf = blk & 1;
        DSA_WRITE(buf);
        __syncthreads();
        const u32x2 mcur = mw;
        if (blk + 1 <= c) { DSA_LOAD(blk + 1); mw = __builtin_nontemporal_load((const u32x2*)(bm + 2 * (blk + 1))); }
        f32x16 S0, S1;
#pragma unroll
        for (int i = 0; i < 16; ++i) { S0[i] = 0.f; S1[i] = 0.f; }
        {
            LAS const unsigned char* k0 = F.lds + KT + buf * KTB + rho * KRS + hf * 16;
            h8 ka0[3], ka1[3];
            ka0[0] = *(const LAS h8*)(k0); ka1[0] = *(const LAS h8*)(k0 + 32 * KRS); ka0[1] = *(const LAS h8*)(k0 + 32); ka1[1] = *(const LAS h8*)(k0 + 32 * KRS + 32);
            __builtin_amdgcn_sched_barrier(0);
#pragma unroll
            for (int s = 0; s < 9; ++s) {
                if (s + 2 < 9) { ka0[(s + 2) % 3] = *(const LAS h8*)(k0 + (s + 2) * 32); ka1[(s + 2) % 3] = *(const LAS h8*)(k0 + 32 * KRS + (s + 2) * 32); }
                __builtin_amdgcn_sched_barrier(0);
                S0 = MFMA32(ka0[s % 3], qf[s], S0); S1 = MFMA32(ka1[s % 3], qf[s], S1);
                __builtin_amdgcn_sched_barrier(0);
            }
        }
        {
            const unsigned m0 = mcur[0] >> (4 * hf), m1 = mcur[1] >> (4 * hf);
            const float ninf = -INFINITY;
            asm volatile("s_nop 15\n\ts_nop 7" : "+v"(S0), "+v"(S1));
#pragma unroll
            for (int i = 0; i < 16; ++i) {
                int k0, k1; float s0 = S0[i], s1 = S1[i];
                asm("v_bfe_i32 %0, %1, %2, 1" : "=v"(k0) : "v"(m0), "n"((i & 3) + 8 * (i >> 2)));
                asm("v_bfe_i32 %0, %1, %2, 1" : "=v"(k1) : "v"(m1), "n"((i & 3) + 8 * (i >> 2)));
                asm("v_bfi_b32 %0, %1, %2, %3" : "=v"(s0) : "v"(k0), "v"(s0), "v"(ninf));
                asm("v_bfi_b32 %0, %1, %2, %3" : "=v"(s1) : "v"(k1), "v"(s1), "v"(ninf));
                S0[i] = s0; S1[i] = s1;
            }
        }
        float mx = fmaxf(nsa::max16(S0), nsa::max16(S1)); mx = max_x32(mx);
        const float mold = mrun, mn = fmaxf(mrun, mx), alpha = __builtin_amdgcn_exp2f(mrun - mn); mrun = mn;
#pragma unroll
        for (int i = 0; i < 16; ++i) { S0[i] = __builtin_amdgcn_exp2f(S0[i] - mn); S1[i] = __builtin_amdgcn_exp2f(S1[i] - mn); }
        const float sm = nsa::sum16(S0) + nsa::sum16(S1);
        lrun = lrun * alpha + sm;
        {
            const int blk16 = (lane >> 4) & 1, q4 = (lane & 15) >> 2, p4 = lane & 3;
            LAS const unsigned char* vb = F.lds + VT + buf * VTB + (4 * hf + q4) * VRS + (16 * blk16 + 4 * p4) * 2;
            h4 vl[3], vh[3];
#define DSA_VRD(i) do { LAS const unsigned char* ad_ = vb + (16 * ((i) >> 2)) * VRS + 64 * ((i) & 3); vl[(i) % 3] = nsa::tr_read4(ad_); vh[(i) % 3] = nsa::tr_read4(ad_ + 8 * VRS); } while (0)
            DSA_VRD(0); DSA_VRD(1);
            h8 pf[4];
            const bool resc = __any(mn > mold);
            pf[0] = nsa::pack_step(S0, 0); if (resc) O[0] = O[0] * alpha;
            __builtin_amdgcn_sched_barrier(0);
#pragma unroll
            for (int i = 0; i < 16; ++i) {
                if (i + 2 < 16) DSA_VRD(i + 2);
                __builtin_amdgcn_sched_barrier(0);
                const h8 av = __builtin_shufflevector(vl[i % 3], vh[i % 3], 0, 1, 2, 3, 4, 5, 6, 7);
                O[i & 3] = MFMA32(av, pf[i >> 2], O[i & 3]);
                if (i < 3 && resc) O[i + 1] = O[i + 1] * alpha;
                if ((i & 3) == 1 && i < 12) pf[(i >> 2) + 1] = (i < 4) ? nsa::pack_step(S0, 1) : nsa::pack_step(S1, (i >> 2) - 1);
                __builtin_amdgcn_sched_barrier(0);
            }
#undef DSA_VRD
        }
    }
#undef DSA_LOAD
#undef DSA_WRITE
    lrun = add_x32(lrun);
    const float invl = (lrun > 0.f) ? 1.f / lrun : 0.f;
    f32x16 A2[2];
#pragma unroll
    for (int i = 0; i < 16; ++i) { A2[0][i] = 0.f; A2[1][i] = 0.f; }
    {
        const f16* wt = (const f16*)(F.ws + WS_WUVT) + (size_t)((L * 4 + hd) * 64 + rho) * 128 + 4 * hf;
        wt = launder_g(wt);
#pragma unroll
        for (int d = 0; d < 4; ++d) {
            O[d] = O[d] * invl;
#pragma unroll
            for (int s = 0; s < 2; ++s) {
                const h8 pf = nsa::pack_step(O[d], s);
#pragma unroll
                for (int vt = 0; vt < 2; ++vt) {
                    const f16* wp = wt + (size_t)(32 * vt) * 128 + 32 * d + 16 * s;
                    const h4 lo4 = *(const h4*)wp, hi4 = *(const h4*)(wp + 8);
                    const h8 av = __builtin_shufflevector(lo4, hi4, 0, 1, 2, 3, 4, 5, 6, 7);
                    A2[vt] = MFMA32(av, pf, A2[vt]);
                }
            }
        }
    }
    float sq = 0.f;
#pragma unroll
    for (int i = 0; i < 16; ++i) sq += A2[0][i] * A2[0][i] + A2[1][i] * A2[1][i];
    sq = add_x32(sq);
    LAS float* ssq = (LAS float*)(F.lds + SSQ);
    __syncthreads();
    if (hf == 0) ssq[w * 32 + rho] = sq;
    __syncthreads();
    const float tot = (ssq[(qh * 4 + 0) * 32 + rho] + ssq[(qh * 4 + 1) * 32 + rho]) + (ssq[(qh * 4 + 2) * 32 + rho] + ssq[(qh * 4 + 3) * 32 + rho]);
    const float rn = rsqrtf(tot * (1.f / 256.f) + EPS);
    const float* ga = gin(a, 23) + L * 256 + hd * 64 + 4 * hf;
    f16* dst = (f16*)(F.ws + WS_XA) + (size_t)m * D + hd * 64 + 4 * hf;
    dst = launder_g(dst); ga = launder_g(ga);
#pragma unroll
    for (int vt = 0; vt < 2; ++vt)
#pragma unroll
        for (int r4 = 0; r4 < 4; ++r4) {
            const int col = 32 * vt + 8 * r4; const f32x4 gn = *(const f32x4*)(ga + col);
            h4 o; o[0] = (f16)(A2[vt][4 * r4] * rn * gn[0]); o[1] = (f16)(A2[vt][4 * r4 + 1] * rn * gn[1]); o[2] = (f16)(A2[vt][4 * r4 + 2] * rn * gn[2]); o[3] = (f16)(A2[vt][4 * r4 + 3] * rn * gn[3]);
            *(u32x2*)(dst + col) = __builtin_bit_cast(u32x2, o);
        }
    __syncthreads();
}

__device__ __forceinline__ void item(Frame& F, int L, ArgsP a, int b, int c) {
    P1Ops ops; pass1_load(F, b, 64 * c, ops);
    for (int r = 0; r < 8; ++r) pass1_round(F, b, 64 * c + 8 * r, ops, r < 7);
    refresh(F); asm volatile("" : "+s"(b), "+s"(c));
    pass2(F, L, a, b, c);
    refresh(F);
}
}

__device__ __forceinline__ void p4_dsa_nsa(Frame& F, int L, ArgsP a) {
    for (int p = F.bx; p < BATCH * 32; p += F.G) {
        const int b = p & 7, c = p >> 3;
        dsa::item(F, L, a, b, 63 - c);
        dsa::item(F, L, a, b, c);
    }
    __syncthreads();
    refresh(F);
    for (int p = F.bx; p < BATCH * 32; p += F.G) {
        const int b = p & 7, c = p >> 3;
        nsa::item(F, L, a, b, 63 - c);
        nsa::item(F, L, a, b, c);
    }
    __syncthreads();
}

__device__ __forceinline__ void p_final(Frame& F, ArgsP a) {
    const float* ss = (const float*)(F.ws + WS_SS1); const float* fg = gin(a, 30); const f16* XB = (const f16*)(F.ws + WS_XB);
    for (int m = F.gw; m < M; m += F.ngw) {
        const float r = pg8::rstd_from_ss(ss, m) * (1.f / XSCALE);
#pragma unroll
        for (int j = 0; j < 2; ++j) {
            const size_t off = (size_t)m * D + j * 512 + F.lane * 8;
            const h8 xh = *(const h8*)(XB + off); const f32x4 g0 = *(const f32x4*)(fg + j * 512 + F.lane * 8), g1 = *(const f32x4*)(fg + j * 512 + F.lane * 8 + 4);
            const f32x4 v0 = (f32x4){(float)xh[0], (float)xh[1], (float)xh[2], (float)xh[3]} * r * g0, v1 = (f32x4){(float)xh[4], (float)xh[5], (float)xh[6], (float)xh[7]} * r * g1;
            *(f32x4*)(gout(a) + off) = v0; *(f32x4*)(gout(a) + off + 4) = v1;
        }
    }
}

constexpr int N_PHASES = 14;
__global__ void __launch_bounds__(NTHREADS, 2) fwd(Args a_) {
    extern __shared__ __attribute__((aligned(16))) unsigned char lds_raw[];
    cg::grid_group grid = cg::this_grid();
    ArgsP a = fresh_args();
    Frame F;
    F.lds = (LAS unsigned char*)lds_raw; F.ws = (GAS unsigned char*)a->ws;
    F.tid = threadIdx.x; F.lane = F.tid & 63; F.wave = __builtin_amdgcn_readfirstlane(F.tid >> 6);
    F.G = gridDim.x; F.bx = blockIdx.x; F.gw = blockIdx.x * NWAVES + F.wave; F.ngw = F.G * NWAVES;
    const int lo = a->ph_lo, hi = a->ph_hi;
    volatile LAS unsigned* xst = (volatile LAS unsigned*)(F.lds + LDS_BYTES - 16);
    if (threadIdx.x == 0) { xst[0] = 0u; xst[1] = 0u; }
    __syncthreads();
    XcdBarrier xbar = xcd_barrier_post((unsigned*)a->ws, xst);
#define IN(k) (lo <= (k) && (k) < hi)
#define SEAM(k) do { if (IN(k) && IN((k) + 1)) { if ((k) == 0) grid.sync(); else xcd_barrier(xbar); } } while (0)
    if (IN(0)) { refresh(F); a = fresh_args(); p0_prologue(F, a); }
    SEAM(0);
    for (int L = 0; L < DEPTH; ++L) {
        const int pb = 1 + 6 * L;
        GAS unsigned char* wl = F.ws + WS_W + (size_t)L * WL_STRIDE;
        if (IN(pb + 0)) {
            refresh(F); a = fresh_args();
            {
                pg8::Gemm g{(const f16*)(F.ws + (L == 0 ? WS_XA : WS_XB)), (const f16*)(wl + WL_INP), D, D, D, nullptr, nullptr, nullptr, nullptr, nullptr, 1.f, 1.f};
                pg8::StaticOrder S; S.init(M, NPREC + NPLAIN, F.G, F.bx);
                pg8::EpiInX E{(float*)(F.ws + WS_PP), (f16*)(F.ws + WS_PH), (const float*)(F.ws + WS_SS1), 1.f / (XSCALE * WSCALE), 1.f / XSCALE};
                pg8::gemm_phase<pg8::EpiInX, false>(F.lds, g, S, E);
            }
        }
        SEAM(pb + 0);
        if (IN(pb + 1)) { refresh(F); a = fresh_args(); p2_finalize(F, L, a); refresh(F); a = fresh_args(); p2_compress(F, L, a); refresh(F); a = fresh_args(); p2_s5_local(F, L); }
        SEAM(pb + 1);
        if (IN(pb + 2)) { refresh(F); a = fresh_args(); p4_s5_out(F, L, a); refresh(F); a = fresh_args(); p4_dsa_nsa(F, L, a); }
        SEAM(pb + 2);
        if (IN(pb + 3)) {
            refresh(F); a = fresh_args();
            pg8::Gemm g{(const f16*)(F.ws + WS_XA), (const f16*)(wl + WL_OUT), D, D, D, nullptr, nullptr, nullptr, nullptr, nullptr, 1.f, 1.f};
            pg8::StaticOrder S; S.init(M, D, F.G, F.bx);
            if (L == 0) { g.xin_f = gin(a, 0); g.XH = (f16*)(F.ws + WS_XB); g.ss = (float*)(F.ws + WS_SS2);
                pg8::EpiRes<false, false, true> E; pg8::gemm_phase<pg8::EpiRes<false, false, true>, false>(F.lds, g, S, E); }
            else { g.xin_h = (const f16*)(F.ws + WS_XB); g.rs = 1.f / XSCALE; g.XH = (f16*)(F.ws + WS_XB); g.ss = (float*)(F.ws + WS_SS2);
                pg8::EpiRes<true, false, true> E; pg8::gemm_phase<pg8::EpiRes<true, false, true>, false>(F.lds, g, S, E); }
        }
        SEAM(pb + 3);
        if (IN(pb + 4)) {
            refresh(F); a = fresh_args();
            pg8::Gemm g{(const f16*)(F.ws + WS_XB), (const f16*)(wl + WL_UP), D, D, D, nullptr, nullptr, nullptr, nullptr, nullptr, 1.f, 1.f};
            pg8::StaticOrder S; S.init(M, DFF, F.G, F.bx);
            pg8::EpiUp E{(f16*)(F.ws + WS_H), (const float*)(F.ws + WS_SS2)};
            pg8::gemm_phase<pg8::EpiUp, false>(F.lds, g, S, E);
        }
        SEAM(pb + 4);
        if (IN(pb + 5)) {
            refresh(F); a = fresh_args();
            pg8::Gemm g{(const f16*)(F.ws + WS_H), (const f16*)(wl + WL_DOWN), DFF, DFF, DFF, nullptr, nullptr, nullptr, nullptr, nullptr, 1.f, 1.f};
            pg8::StaticOrder S; S.init(M, D, F.G, F.bx, 1);
            g.xin_h = (const f16*)(F.ws + WS_XB); g.ss = (float*)(F.ws + WS_SS1);
            g.XH = (f16*)(F.ws + WS_XB); g.hs = XSCALE;
            { pg8::EpiRes<true, false, true> E; pg8::gemm_phase<pg8::EpiRes<true, false, true>, false>(F.lds, g, S, E); }
        }
        SEAM(pb + 5);
    }
    if (IN(13)) { refresh(F); a = fresh_args(); p_final(F, a); }
#undef IN
#undef SEAM
}

#ifndef MK_MULTI
#define MK_MULTI 0
#endif
extern "C" void kernel_launch(void* const* d_in, const int* in_sizes, int n_in, void* d_out, int out_size,
                              void* d_ws, size_t ws_size, hipStream_t stream) {
    static int grid = 0;
    if (grid == 0) {
        int dev = 0, cus = 0, per_cu = 0;
        (void)hipGetDevice(&dev);
        (void)hipDeviceGetAttribute(&cus, hipDeviceAttributeMultiprocessorCount, dev);
        (void)hipFuncSetAttribute((const void*)fwd, hipFuncAttributeMaxDynamicSharedMemorySize, LDS_BYTES);
        (void)hipOccupancyMaxActiveBlocksPerMultiprocessor(&per_cu, (const void*)fwd, NTHREADS, LDS_BYTES);
        if (per_cu < 1) per_cu = 1;
        grid = cus * per_cu;
        if (n_in != 31 || ws_size < WS_END) fprintf(stderr, "kernel_launch: unexpected n_in %d / ws %zu\n", n_in, ws_size);
        fprintf(stderr, "grid %d (cus %d per_cu %d) ws %zu\n", grid, cus, per_cu, ws_size);
    }
    (void)hipMemsetAsync(d_ws, 0, 16384, stream);
    Args a{};
    for (int i = 0; i < 31; ++i) a.in[i] = (const float*)d_in[i];
    a.out = (float*)d_out; a.ws = (unsigned char*)d_ws;
    for (int i = 0; i < 8; ++i) a.inv16[i] = (float)pow(500000.0, -(double)(2 * i) / 16.0);
    for (int i = 0; i < 4; ++i) a.inv8[i] = (float)pow(500000.0, -(double)(2 * i) / 8.0);
#if MK_MULTI
    for (int p = 0; p < N_PHASES; ++p) { a.ph_lo = p; a.ph_hi = p + 1; hipLaunchKernelGGL(fwd, dim3(grid), dim3(NTHREADS), LDS_BYTES, stream, a); }
#else
    a.ph_lo = 0; a.ph_hi = N_PHASES;
    void* args[] = {&a};
    hipError_t e = hipLaunchCooperativeKernel((const void*)fwd, dim3(grid), dim3(NTHREADS), args, LDS_BYTES, stream);
    if (e != hipSuccess) fprintf(stderr, "cooperative launch failed: %s (grid %d)\n", hipGetErrorString(e), grid);
#endif
}
```

```cpp
#include <hip/hip_runtime.h>
#include <hip/hip_cooperative_groups.h>
#include <cstdio>
#include <cmath>
namespace cg = cooperative_groups;

#define LAS __attribute__((address_space(3)))
#define GAS __attribute__((address_space(1)))
typedef _Float16 f16;
typedef _Float16 h8 __attribute__((ext_vector_type(8)));
typedef _Float16 h4 __attribute__((ext_vector_type(4)));
typedef _Float16 h2 __attribute__((ext_vector_type(2)));
typedef float f32x4 __attribute__((ext_vector_type(4)));
typedef float f32x2 __attribute__((ext_vector_type(2)));
typedef unsigned u32x4 __attribute__((ext_vector_type(4)));
typedef unsigned u32x2 __attribute__((ext_vector_type(2)));
typedef float f32x16 __attribute__((ext_vector_type(16)));
typedef short v4i16_t __attribute__((ext_vector_type(4)));
#define MFMA32(a, b, c) __builtin_amdgcn_mfma_f32_32x32x16_f16((a), (b), (c), 0, 0, 0)

constexpr int BATCH = 8, SEQ = 4096, M = BATCH * SEQ, D = 1024, NIN = 2124, DFF = 4096, DEPTH = 2;
constexpr float EPS = 1e-6f;
constexpr int NWAVES = 8, NTHREADS = 512;
constexpr int LDS_BYTES = 152 * 1024;
constexpr int C_AQ = 0, C_CKV = 256, C_KR = 384, C_IQ = 400, C_IK = 528, C_IW = 560, C_BU = 564, C_CQ = 820, C_CKVN = 1332, C_GATE = 2100;
constexpr int PH_LD = 1792;
constexpr int H_QA = 0, H_KA = 576, H_BU = 720, H_VC = 976, H_KS = 1104, H_VS = 1232, H_KW = 1360, H_VW = 1488, H_GATE = 1616, H_IK = 1640, H_IW = 1672, H_END = 1676;
constexpr int PP_LD = 1024;
constexpr int P_CQ = 0, P_KC = 512, P_IQ = 640, P_IK = 768, P_IW = 800, P_END = 804;
constexpr int P_IKS = 832, P_IQS = 864;
constexpr float ISC = 8.f;
constexpr bool SPLIT = false;
constexpr int NPREC = 768, NPLAIN = 1792;
constexpr float XSCALE = 16.f, WSCALE = 128.f;

constexpr size_t MiB = 1u << 20;
constexpr size_t WS_ROPE = 1 * MiB;
constexpr size_t WS_S5C = 4 * MiB;
constexpr int S5C_STRIDE = 196608;
constexpr int S5_AR = 0, S5_AI = 1024, S5_BBR = 2048, S5_BBI = 18432, S5_ATR = 34816, S5_ATI = 100352, S5_CB = 165888;
constexpr size_t WS_SS1 = 6 * MiB, WS_SS2 = 8 * MiB;
constexpr size_t WS_HLOC = 10 * MiB;
constexpr size_t WS_KCMP = 14 * MiB, WS_VCMP = 15 * MiB;
constexpr size_t WS_W = 16 * MiB, WL_STRIDE = 28 * MiB;
constexpr size_t WL_INP = 0, WL_INH = (size_t)768 * 1024 * 2,        WL_OUT = 10 * MiB, WL_UP = 12 * MiB, WL_DOWN = 20 * MiB;
constexpr size_t WS_XA = 72 * MiB, WS_XB = 136 * MiB, WS_PP = 200 * MiB, WS_PH = 328 * MiB, WS_H = 200 * MiB, WS_BM = 456 * MiB, WS_END = 484 * MiB;
constexpr size_t WS_WUVT = 5 * MiB + 768 * 1024;
constexpr size_t WS_GLUT = 472 * MiB;
constexpr size_t WS_W1T = 474 * MiB;
constexpr size_t WS_BBT = 476 * MiB;
constexpr size_t WS_CMT = 473 * MiB;
constexpr size_t WS_IKT = 480 * MiB;
constexpr size_t XPLANE = WS_XB - WS_XA;

struct Args {
    const float* in[31];
    float* out;
    unsigned char* ws;
    float inv16[8];
    float inv8[4];
    int ph_lo, ph_hi;
};

typedef const Args __attribute__((address_space(4)))* ArgsP;
__device__ __forceinline__ const float* gin(ArgsP a, int i) { return (const float*)(GAS const float*)a->in[i]; }
__device__ __forceinline__ float* gout(ArgsP a) { return (float*)(GAS float*)a->out; }
template <class T> __device__ __forceinline__ T* launder_g(T* p) { GAS T* q = (GAS T*)p; asm volatile("" : "+v"(q)); return (T*)q; }
__device__ __forceinline__ ArgsP fresh_args() { ArgsP p = (ArgsP)__builtin_amdgcn_kernarg_segment_ptr(); asm volatile("" : "+s"(p)); return p; }
__device__ __forceinline__ int lane_id() { return (int)__builtin_amdgcn_mbcnt_hi(~0u, __builtin_amdgcn_mbcnt_lo(~0u, 0u)); }
template <int CTRL> __device__ __forceinline__ float dpp_mv(float v) { return __builtin_bit_cast(float, __builtin_amdgcn_mov_dpp(__builtin_bit_cast(int, v), CTRL, 0xF, 0xF, true)); }
__device__ __forceinline__ float wave_sum(float v) {
    v += dpp_mv<0xB1>(v); v += dpp_mv<0x4E>(v); v += dpp_mv<0x141>(v); v += dpp_mv<0x140>(v);
    const int vi = __builtin_bit_cast(int, v);
    return (__builtin_bit_cast(float, __builtin_amdgcn_readlane(vi, 0)) + __builtin_bit_cast(float, __builtin_amdgcn_readlane(vi, 16)))
         + (__builtin_bit_cast(float, __builtin_amdgcn_readlane(vi, 32)) + __builtin_bit_cast(float, __builtin_amdgcn_readlane(vi, 48)));
}
__device__ __forceinline__ float wave_max(float v) {
#pragma unroll
    for (int o = 1; o < 64; o <<= 1) v = fmaxf(v, __shfl_xor(v, o));
    return v;
}
__device__ __forceinline__ int wave_sum_i(int v) {
#pragma unroll
    for (int o = 1; o < 64; o <<= 1) v += __shfl_xor(v, o);
    return v;
}
__device__ __forceinline__ float max_x32(float v) { const auto rr = __builtin_amdgcn_permlane32_swap(__float_as_uint(v), __float_as_uint(v), false, false); return fmaxf(__uint_as_float(rr[0]), __uint_as_float(rr[1])); }
__device__ __forceinline__ float add_x32(float v) { const auto rr = __builtin_amdgcn_permlane32_swap(__float_as_uint(v), __float_as_uint(v), false, false); return __uint_as_float(rr[0]) + __uint_as_float(rr[1]); }
__device__ __forceinline__ float partner_x32(float v, int hf) { const auto rr = __builtin_amdgcn_permlane32_swap(__float_as_uint(v), __float_as_uint(v), false, false); return __uint_as_float(hf ? rr[0] : rr[1]); }
__device__ __forceinline__ float gelu_tanh(float x) {
    const float u = 0.7978845608028654f * (x + 0.044715f * x * x * x);
    const float e = __builtin_amdgcn_exp2f(2.885390081777927f * u);
    return x * (1.f - __builtin_amdgcn_rcpf(1.f + e));
}
__device__ __forceinline__ float sigmoidf(float x) { return __builtin_amdgcn_rcpf(1.f + __builtin_amdgcn_exp2f(-1.4426950408889634f * x)); }
__device__ __forceinline__ unsigned mono_key(float f) {
    unsigned u = __float_as_uint(f);
    return (u & 0x80000000u) ? ~u : (u | 0x80000000u);
}
__device__ __forceinline__ void lds_fence() { asm volatile("s_waitcnt lgkmcnt(0)" ::: "memory"); }
template <int CTRL> __device__ __forceinline__ float dpp_f(float v) { return __builtin_bit_cast(float, __builtin_amdgcn_mov_dpp(__builtin_bit_cast(int, v), CTRL, 0xF, 0xF, true)); }

namespace pg8 {
constexpr int BM = 256, BK = 64, HALF = 128, HTB = HALF * BK * 2, STAGE_BYTES = 8 * HTB, NXCD = 8, WGM = 8;
__device__ __forceinline__ int lds_byte(int r, int c) { const int st = (r >> 4) * 2 + (c >> 5), rr = r & 15, cc = c & 31, ob = rr * 64 + cc * 2; return st * 1024 + (ob ^ (((ob >> 9) & 1) << 5)); }
__device__ __forceinline__ void stage_rc(int b, int& R, int& C) { const int st = b / 1024, sb = b % 1024, swz = sb ^ (((sb >> 9) & 1) << 5); R = (st >> 1) * 16 + swz / 64; C = (st & 1) * 32 + (swz % 64) / 2; }
__device__ __forceinline__ int perm32(int rho) { const int n = rho >> 4, i = rho & 15; return 8 * (i >> 2) + 4 * n + (i & 3); }

struct Unit { int pm, pn; };
struct Gemm { const f16* A; const f16* Bt; int lda, ldb, K;
    const float* xin_f; const f16* xin_h; float* xout; f16* XH; float* ss; float rs, hs; };

struct StaticOrder {
    int nM, nN, nwg, G, c, rev;
    __device__ void init(int M_, int N_, int G_, int c_, int rev_ = 0) { nM = M_ / BM; nN = N_ / BM; nwg = nM * nN; G = G_; c = c_; rev = rev_; }
    __device__ bool next(int i, Unit& u) const {
        const long L = (long)i * G + c; if (L >= nwg) return false;
        int wgid = (int)L; { const int q = nwg / NXCD, r = nwg % NXCD, xcd = wgid % NXCD, off = wgid / NXCD; wgid = (xcd < r ? xcd * (q + 1) : r * (q + 1) + (xcd - r) * q) + off; }
        const int nig = WGM * nN, gid = wgid / nig, fm = gid * WGM, gsz = (nM - fm) < WGM ? (nM - fm) : WGM;
        u.pm = fm + ((wgid % nig) % gsz); u.pn = (wgid % nig) / gsz; if (rev) u.pm = nM - 1 - u.pm; return true;
    }
};

template <bool WRAPA>
__device__ __forceinline__ size_t koffA(int kt) {
    if constexpr (WRAPA) return (size_t)(kt & 15) * (BK * 2) + (((kt >> 4) == 1) ? XPLANE : 0);
    else return (size_t)kt * (BK * 2);
}

template <class Epi, bool WRAPA>
__device__ __forceinline__ void gemm_phase(LAS unsigned char* lds, const Gemm g, const StaticOrder& S, const Epi& E, int wave_) {
    int tid = wave_ * 64 + lane_id(); asm volatile("" : "+v"(tid));
    const int wid = __builtin_amdgcn_readfirstlane(tid >> 6), lane = tid & 63, wr = wid >> 2, wc = wid & 3, fr = lane & 15, fq = lane >> 4;
    const int nt = g.K / BK;
    unsigned voffA[2], voffB[2];
#pragma unroll
    for (int i = 0; i < 2; ++i) { int R, C; stage_rc(tid * 16 + i * 8192, R, C); const int Rb = (R & ~31) + perm32(R & 31);
        voffA[i] = (unsigned)(R * g.lda + C) * 2u; voffB[i] = (unsigned)(Rb * g.ldb + C) * 2u; }
    const size_t kstep = (size_t)(BK * 2);
    const size_t hstepA = (size_t)HALF * g.lda * 2, hstepB = (size_t)HALF * g.ldb * 2;
    const size_t tstepA = 2 * hstepA, tstepB = 2 * hstepB;
    const unsigned ldsw = (unsigned)wid * 1024u;
    const int aoff = lds_byte(wr * 64 + fr, fq * 8), boff = lds_byte(wc * 32 + fr, fq * 8);
#define PG8_SA(b, h) (((b) * 2 + (h)) * HTB)
#define PG8_SB(b, h) ((4 + (b) * 2 + (h)) * HTB)
#define PG8_STAGE(bufoff, gbase, voff) do { _Pragma("unroll") for (int _i = 0; _i < 2; ++_i) \
        __builtin_amdgcn_global_load_lds((const unsigned*)((const char*)(gbase) + (voff)[_i]), (LAS unsigned*)(lds + (bufoff) + ldsw + _i * 8192), 16, 0, 0); } while (0)
#define PG8_LDA(dst, b, h) do { _Pragma("unroll") for (int m = 0; m < 4; ++m) _Pragma("unroll") for (int k = 0; k < 2; ++k) dst[m][k] = *(const LAS h8*)(lds + PG8_SA(b, h) + aoff + m * 2048 + k * 1024); } while (0)
#define PG8_LDB(dst, b, h) do { _Pragma("unroll") for (int n = 0; n < 2; ++n) _Pragma("unroll") for (int k = 0; k < 2; ++k) dst[n][k] = *(const LAS h8*)(lds + PG8_SB(b, h) + boff + n * 2048 + k * 1024); } while (0)
#define PG8_MMA(ai, bj, At, Bt) do { __builtin_amdgcn_s_setprio(1); _Pragma("unroll") for (int m = 0; m < 4; ++m) _Pragma("unroll") for (int n = 0; n < 2; ++n) _Pragma("unroll") for (int k = 0; k < 2; ++k) \
        acc[ai][bj][m][n] = __builtin_amdgcn_mfma_f32_16x16x32_f16(Bt[n][k], At[m][k], acc[ai][bj][m][n], 0, 0, 0); __builtin_amdgcn_s_setprio(0); } while (0)
#define PG8_WAIT_V(n) asm volatile("s_waitcnt vmcnt(" #n ")" ::: "memory")
#define PG8_WAIT_L(n) asm volatile("s_waitcnt lgkmcnt(" #n ")" ::: "memory")
#define PG8_BAR __builtin_amdgcn_s_barrier()
#define PG8_SCHED __builtin_amdgcn_sched_barrier(0)
    Unit cur, nxt; int ui = 0;
    if (!S.next(0, cur)) return;
    E.prep(lds, S, tid);
    f32x4 acc[2][2][4][2];
#pragma unroll
    for (int a = 0; a < 2; ++a)
#pragma unroll
        for (int b = 0; b < 2; ++b)
#pragma unroll
            for (int m = 0; m < 4; ++m)
#pragma unroll
                for (int n = 0; n < 2; ++n) acc[a][b][m][n] = (f32x4){0.f, 0.f, 0.f, 0.f};
    h8 At[4][2], B0[2][2], B1[2][2];
    const char* cA = (const char*)g.A + (size_t)cur.pm * tstepA; const char* cB = (const char*)g.Bt + (size_t)cur.pn * tstepB;
    PG8_STAGE(PG8_SB(0, 0), cB, voffB); PG8_STAGE(PG8_SB(0, 1), cB + hstepB, voffB); PG8_STAGE(PG8_SA(0, 0), cA + koffA<WRAPA>(0), voffA); PG8_STAGE(PG8_SA(0, 1), cA + koffA<WRAPA>(0) + hstepA, voffA);
    if (wr == 1) PG8_BAR;
    PG8_WAIT_V(2); PG8_BAR;
    PG8_STAGE(PG8_SB(1, 0), cB + kstep, voffB); PG8_STAGE(PG8_SA(1, 0), cA + koffA<WRAPA>(1), voffA); PG8_STAGE(PG8_SB(1, 1), cB + hstepB + kstep, voffB);
    PG8_WAIT_V(6); PG8_BAR;
    for (;;) {
        const bool has_next = S.next(ui + 1, nxt);
        const char* nA = has_next ? (const char*)g.A + (size_t)nxt.pm * tstepA : cA; const char* nB = has_next ? (const char*)g.Bt + (size_t)nxt.pn * tstepB : cB;
        for (int t = 0; t < nt; t += 2) {
            const bool last = (t == nt - 2);
            const char* a1 = cA + koffA<WRAPA>(t + 1);
            const char* a2 = last ? nA + koffA<WRAPA>(0) : cA + koffA<WRAPA>(t + 2); const char* b2 = last ? nB : cB + (size_t)(t + 2) * kstep;
            const char* a3 = last ? nA + koffA<WRAPA>(1) : cA + koffA<WRAPA>(t + 3); const char* b3 = b2 + kstep;
            PG8_LDB(B0, 0, 0); PG8_LDB(B1, 0, 1); PG8_SCHED; PG8_LDA(At, 0, 0); PG8_STAGE(PG8_SA(1, 1), a1 + hstepA, voffA);
            PG8_WAIT_V(8); PG8_WAIT_L(0); PG8_BAR; PG8_MMA(0, 0, At, B0); PG8_MMA(0, 1, At, B1); PG8_BAR; PG8_SCHED;
            PG8_LDA(At, 0, 1); PG8_STAGE(PG8_SB(0, 0), b2, voffB); PG8_STAGE(PG8_SB(0, 1), b2 + hstepB, voffB); PG8_STAGE(PG8_SA(0, 0), a2, voffA);
            PG8_WAIT_V(8); PG8_WAIT_L(0); PG8_BAR; PG8_MMA(1, 0, At, B0); PG8_MMA(1, 1, At, B1); PG8_BAR; PG8_SCHED;
            PG8_LDB(B0, 1, 0); PG8_LDB(B1, 1, 1); PG8_SCHED; PG8_LDA(At, 1, 0); PG8_STAGE(PG8_SA(0, 1), a2 + hstepA, voffA);
            PG8_WAIT_V(8); PG8_WAIT_L(0); PG8_BAR; PG8_MMA(0, 0, At, B0); PG8_MMA(0, 1, At, B1); PG8_BAR; PG8_SCHED;
            PG8_LDA(At, 1, 1); PG8_STAGE(PG8_SB(1, 0), b3, voffB); PG8_STAGE(PG8_SB(1, 1), b3 + hstepB, voffB); PG8_STAGE(PG8_SA(1, 0), a3, voffA);
            PG8_WAIT_V(8); PG8_WAIT_L(0); PG8_BAR; PG8_MMA(1, 0, At, B0); PG8_MMA(1, 1, At, B1); PG8_BAR; PG8_SCHED;
        }
        if (wr == 0) PG8_BAR;
        E(acc, cur, wr, wc, fr, fq, g, lds, ui);
        if (!has_next) break;
#pragma unroll
        for (int a = 0; a < 2; ++a)
#pragma unroll
            for (int b = 0; b < 2; ++b)
#pragma unroll
                for (int m = 0; m < 4; ++m)
#pragma unroll
                    for (int n = 0; n < 2; ++n) acc[a][b][m][n] = (f32x4){0.f, 0.f, 0.f, 0.f};
        cur = nxt; cA = nA; cB = nB; ++ui;
        if (wr == 1) PG8_BAR;
    }
    PG8_WAIT_V(0);
    PG8_BAR;
#undef PG8_SA
#undef PG8_SB
#undef PG8_STAGE
#undef PG8_LDA
#undef PG8_LDB
#undef PG8_MMA
#undef PG8_WAIT_V
#undef PG8_WAIT_L
#undef PG8_BAR
#undef PG8_SCHED
}

__device__ __forceinline__ float rstd_from_ss(const float* ss, int row) {
    const f32x4* p = (const f32x4*)(ss + (size_t)row * 16);
    const f32x4 a = p[0], b = p[1], c = p[2], d = p[3];
    const float s = ((a[0] + a[1]) + (a[2] + a[3])) + ((b[0] + b[1]) + (b[2] + b[3])) + ((c[0] + c[1]) + (c[2] + c[3])) + ((d[0] + d[1]) + (d[2] + d[3]));
    return rsqrtf(s * (1.f / 1024.f) + EPS);
}
__device__ __forceinline__ u32x4 pack8h(const f32x4 v0, const f32x4 v1) {
    h8 h; h[0] = (f16)v0[0]; h[1] = (f16)v0[1]; h[2] = (f16)v0[2]; h[3] = (f16)v0[3]; h[4] = (f16)v1[0]; h[5] = (f16)v1[1]; h[6] = (f16)v1[2]; h[7] = (f16)v1[3];
    return __builtin_bit_cast(u32x4, h);
}
constexpr int RTAB = STAGE_BYTES;
__device__ __forceinline__ void rstd_table(LAS unsigned char* lds, const float* ss, int pm, int wr, int wc, int fr, int fq) {
    const int t = (wr * 4 + wc) * 64 + fq * 16 + fr, row = t >> 1;
    const f32x4* p = (const f32x4*)(ss + (size_t)(pm * BM + row) * 16) + 2 * (t & 1);
    const f32x4 a = p[0], b = p[1];
    float s = ((a[0] + a[1]) + (a[2] + a[3])) + ((b[0] + b[1]) + (b[2] + b[3]));
    s += __builtin_bit_cast(float, __builtin_amdgcn_mov_dpp(__builtin_bit_cast(int, s), 0xB1, 0xF, 0xF, true));
    if ((t & 1) == 0) ((LAS float*)(lds + RTAB))[row] = rsqrtf(s * (1.f / 1024.f) + EPS);
    asm volatile("s_waitcnt lgkmcnt(0)\n\ts_barrier" ::: "memory");
}
constexpr int MAXU = 8;
template <class Order>
__device__ __forceinline__ void rstd_tables(LAS unsigned char* lds, const float* ss, const Order& S, int t) {
    Unit u; int pmv[MAXU];
#pragma unroll
    for (int i = 0; i < MAXU; ++i) { (void)S.next(i, u); pmv[i] = u.pm; }
    const int row = t >> 1;
    f32x4 a[MAXU], b[MAXU];
#pragma unroll
    for (int i = 0; i < MAXU; ++i) { const f32x4* p = (const f32x4*)(ss + (size_t)(pmv[i] * BM + row) * 16) + 2 * (t & 1); a[i] = p[0]; b[i] = p[1]; }
#pragma unroll
    for (int i = 0; i < MAXU; ++i) {
        float s_ = ((a[i][0] + a[i][1]) + (a[i][2] + a[i][3])) + ((b[i][0] + b[i][1]) + (b[i][2] + b[i][3]));
        s_ += __builtin_bit_cast(float, __builtin_amdgcn_mov_dpp(__builtin_bit_cast(int, s_), 0xB1, 0xF, 0xF, true));
        if ((t & 1) == 0) ((LAS float*)(lds + RTAB + i * 1024))[row] = rsqrtf(s_ * (1.f / 1024.f) + EPS);
    }
}
template <bool F32OUT> struct EpiIn {
    void* O; int ldc; const float* ss; float sc;
    template <class Order> __device__ __forceinline__ void prep(LAS unsigned char*, const Order&, int) const {}
    __device__ __forceinline__ void operator()(const f32x4 (&acc)[2][2][4][2], const Unit& u, int wr, int wc, int fr, int fq, const Gemm&, LAS unsigned char*, int) const {
        const int row0 = u.pm * BM + wr * 64 + fr, col0 = u.pn * BM + wc * 32 + 8 * fq;
#pragma unroll
        for (int ai = 0; ai < 2; ++ai)
#pragma unroll
            for (int m = 0; m < 4; ++m) {
                const int row = row0 + ai * HALF + m * 16;
                const float r = rstd_from_ss(ss, row) * sc;
#pragma unroll
                for (int bj = 0; bj < 2; ++bj) {
                    if (col0 + bj * HALF >= (F32OUT ? NPREC : H_END)) continue;
                    const f32x4 v0 = acc[ai][bj][m][0] * r, v1 = acc[ai][bj][m][1] * r;
                    if constexpr (F32OUT) { float* p = (float*)O + (size_t)row * ldc + col0 + bj * HALF; *(f32x4*)p = v0; *(f32x4*)(p + 4) = v1; }
                    else { f16* p = (f16*)O + (size_t)row * ldc + col0 + bj * HALF; *(u32x4*)p = pack8h(v0, v1); }
                }
            }
    }
};
struct EpiInX {
    float* PPo; f16* PHo; const float* ss; float sc1, sc2;
    template <class Order> __device__ __forceinline__ void prep(LAS unsigned char* lds, const Order& S, int t) const { rstd_tables(lds, ss, S, t); }
    __device__ __forceinline__ void operator()(const f32x4 (&acc)[2][2][4][2], const Unit& u, int wr, int wc, int fr, int fq, const Gemm&, LAS unsigned char* lds, int ui) const {
        if (ui >= MAXU) rstd_table(lds, ss, u.pm, wr, wc, fr, fq);
        const LAS float* tab = (const LAS float*)(lds + RTAB + (ui < MAXU ? ui : 0) * 1024) + wr * 64 + fr;
        const int row0 = u.pm * BM + wr * 64 + fr;
        const bool f32out = u.pn < NPREC / BM;
        const int col0 = (f32out ? u.pn : u.pn - NPREC / BM) * BM + wc * 32 + 8 * fq;
        const float sc = f32out ? sc1 : sc2;
#pragma unroll
        for (int ai = 0; ai < 2; ++ai)
#pragma unroll
            for (int m = 0; m < 4; ++m) {
                const int row = row0 + ai * HALF + m * 16;
                const float r = tab[ai * HALF + m * 16] * sc;
#pragma unroll
                for (int bj = 0; bj < 2; ++bj) {
                    const int col = col0 + bj * HALF;
                    const f32x4 v0 = acc[ai][bj][m][0] * r, v1 = acc[ai][bj][m][1] * r;
                    if (f32out) { float* p = PPo + (size_t)row * PP_LD + col; *(f32x4*)p = v0; *(f32x4*)(p + 4) = v1; }
                    else if (col < H_END) *(u32x4*)(PHo + (size_t)row * PH_LD + col) = pack8h(v0, v1);
                }
            }
    }
};
template <bool RES_F16, bool OUT_F32, bool OUT_H> struct EpiRes {
    template <class Order> __device__ __forceinline__ void prep(LAS unsigned char*, const Order&, int) const {}
    __device__ __forceinline__ void operator()(const f32x4 (&acc)[2][2][4][2], const Unit& u, int wr, int wc, int fr, int fq, const Gemm& G, LAS unsigned char*, int) const {
        const float* xin_f = G.xin_f; const f16* xin_h = G.xin_h; float* xout = G.xout; f16* XH = G.XH; float* ss = G.ss; const float rs = G.rs, hs = G.hs;
        const int row0 = u.pm * BM + wr * 64 + fr, col0 = u.pn * BM + wc * 32 + 8 * fq;
#pragma unroll
        for (int ai = 0; ai < 2; ++ai) {
            h8 xh[4][2]; f32x4 xf[4][2][2];
#pragma unroll
            for (int m = 0; m < 4; ++m)
#pragma unroll
                for (int bj = 0; bj < 2; ++bj) {
                    const size_t off = (size_t)(row0 + ai * HALF + m * 16) * D + col0 + bj * HALF;
                    if constexpr (RES_F16) xh[m][bj] = *(const h8*)(xin_h + off);
                    else { xf[m][bj][0] = *(const f32x4*)(xin_f + off); xf[m][bj][1] = *(const f32x4*)(xin_f + off + 4); }
                }
#pragma unroll
            for (int m = 0; m < 4; ++m)
#pragma unroll
                for (int bj = 0; bj < 2; ++bj) {
                    if constexpr (RES_F16) asm volatile("" : "+v"(xh[m][bj]));
                    else { asm volatile("" : "+v"(xf[m][bj][0])); asm volatile("" : "+v"(xf[m][bj][1])); }
                }
#pragma unroll
            for (int m = 0; m < 4; ++m) {
                const int row = row0 + ai * HALF + m * 16;
                float sq = 0.f;
#pragma unroll
                for (int bj = 0; bj < 2; ++bj) {
                    const size_t off = (size_t)row * D + col0 + bj * HALF;
                    f32x4 x0, x1;
                    if constexpr (RES_F16) { const h8 xv = xh[m][bj];
                        x0 = (f32x4){(float)xv[0], (float)xv[1], (float)xv[2], (float)xv[3]} * rs; x1 = (f32x4){(float)xv[4], (float)xv[5], (float)xv[6], (float)xv[7]} * rs; }
                    else { x0 = xf[m][bj][0]; x1 = xf[m][bj][1]; }
                    const f32x4 v0 = acc[ai][bj][m][0] + x0, v1 = acc[ai][bj][m][1] + x1;
                    if constexpr (OUT_F32) { *(f32x4*)(xout + off) = v0; *(f32x4*)(xout + off + 4) = v1; }
                    sq += (v0[0] * v0[0] + v0[1] * v0[1]) + (v0[2] * v0[2] + v0[3] * v0[3]) + (v1[0] * v1[0] + v1[1] * v1[1]) + (v1[2] * v1[2] + v1[3] * v1[3]);
                    if constexpr (OUT_H) *(u32x4*)(XH + off) = pack8h(v0 * hs, v1 * hs);
                }
                sq += __shfl_xor(sq, 16); sq += __shfl_xor(sq, 32);
                if (fq == 0) ss[(size_t)row * 16 + u.pn * 4 + wc] = sq;
            }
        }
    }
};
struct EpiUp {
    f16* O; const float* ss;
    template <class Order> __device__ __forceinline__ void prep(LAS unsigned char* lds, const Order& S, int t) const { rstd_tables(lds, ss, S, t); }
    __device__ __forceinline__ void operator()(const f32x4 (&acc)[2][2][4][2], const Unit& u, int wr, int wc, int fr, int fq, const Gemm&, LAS unsigned char* lds, int ui) const {
        if (ui >= MAXU) rstd_table(lds, ss, u.pm, wr, wc, fr, fq);
        const LAS float* tab = (const LAS float*)(lds + RTAB + (ui < MAXU ? ui : 0) * 1024) + wr * 64 + fr;
        const int row0 = u.pm * BM + wr * 64 + fr, col0 = u.pn * BM + wc * 32 + 8 * fq;
#pragma unroll
        for (int ai = 0; ai < 2; ++ai)
#pragma unroll
            for (int m = 0; m < 4; ++m) {
                const int row = row0 + ai * HALF + m * 16;
                const float r = tab[ai * HALF + m * 16];
#pragma unroll
                for (int bj = 0; bj < 2; ++bj) {
                    f32x4 v0 = acc[ai][bj][m][0] * r, v1 = acc[ai][bj][m][1] * r;
#pragma unroll
                    for (int j = 0; j < 4; ++j) { const float a = fmaxf(v0[j], 0.f), b = fmaxf(v1[j], 0.f); v0[j] = a * a; v1[j] = b * b; }
                    *(u32x4*)(O + (size_t)row * DFF + col0 + bj * HALF) = pack8h(v0, v1);
                }
            }
    }
};
}


#define XB_TMO      128
#define XB_XCNT(j)  (256  + 64 * (j))
#define XB_XSUB(j)  (1280 + 64 * (j))
#define XB_XGEN(j)  (2304 + 64 * (j))
#define XB_TOP      3328
#define XB_TOPGEN   3392
#define XCD_BAR_WORDS 3456
#define XB_SPIN_CAP (1u << 22)
__device__ __forceinline__ unsigned xb_ld(unsigned* p)              { return __hip_atomic_load(p, __ATOMIC_RELAXED, __HIP_MEMORY_SCOPE_AGENT); }
__device__ __forceinline__ unsigned xb_add(unsigned* p, unsigned v) { return __hip_atomic_fetch_add(p, v, __ATOMIC_RELAXED, __HIP_MEMORY_SCOPE_AGENT); }
__device__ __forceinline__ unsigned xb_xcc_id() { return (unsigned)__builtin_amdgcn_s_getreg((3 << 11) | 20) & 0xFu; }
#define XB_SPIN(cond, bar) do { unsigned _sp = 0; while (cond) { __builtin_amdgcn_s_sleep(1); \
    if ((++_sp & 255u) == 0u) { if (xb_ld(&(bar)[XB_TMO])) break; if (_sp > XB_SPIN_CAP) { atomicAdd(&(bar)[XB_TMO], 1u); break; } } } } while (0)
struct XcdBarrier { unsigned* bar; unsigned x; volatile LAS unsigned* st; int w0; };
__device__ __forceinline__ XcdBarrier xcd_barrier_post(unsigned* bar, volatile LAS unsigned* st, int wave_) {
    XcdBarrier b; b.bar = bar; b.x = xb_xcc_id(); b.st = st; b.w0 = (wave_ == 0);
    if (b.w0 && lane_id() == 0) (void)xb_add(&bar[XB_XCNT(b.x)], 1u);
    return b;
}
__device__ __forceinline__ void xcd_barrier_complete(unsigned* bar, unsigned x, unsigned& nloc, unsigned& nx) {
    const unsigned G = gridDim.x * gridDim.y * gridDim.z;
    unsigned sum, cnt, mine, sp = 0u;
    for (;;) {
        sum = 0u; cnt = 0u; mine = 0u;
#pragma unroll
        for (unsigned j = 0; j < 16; ++j) { const unsigned c = xb_ld(&bar[XB_XCNT(j)]); sum += c; cnt += (c > 0u) ? 1u : 0u; mine = (j == x) ? c : mine; }
        if (sum == G) break;
        __builtin_amdgcn_s_sleep(1);
        if ((++sp & 255u) == 0u) { if (xb_ld(&bar[XB_TMO])) break; if (sp > XB_SPIN_CAP) { atomicAdd(&bar[XB_TMO], 1u); break; } }
    }
    nloc = mine > 0u ? mine : 1u; nx = cnt > 0u ? cnt : 1u;
}
__device__ __forceinline__ void xcd_barrier(const XcdBarrier& b) {
    asm volatile("s_waitcnt vmcnt(0)" ::: "memory");
    __syncthreads();
    if (b.w0 && lane_id() == 0) {
        unsigned* bar = b.bar;
        __builtin_amdgcn_s_waitcnt(0);
        unsigned nloc = b.st[0], nx = b.st[1];
        if (nloc == 0u) { xcd_barrier_complete(bar, b.x, nloc, nx); b.st[0] = nloc; b.st[1] = nx; }
        const unsigned old = xb_add(&bar[XB_XSUB(b.x)], 1u);
        const unsigned gen = old / nloc;
        if (old + 1u == (gen + 1u) * nloc) {
            __builtin_amdgcn_fence(__ATOMIC_RELEASE, "agent");
            asm volatile("s_waitcnt vmcnt(0)" ::: "memory");
            const unsigned og = xb_add(&bar[XB_TOP], 1u);
            const unsigned tg = og / nx;
            if (og + 1u == (tg + 1u) * nx) xb_add(&bar[XB_TOPGEN], 1u);
            else XB_SPIN(xb_ld(&bar[XB_TOPGEN]) == tg, bar);
            __builtin_amdgcn_fence(__ATOMIC_ACQUIRE, "agent");
            xb_add(&bar[XB_XGEN(b.x)], 1u);
            asm volatile("s_waitcnt vmcnt(0)" ::: "memory");
        } else {
            XB_SPIN(xb_ld(&bar[XB_XGEN(b.x)]) == gen, bar);
            __builtin_amdgcn_fence(__ATOMIC_ACQUIRE, "agent");
            asm volatile("s_waitcnt vmcnt(0)" ::: "memory");
        }
    }
    __syncthreads();
}

struct Frame {
    LAS unsigned char* lds;
    GAS unsigned char* ws;
    int tid, lane, wave, gw, ngw, G, bx;
};
__device__ __forceinline__ void refresh(Frame& F) {
    int t = F.wave * 64 + lane_id(); asm volatile("" : "+v"(t));
    F.tid = t; F.lane = t & 63; F.wave = __builtin_amdgcn_readfirstlane(t >> 6);
    int bx = blockIdx.x; asm volatile("" : "+s"(bx));
    F.bx = bx; F.gw = bx * NWAVES + F.wave;
    { GAS unsigned char* wsp = F.ws; asm volatile("" : "+s"(wsp)); F.ws = wsp; }
}

__device__ __forceinline__ float winh_val(const float* Win, const float* g1, const float* wuk, int k, int n) {
    int src = -1;
    if (n < H_KA) {
        const int h = n / 144, j = n % 144;
        if (j < 128) return 0.f;
        src = C_AQ + h * 64 + (j - 128);
    }
    else if (n < H_KA + 128) src = C_CKV + (n - H_KA);
    else if (n < H_BU) src = C_KR + (n - H_KA - 128);
    else if (n < H_VC) src = C_BU + (n - H_BU);
    else if (n < H_KS) src = C_CKVN + 128 + (n - H_VC);
    else if (n < H_VS) src = C_CKVN + 256 + (n - H_KS);
    else if (n < H_KW) src = C_CKVN + 384 + (n - H_VS);
    else if (n < H_VW) src = C_CKVN + 512 + (n - H_KW);
    else if (n < H_GATE) src = C_CKVN + 640 + (n - H_VW);
    else if (n < H_IK) src = C_GATE + (n - H_GATE);
    else if (n < H_IW) src = C_IK + (n - H_IK);
    else if (n < H_END) src = C_IW + (n - H_IW);
    if (src < 0) return 0.f;
    return Win[(size_t)k * NIN + src] * g1[k];
}
__device__ __forceinline__ float winp_val(const float* Win, const float* g1, int k, int n) {
    int src = -1;
    if (n < P_KC) src = C_CQ + n;
    else if (n < P_IQ) src = C_CKVN + (n - P_KC);
    else if (n < P_IK) src = C_IQ + (n - P_IQ);
    if (src < 0) return 0.f;
    return Win[(size_t)k * NIN + src] * g1[k];
}

__device__ __forceinline__ void tile_store(const LAS float* scr, f16* dst, int ldd, int k0, int n0, int lane, bool lo_part, bool skip_absorbed = false) {
    const int c = lane & 7;
#pragma unroll
    for (int j = 0; j < 4; ++j) {
        const int n = (lane >> 3) + 8 * j; const LAS float* s = scr + (8 * c) * 33 + n;
        if (skip_absorbed && (n0 + n) < H_KA && ((n0 + n) % 144) < 128) continue;
        h8 o;
#pragma unroll
        for (int e = 0; e < 8; ++e) { const float v = s[e * 33]; const f16 hi = (f16)v; o[e] = lo_part ? (f16)(v - (float)hi) : hi; }
        *(u32x4*)(dst + (size_t)(n0 + n) * ldd + k0 + 8 * c) = __builtin_bit_cast(u32x4, o);
    }
}

__device__ __forceinline__ void p0_prologue(Frame& F, ArgsP a) {
    LAS float* scr = (LAS float*)(F.lds + F.wave * 16384);
    const int lane = F.lane;
    constexpr int T_INP = (NPREC / 32) * (D / 64), T_INH = (NPLAIN / 32) * (D / 64), T_OUT = (D / 32) * (D / 64), T_UP = (DFF / 32) * (D / 64), T_DOWN = (D / 32) * (DFF / 64);
    constexpr int T_LAYER = T_INP + T_INH + T_OUT + T_UP + T_DOWN;
    for (int it = F.gw; it < DEPTH * T_LAYER; it += F.ngw) {
        const int L = it / T_LAYER; int r = it % T_LAYER;
        const float* Win = gin(a, 3) + (size_t)L * D * NIN; const float* g1 = gin(a, 2) + L * D;
        GAS unsigned char* wl = F.ws + WS_W + (size_t)L * WL_STRIDE;
        int kind, nnb;
        if (r < T_INP) { kind = 0; nnb = T_INP / (D / 64); }
        else if ((r -= T_INP) < T_INH) { kind = 1; nnb = T_INH / (D / 64); }
        else if ((r -= T_INH) < T_OUT) { kind = 2; nnb = T_OUT / (D / 64); }
        else if ((r -= T_OUT) < T_UP) { kind = 3; nnb = T_UP / (D / 64); }
        else { r -= T_UP; kind = 4; nnb = T_DOWN / (DFF / 64); }
        const int kb = r / nnb, nb = r % nnb, n0 = nb * 32, k0 = kb * 64;
        const int kkb = lane >> 5, nn = lane & 31, n = n0 + nn;
        if (kind == 0) {
#pragma unroll 8
            for (int i = 0; i < 32; ++i) { const int kk = 2 * i + kkb; scr[kk * 33 + nn] = winp_val(Win, g1, k0 + kk, n) * WSCALE; }
        } else if (kind == 1) {
            for (int i = 0; i < 32; ++i) { const int kk = 2 * i + kkb; scr[kk * 33 + nn] = winh_val(Win, g1, gin(a, 5) + (size_t)L * 128 * 192, k0 + kk, n); }
        } else if (kind == 2) {
            const float* src = gin(a, 26) + (size_t)L * D * D + n;
            float wv_[32];
#pragma unroll
            for (int i = 0; i < 32; ++i) wv_[i] = src[(size_t)(k0 + 2 * i + kkb) * D];
#pragma unroll
            for (int i = 0; i < 32; ++i) scr[(2 * i + kkb) * 33 + nn] = wv_[i];
        } else if (kind == 3) {
            const float* src = gin(a, 28) + (size_t)L * D * DFF + n; const float* g2 = gin(a, 27) + L * D;
            float wv_[32], gv_[32];
#pragma unroll
            for (int i = 0; i < 32; ++i) { wv_[i] = src[(size_t)(k0 + 2 * i + kkb) * DFF]; gv_[i] = g2[k0 + 2 * i + kkb]; }
#pragma unroll
            for (int i = 0; i < 32; ++i) scr[(2 * i + kkb) * 33 + nn] = wv_[i] * gv_[i];
        } else {
            const float* src = gin(a, 29) + (size_t)L * DFF * D + n;
            float wv_[32];
#pragma unroll
            for (int i = 0; i < 32; ++i) wv_[i] = src[(size_t)(k0 + 2 * i + kkb) * D];
#pragma unroll
            for (int i = 0; i < 32; ++i) scr[(2 * i + kkb) * 33 + nn] = wv_[i];
        }
        lds_fence();
        if (kind == 0) tile_store(scr, (f16*)(wl + WL_INP), D, k0, n0, lane, false);
        else if (kind == 1) tile_store(scr, (f16*)(wl + WL_INH), D, k0, n0, lane, false, true);
        else if (kind == 2) tile_store(scr, (f16*)(wl + WL_OUT), D, k0, n0, lane, false);
        else if (kind == 3) tile_store(scr, (f16*)(wl + WL_UP), D, k0, n0, lane, false);
        else tile_store(scr, (f16*)(wl + WL_DOWN), DFF, k0, n0, lane, false);
        lds_fence();
    }
    for (int it = F.gw; it < DEPTH * 4 * 64; it += F.ngw) {
        const int L = it >> 8, h = (it >> 6) & 3, kb = it & 63, k0 = kb * 16;
        const float* Win = gin(a, 3) + (size_t)L * D * NIN + C_AQ + h * 64 + 16; const float* g1 = gin(a, 2) + L * D;
        const float* wuk = gin(a, 5) + (size_t)L * 128 * 192 + h * 48;
        float wa[48], wb[48];
#pragma unroll
        for (int q4 = 0; q4 < 12; ++q4) { const f32x4 va = *(const f32x4*)(wuk + (size_t)lane * 192 + 4 * q4), vb = *(const f32x4*)(wuk + (size_t)(lane + 64) * 192 + 4 * q4);
#pragma unroll
            for (int e = 0; e < 4; ++e) { wa[4 * q4 + e] = va[e]; wb[4 * q4 + e] = vb[e]; } }
        f16* dst = (f16*)(F.ws + WS_W + (size_t)L * WL_STRIDE + WL_INH) + (size_t)(h * 144) * D + k0;
#pragma unroll
        for (int kh = 0; kh < 2; ++kh) {
            h8 oa, ob;
#pragma unroll
            for (int kk = 0; kk < 8; ++kk) {
                const int k = k0 + kh * 8 + kk; const float* wr_ = Win + (size_t)k * NIN; float sa = 0.f, sb = 0.f;
#pragma unroll
                for (int q4 = 0; q4 < 12; ++q4) { const f32x4 x4 = *(const f32x4*)(wr_ + 4 * q4);
#pragma unroll
                    for (int e = 0; e < 4; ++e) { sa += x4[e] * wa[4 * q4 + e]; sb += x4[e] * wb[4 * q4 + e]; } }
                const float gk = g1[k]; oa[kk] = (f16)(sa * gk); ob[kk] = (f16)(sb * gk);
            }
            *(u32x4*)(dst + (size_t)lane * D + kh * 8) = __builtin_bit_cast(u32x4, oa);
            *(u32x4*)(dst + (size_t)(lane + 64) * D + kh * 8) = __builtin_bit_cast(u32x4, ob);
        }
    }
    {
        const float* x = gin(a, 0); f16* XA = (f16*)(F.ws + WS_XA); float* ss = (float*)(F.ws + WS_SS1);
        for (int m0 = F.gw; m0 < M; m0 += 4 * F.ngw) {
            f32x4 v[4][4];
#pragma unroll
            for (int r = 0; r < 4; ++r)
#pragma unroll
                for (int j = 0; j < 4; ++j) v[r][j] = *(const f32x4*)(x + (size_t)min(m0 + r * F.ngw, M - 1) * D + j * 256 + lane * 4);
#pragma unroll
            for (int r = 0; r < 4; ++r) {
                const int m = m0 + r * F.ngw;
                if (m < M) {
                    float sq = 0.f;
#pragma unroll
                    for (int j = 0; j < 4; ++j) {
                        const f32x4 vv = v[r][j];
                        sq += (vv[0] * vv[0] + vv[1] * vv[1]) + (vv[2] * vv[2] + vv[3] * vv[3]);
                        h4 hi;
#pragma unroll
                        for (int e = 0; e < 4; ++e) hi[e] = (f16)(vv[e] * XSCALE);
                        *(u32x2*)(XA + (size_t)m * D + j * 256 + lane * 4) = __builtin_bit_cast(u32x2, hi);
                    }
                    sq = wave_sum(sq);
                    if (lane < 16) ss[(size_t)m * 16 + lane] = (lane == 0) ? sq : 0.f;
                }
            }
        }
    }
    {
        const int* pos = (const int*)gin(a, 1); float* R = (float*)(F.ws + WS_ROPE);
        for (int m = F.bx * NTHREADS + F.tid; m < M; m += F.G * NTHREADS) {
            const float p = (float)pos[m];
#pragma unroll
            for (int i = 0; i < 8; ++i) { const float ang = p * a->inv16[i]; R[(size_t)m * 8 + i] = (float)cos((double)ang); R[(size_t)M * 8 + (size_t)m * 8 + i] = (float)sin((double)ang); }
#pragma unroll
            for (int i = 0; i < 4; ++i) { const float ang = p * a->inv8[i]; R[(size_t)M * 16 + (size_t)m * 4 + i] = (float)cos((double)ang); R[(size_t)M * 20 + (size_t)m * 4 + i] = (float)sin((double)ang); }
        }
    }
    for (int idx = F.bx * NTHREADS + F.tid; idx < DEPTH * 1024; idx += F.G * NTHREADS) {
        const int L = idx >> 10, gp = idx & 1023, g = gp >> 6;
        float* C = (float*)(F.ws + WS_S5C) + (size_t)L * S5C_STRIDE;
        const double lr = gin(a, 7)[L * 1024 + gp], li = gin(a, 8)[L * 1024 + gp], step = exp((double)gin(a, 9)[L * 16 + g]);
        const double mag = exp(lr * step), th = li * step, ar = mag * cos(th), ai = mag * sin(th);
        C[S5_AR + gp] = (float)ar; C[S5_AI + gp] = (float)ai;
    }
    for (int idx = F.bx * NTHREADS + F.tid; idx < DEPTH * 1024; idx += F.G * NTHREADS) {
        const int k = 1, gp = idx & 1023, L = idx >> 10, g = gp >> 6;
        float* C = (float*)(F.ws + WS_S5C) + (size_t)L * S5C_STRIDE;
        const double lr = gin(a, 7)[L * 1024 + gp], li = gin(a, 8)[L * 1024 + gp], step = exp((double)gin(a, 9)[L * 16 + g]);
        const double e = 64.0 * k, mg = exp(lr * step * e), an = li * step * e;
        C[S5_ATR + k * 1024 + gp] = (float)(mg * cos(an)); C[S5_ATI + k * 1024 + gp] = (float)(mg * sin(an));
    }
    for (int idx = F.bx * NTHREADS + F.tid; idx < DEPTH * 16 * 128 * 16; idx += F.G * NTHREADS) {
        const int ch = idx & 15, col = (idx >> 4) & 127, g = (idx >> 11) & 15, L = idx >> 15, p = col & 63, gp = g * 64 + p;
        const double lr = gin(a, 7)[L * 1024 + gp], li = gin(a, 8)[L * 1024 + gp], step = exp((double)gin(a, 9)[L * 16 + g]);
        const double mag = exp(lr * step), th = li * step, ar = mag * cos(th), ai = mag * sin(th);
        const double den = lr * lr + li * li, zr = ((ar - 1.0) * lr + ai * li) / den, zi = (ai * lr - (ar - 1.0) * li) / den;
        const double br = gin(a, 10)[(size_t)L * 16384 + gp * 16 + ch], bi = gin(a, 11)[(size_t)L * 16384 + gp * 16 + ch];
        ((f16*)(F.ws + WS_BBT))[idx] = (f16)(256.0 * ((col < 64) ? (zr * br - zi * bi) : (zr * bi + zi * br)));
    }
    for (int idx = F.bx * NTHREADS + F.tid; idx < DEPTH * 2 * 64 * 2048; idx += F.G * NTHREADS) {
        const int col = idx & 63, k = (idx >> 6) & 2047, kv = (idx >> 17) & 1, L = idx >> 18;
        const float v = gin(a, kv ? 21 : 19)[(size_t)L * 2048 * 64 + (size_t)k * 64 + col] * WSCALE;
        const f16 hi = (f16)v;
        f16* d = (f16*)(F.ws + WS_W1T) + ((((size_t)((L * 2 + kv) * 2) * 2 + (col >> 5)) * 128 + (k >> 4)) * 64 + (col & 31) + 32 * ((k >> 3) & 1)) * 8 + (k & 7);
        d[0] = hi; if constexpr (SPLIT) d[(size_t)2 * 128 * 512] = (f16)(v - (float)hi);
    }
    for (int idx = F.bx * NTHREADS + F.tid; idx < DEPTH * 16 * 32 * 128; idx += F.G * NTHREADS) {
        const int k = idx & 127, ho = (idx >> 7) & 31, g = (idx >> 12) & 15, L = idx >> 16;
        float v = 0.f;
        if (ho < 16) v = (k < 64) ? gin(a, 12)[(size_t)L * 16384 + (g * 16 + ho) * 64 + k] : -gin(a, 13)[(size_t)L * 16384 + (g * 16 + ho) * 64 + (k - 64)];
        ((f16*)(F.ws + WS_CMT))[((((size_t)(L * 16 + g) * 8 + (k >> 4)) * 64 + ho + 32 * ((k >> 3) & 1)) * 8) + (k & 7)] = (f16)v;
    }
    for (int idx = F.bx * NTHREADS + F.tid; idx < DEPTH * 65536; idx += F.G * NTHREADS) {
        const int col = idx & 255, k = (idx >> 8) & 255, L = idx >> 16;
        ((f16*)(F.ws + WS_GLUT))[((((size_t)(L * 8 + (col >> 5)) * 16 + (k >> 4)) * 64 + (col & 31) + 32 * ((k >> 3) & 1)) * 8) + (k & 7)] = (f16)gin(a, 15)[(size_t)L * 65536 + k * 256 + col];
    }
    for (int idx = F.bx * NTHREADS + F.tid; idx < DEPTH * 4 * 64 * 128; idx += F.G * NTHREADS) {
        const int r = idx & 127, v = (idx >> 7) & 63, h = (idx >> 13) & 3, L = idx >> 15;
        ((f16*)(F.ws + WS_WUVT))[idx] = (f16)gin(a, 6)[(size_t)L * 128 * 256 + r * 256 + h * 64 + v];
    }
    for (int it = F.gw; it < DEPTH * 2 * 32; it += F.ngw) {
        const int L = it >> 6, kv = (it >> 5) & 1, part = it & 31;
        const float* pos = gin(a, 17 + kv) + (size_t)L * 2048 + part * 64; const float* w1 = gin(a, kv ? 21 : 19) + (size_t)L * 2048 * 64 + (size_t)part * 64 * 64;
        float s = 0.f;
#pragma unroll 16
        for (int i = 0; i < 64; ++i) s += pos[i] * w1[(size_t)i * 64 + lane];
        ((float*)(F.ws + WS_S5C) + (size_t)L * S5C_STRIDE + S5_CB)[(part * 2 + kv) * 64 + lane] = s;
    }
}

__device__ __forceinline__ void rope_f16(f16* q, int i, int half, float c, float s) {
    const float x1 = (float)q[i], x2 = (float)q[i + half];
    q[i] = (f16)(x1 * c - x2 * s); q[i + half] = (f16)(x2 * c + x1 * s);
}
__device__ __forceinline__ void rope16h(f16* p, const float* cs, const float* sn) {
    const h8 a = *(const h8*)p, b = *(const h8*)(p + 8);
    const f32x4 c0 = *(const f32x4*)cs, c1 = *(const f32x4*)(cs + 4), s0 = *(const f32x4*)sn, s1 = *(const f32x4*)(sn + 4);
    const float c[8] = {c0[0], c0[1], c0[2], c0[3], c1[0], c1[1], c1[2], c1[3]}, s[8] = {s0[0], s0[1], s0[2], s0[3], s1[0], s1[1], s1[2], s1[3]};
    h8 oa, ob;
#pragma unroll
    for (int i = 0; i < 8; ++i) { const float x1 = (float)a[i], x2 = (float)b[i]; oa[i] = (f16)(x1 * c[i] - x2 * s[i]); ob[i] = (f16)(x2 * c[i] + x1 * s[i]); }
    *(h8*)p = oa; *(h8*)(p + 8) = ob;
}
__device__ __forceinline__ void rope8f(float* p, const float* cs, const float* sn) {
    const f32x4 a = *(const f32x4*)p, b = *(const f32x4*)(p + 4), c = *(const f32x4*)cs, s = *(const f32x4*)sn;
    *(f32x4*)p = a * c - b * s; *(f32x4*)(p + 4) = b * c + a * s;
}
__device__ __forceinline__ void p2_finalize(Frame& F, int L, ArgsP a) {
    const int lane = F.lane, l = lane & 15;
    float* PP = (float*)(F.ws + WS_PP); f16* PH = (f16*)(F.ws + WS_PH); const float* R = (const float*)(F.ws + WS_ROPE);
    const float* kvg = gin(a, 4) + L * 128 + 8 * l;
    const f32x4 kg0 = *(const f32x4*)kvg, kg1 = *(const f32x4*)(kvg + 4);
    const int off = (l < 4) ? H_QA + l * 144 + 128 : (l == 4) ? H_KA + 128 : (l < 7) ? H_KS + (l - 5) * 64 : H_KW + (l - 7) * 64;
    for (int m0 = F.gw * 4; m0 < M; m0 += F.ngw * 4) {
        const int m = m0 + (lane >> 4);
        float* pp = PP + (size_t)m * PP_LD; f16* ph = PH + (size_t)m * PH_LD;
        const char* src0 = (l < 9) ? (const char*)(ph + off) : (l < 13) ? (const char*)(pp + P_IQ + (l - 9) * 32) : (l == 13) ? (const char*)(ph + H_IK) : (l == 14) ? (const char*)(ph + H_IW) : (const char*)(ph + H_GATE);
        const char* src1 = (l >= 9 && l < 13) ? src0 + 64 : src0;
        u32x4 pre[4], pre2[4];
#pragma unroll
        for (int i = 0; i < 4; ++i) pre[i] = *(const u32x4*)(src0 + 16 * i);
#pragma unroll
        for (int i = 0; i < 4; ++i) pre2[i] = *(const u32x4*)(src1 + 16 * i);
        const float* c16 = R + (size_t)m * 8; const float* s16 = R + (size_t)M * 8 + (size_t)m * 8;
        const float* c8 = R + (size_t)M * 16 + (size_t)m * 4; const float* s8 = R + (size_t)M * 20 + (size_t)m * 4;
        f32x4 c16a = *(const f32x4*)c16, c16b = *(const f32x4*)(c16 + 4), s16a = *(const f32x4*)s16, s16b = *(const f32x4*)(s16 + 4), c8v = *(const f32x4*)c8, s8v = *(const f32x4*)s8;
        h8 cv = *(const h8*)(ph + H_KA + 8 * l);
#pragma unroll
        for (int i = 0; i < 4; ++i) { asm volatile("" : "+v"(pre[i])); asm volatile("" : "+v"(pre2[i])); }
        asm volatile("" : "+v"(c16a), "+v"(c16b), "+v"(s16a), "+v"(s16b), "+v"(c8v), "+v"(s8v), "+v"(cv));
        float cf[8]; float sq = 0.f;
#pragma unroll
        for (int i = 0; i < 8; ++i) { cf[i] = (float)cv[i]; sq += cf[i] * cf[i]; }
        sq += dpp_f<0xB1>(sq); sq += dpp_f<0x4E>(sq); sq += dpp_f<0x141>(sq); sq += dpp_f<0x140>(sq);
        if (l < 9) {
            const h8 ra = __builtin_bit_cast(h8, pre[0]), rb = __builtin_bit_cast(h8, pre[1]);
            const float c[8] = {c16a[0], c16a[1], c16a[2], c16a[3], c16b[0], c16b[1], c16b[2], c16b[3]}, sn[8] = {s16a[0], s16a[1], s16a[2], s16a[3], s16b[0], s16b[1], s16b[2], s16b[3]};
            h8 oa, ob;
#pragma unroll
            for (int i = 0; i < 8; ++i) { const float x1 = (float)ra[i], x2 = (float)rb[i]; oa[i] = (f16)(x1 * c[i] - x2 * sn[i]); ob[i] = (f16)(x2 * c[i] + x1 * sn[i]); }
            *(h8*)(ph + off) = oa; *(h8*)(ph + off + 8) = ob;
        }
        else if (l < 14) {
            f32x4 x[8];
            if (l == 13) {
#pragma unroll
                for (int c4 = 0; c4 < 4; ++c4) { const h8 kh = __builtin_bit_cast(h8, pre[c4]);
                    x[2 * c4] = (f32x4){(float)kh[0], (float)kh[1], (float)kh[2], (float)kh[3]}; x[2 * c4 + 1] = (f32x4){(float)kh[4], (float)kh[5], (float)kh[6], (float)kh[7]}; }
            } else {
#pragma unroll
                for (int i = 0; i < 4; ++i) { x[i] = __builtin_bit_cast(f32x4, pre[i]); x[4 + i] = __builtin_bit_cast(f32x4, pre2[i]); }
            }
            { const f32x4 ra = x[0] * c8v - x[1] * s8v, rb = x[1] * c8v + x[0] * s8v; x[0] = ra; x[1] = rb; }
            f16* dh = (f16*)(pp + P_IQS) + (l - 9) * 32; f16* dl = dh + 128;
            f16* kt = (f16*)(F.ws + WS_IKT) + ((size_t)(m >> 5) * 256 + (m & 31)) * 8;
#pragma unroll
            for (int c4 = 0; c4 < 4; ++c4) {
                const f32x4 x0 = x[2 * c4], x1 = x[2 * c4 + 1];
                h8 hi, lo;
#pragma unroll
                for (int e = 0; e < 4; ++e) { const float a0 = x0[e] * ISC, a1 = x1[e] * ISC; hi[e] = (f16)a0; lo[e] = (f16)(a0 - (float)hi[e]); hi[4 + e] = (f16)a1; lo[4 + e] = (f16)(a1 - (float)hi[4 + e]); }
                if (l == 13) { *(h8*)(kt + ((c4 >> 1) * 64 + 32 * (c4 & 1)) * 8) = hi; if constexpr (SPLIT) *(h8*)(kt + ((2 + (c4 >> 1)) * 64 + 32 * (c4 & 1)) * 8) = lo; }
                else { *(h8*)(dh + 8 * c4) = hi; if constexpr (SPLIT) *(h8*)(dl + 8 * c4) = lo; }
            }
        }
        else if (l == 14) { const h8 wh = __builtin_bit_cast(h8, pre[0]); *(f32x4*)(pp + P_IW) = (f32x4){(float)wh[0], (float)wh[1], (float)wh[2], (float)wh[3]} * 0.5f; }
        else {
#pragma unroll
            for (int j = 0; j < 3; ++j) { h8 g = __builtin_bit_cast(h8, pre[j]);
#pragma unroll
                for (int i = 0; i < 8; ++i) g[i] = (f16)sigmoidf((float)g[i]);
                *(h8*)(ph + H_GATE + 8 * j) = g; }
        }
        const float rk = rsqrtf(sq * (1.f / 128.f) + EPS);
        h8 co;
#pragma unroll
        for (int i = 0; i < 4; ++i) { co[i] = (f16)(cf[i] * rk * kg0[i]); co[4 + i] = (f16)(cf[4 + i] * rk * kg1[i]); }
        *(h8*)(ph + H_KA + 8 * l) = co;
    }
}

__device__ __forceinline__ void p2_compress(Frame& F, int L, ArgsP a) {
    const int w = F.wave;
    const float* PP = (const float*)(F.ws + WS_PP); const f16* PH = (const f16*)(F.ws + WS_PH);
    constexpr int TRS = 144, TSZ = 272 * TRS;
    LAS unsigned char* TH = F.lds; LAS unsigned char* TL = F.lds + TSZ;
    LAS float* part = (LAS float*)(F.lds + 2 * TSZ);
    const float* CB = (const float*)(F.ws + WS_S5C) + (size_t)L * S5C_STRIDE + S5_CB;
    constexpr float ASC = 8.f;
    float cbs0 = 0.f, cbs1 = 0.f;
    {
        const int lane = F.lane;
        float t0[32], t1[32];
#pragma unroll
        for (int q = 0; q < 32; ++q) { t0[q] = CB[(q * 2 + 0) * 64 + lane]; t1[q] = CB[(q * 2 + 1) * 64 + lane]; }
#pragma unroll
        for (int q = 0; q < 32; ++q) { cbs0 += t0[q]; cbs1 += t1[q]; }
    }
    for (int it = F.bx; it < 512; it += F.G) {
        const int kv = it >> 8, b = (it >> 5) & 7, g = (it >> 4) & 1, nb = it & 15, n0 = nb * 16, tok0 = n0 * 16;
        int tid_ = F.tid; asm volatile("" : "+v"(tid_));
        const int lane = tid_ & 63, hf = lane >> 5, r31 = lane & 31;
        f32x4 tx0[5], tx1[5]; h8 thv[5];
#pragma unroll
        for (int j = 0; j < 5; ++j) {
            const int e = tid_ + j * NTHREADS, tl = e >> 3, c8 = e & 7, tok = min(tok0 + tl, SEQ - 1);
            if (kv == 0) { const float* p = PP + (size_t)(b * SEQ + tok) * PP_LD + P_KC + g * 64 + c8 * 8; tx0[j] = *(const f32x4*)p; tx1[j] = *(const f32x4*)(p + 4); }
            else thv[j] = *(const h8*)(PH + (size_t)(b * SEQ + tok) * PH_LD + H_VC + g * 64 + c8 * 8);
        }
        const f16* wt = (const f16*)(F.ws + WS_W1T) + (((size_t)((L * 2 + kv) * 2) * 2 * 128 + 16 * w) * 64 + lane) * 8;
        __syncthreads();
#pragma unroll
        for (int j = 0; j < 5; ++j) {
            const int e = tid_ + j * NTHREADS, tl = e >> 3, c8 = e & 7, tok = tok0 + tl; h8 hi, lo;
            if (e < 272 * 8) {
#pragma unroll
                for (int i = 0; i < 8; ++i) { hi[i] = (f16)0.f; lo[i] = (f16)0.f; }
                if (tok < SEQ) {
                    if (kv == 0) {
                        const f32x4 x0 = tx0[j], x1 = tx1[j];
#pragma unroll
                        for (int i = 0; i < 4; ++i) { const float a0 = x0[i] * ASC, a1 = x1[i] * ASC; hi[i] = (f16)a0; lo[i] = (f16)(a0 - (float)hi[i]); hi[4 + i] = (f16)a1; lo[4 + i] = (f16)(a1 - (float)hi[4 + i]); }
                    } else {
                        const h8 hv = thv[j];
#pragma unroll
                        for (int i = 0; i < 8; ++i) hi[i] = (f16)((float)hv[i] * ASC);
                    }
                }
                *(LAS h8*)(TH + tl * TRS + c8 * 16) = hi; if constexpr (SPLIT) *(LAS h8*)(TL + tl * TRS + c8 * 16) = lo;
            }
        }
        h8 fb0[16], fb1[16];
#pragma unroll
        for (int s_ = 0; s_ < 16; ++s_) { fb0[s_] = *(const h8*)(wt + (size_t)s_ * 512); fb1[s_] = *(const h8*)(wt + (size_t)(128 + s_) * 512); }
        __syncthreads();
        f32x16 A0, A1;
#pragma unroll
        for (int i = 0; i < 16; ++i) { A0[i] = 0.f; A1[i] = 0.f; }
        {
            const int nl = (r31 < 16) ? r31 : 15;
#pragma unroll
            for (int s_ = 0; s_ < 16; ++s_) {
                const int kg0 = 256 * w + 16 * s_, l = kg0 >> 6, d0 = (kg0 & 63) + 8 * hf;
                const int off = (16 * nl + l) * TRS + d0 * 2;
                const h8 ah = *(const LAS h8*)(TH + off);
                A0 = MFMA32(ah, fb0[s_], A0); A1 = MFMA32(ah, fb1[s_], A1);
                if (SPLIT && kv == 0) {
                    const h8 al = *(const LAS h8*)(TL + off);
                    const h8 bl0 = *(const h8*)(wt + (size_t)(256 + s_) * 512), bl1 = *(const h8*)(wt + (size_t)(384 + s_) * 512);
                    A0 = MFMA32(ah, bl0, A0); A1 = MFMA32(ah, bl1, A1);
                    A0 = MFMA32(al, fb0[s_], A0); A1 = MFMA32(al, fb1[s_], A1);
                }
            }
        }
        const float* w2 = gin(a, kv ? 22 : 20) + (size_t)L * 64 * 64;
        float wv[64];
#pragma unroll
        for (int i = 0; i < 64; ++i) wv[i] = w2[i * 64 + lane];
#pragma unroll
        for (int i = 0; i < 8; ++i) { const int row = (i & 3) + 8 * (i >> 2) + 4 * hf; part[(w * 16 + row) * 64 + r31] = A0[i]; part[(w * 16 + row) * 64 + 32 + r31] = A1[i]; }
        __syncthreads();
        float acc0 = 0.f, acc1 = 0.f;
#pragma unroll
        for (int ww = 0; ww < 8; ++ww) { acc0 += part[(ww * 16 + 2 * w) * 64 + lane]; acc1 += part[(ww * 16 + 2 * w + 1) * 64 + lane]; }
        const float cb = kv ? cbs1 : cbs0;
        const float osc = 1.f / (ASC * WSCALE);
        const float h0 = gelu_tanh(acc0 * osc + cb), h1 = gelu_tanh(acc1 * osc + cb);
        float o0 = 0.f, o1 = 0.f;
#pragma unroll
        for (int i = 0; i < 64; ++i) {
            o0 += __builtin_bit_cast(float, __builtin_amdgcn_readlane(__builtin_bit_cast(int, h0), i)) * wv[i];
            o1 += __builtin_bit_cast(float, __builtin_amdgcn_readlane(__builtin_bit_cast(int, h1), i)) * wv[i];
        }
        float* dst = (float*)(F.ws + (kv ? WS_VCMP : WS_KCMP));
        const int na = n0 + 2 * w, nb2 = na + 1;
        if (na < 255) dst[((size_t)(b * 256 + na) * 2 + g) * 64 + lane] = o0;
        if (nb2 < 255) dst[((size_t)(b * 256 + nb2) * 2 + g) * 64 + lane] = o1;
    }
    __syncthreads();
}

__device__ __forceinline__ void s5_load_u(Frame& F, LAS float* ul, int b, int g, int c) {
    const f16* PH = (const f16*)(F.ws + WS_PH);
    const f16* p = PH + (size_t)(b * SEQ + c * 64 + F.lane) * PH_LD + H_BU + g * 16;
    const h8 u0 = *(const h8*)p, u1 = *(const h8*)(p + 8);
    LAS float* d = ul + F.lane * 16;
    *(LAS f32x4*)(d) = (f32x4){(float)u0[0], (float)u0[1], (float)u0[2], (float)u0[3]};
    *(LAS f32x4*)(d + 4) = (f32x4){(float)u0[4], (float)u0[5], (float)u0[6], (float)u0[7]};
    *(LAS f32x4*)(d + 8) = (f32x4){(float)u1[0], (float)u1[1], (float)u1[2], (float)u1[3]};
    *(LAS f32x4*)(d + 12) = (f32x4){(float)u1[4], (float)u1[5], (float)u1[6], (float)u1[7]};
    lds_fence();
}
__device__ __forceinline__ void p2_s5_local(Frame& F, int L) {
    const int lane = F.lane, hf = lane >> 5, r31 = lane & 31;
    const float* C = (const float*)(F.ws + WS_S5C) + (size_t)L * S5C_STRIDE;
    constexpr int HRS = 272;
    LAS unsigned char* ht = F.lds + F.wave * (32 * HRS);
    f32x2* HL = (f32x2*)(F.ws + WS_HLOC);
    for (int it = F.gw; it < 8 * 16 * 64; it += F.ngw) {
        const int b = it >> 10, g = (it >> 6) & 15, c = it & 63, gp = g * 64 + lane;
        const float ar = C[S5_AR + gp], ai = C[S5_AI + gp];
        h8 bb[4];
        {
            const f16* bp_ = (const f16*)(F.ws + WS_BBT) + ((size_t)((L * 16 + g) * 128 + r31)) * 16 + 8 * hf;
#pragma unroll
            for (int ct = 0; ct < 4; ++ct) bb[ct] = *(const h8*)(bp_ + (size_t)ct * 32 * 16);
        }
        const f16* up = (const f16*)(F.ws + WS_PH) + (size_t)(b * SEQ + c * 64 + r31) * PH_LD + H_BU + g * 16 + 8 * hf;
        const h8 uf0 = *(const h8*)up, uf1 = *(const h8*)(up + (size_t)32 * PH_LD);
        float hr = 0.f, hi = 0.f;
#pragma unroll
        for (int half = 0; half < 2; ++half) {
#pragma unroll
            for (int ct = 0; ct < 4; ++ct) {
                f32x16 X;
#pragma unroll
                for (int i = 0; i < 16; ++i) X[i] = 0.f;
                X = MFMA32(half ? uf1 : uf0, bb[ct], X);
#pragma unroll
                for (int i = 0; i < 16; ++i) *(LAS f16*)(ht + ((i & 3) + 8 * (i >> 2) + 4 * hf) * HRS + (32 * ct + r31) * 2) = (f16)X[i];
            }
            lds_fence();
#pragma unroll 8
            for (int jj = 0; jj < 32; ++jj) {
                const float xr = (float)*(const LAS f16*)(ht + jj * HRS + lane * 2) * (1.f / 256.f), xi = (float)*(const LAS f16*)(ht + jj * HRS + 128 + lane * 2) * (1.f / 256.f);
                const float nr = ar * hr - ai * hi + xr, ni = ar * hi + ai * hr + xi; hr = nr; hi = ni;
            }
            lds_fence();
        }
        HL[(size_t)it * 64 + lane] = (f32x2){hr, hi};
    }
}

__device__ __forceinline__ void p4_s5_out(Frame& F, int L, ArgsP a) {
    const int lane = F.lane, w = F.wave, tid = F.tid;
    const float* C = (const float*)(F.ws + WS_S5C) + (size_t)L * S5C_STRIDE;
    LAS f16* yh = (LAS f16*)F.lds;
    LAS float* ul = (LAS float*)(F.lds + 34816 + w * 4096);
    constexpr int HRS = 272;
    LAS unsigned char* ht = F.lds + 67584 + w * (32 * HRS);
    LAS float* bo = (LAS float*)(F.lds + 34816);
    const f32x2* HL = (const f32x2*)(F.ws + WS_HLOC);
    f16* MIX = (f16*)(F.ws + WS_XA);
    const float* dvec = gin(a, 14) + L * 256;
    const float* glub = gin(a, 16) + L * 256; const float* gainb = gin(a, 24) + L * 256;
    const int hf = lane >> 5, r31 = lane & 31;
    for (int it = F.bx; it < 512; it += F.G) {
        const int b = it & 7, cc = (it >> 3) & 31, c = (it < 256) ? cc : 63 - cc;
        __syncthreads();
        for (int gi = 0; gi < 2; ++gi) {
            const int g = 2 * w + gi, gp = g * 64 + lane;
            const float ar = C[S5_AR + gp], ai = C[S5_AI + gp];
            h8 bb[4], cm[8];
            {
                const f16* bp_ = (const f16*)(F.ws + WS_BBT) + ((size_t)((L * 16 + g) * 128 + r31)) * 16 + 8 * hf;
#pragma unroll
                for (int ct = 0; ct < 4; ++ct) bb[ct] = *(const h8*)(bp_ + (size_t)ct * 32 * 16);
                const f16* cp_ = (const f16*)(F.ws + WS_CMT) + ((size_t)(L * 16 + g) * 8 * 64 + lane) * 8;
#pragma unroll
                for (int s = 0; s < 8; ++s) cm[s] = *(const h8*)(cp_ + (size_t)s * 512);
            }
            const float dho = (r31 < 16) ? dvec[g * 16 + r31] : 0.f;
            const f16* up = (const f16*)(F.ws + WS_PH) + (size_t)(b * SEQ + c * 64 + r31) * PH_LD + H_BU + g * 16 + 8 * hf;
            const h8 ufa = *(const h8*)up, ufb = *(const h8*)(up + (size_t)32 * PH_LD);
            const f16* pu = (const f16*)(F.ws + WS_PH) + (size_t)(b * SEQ + c * 64 + lane) * PH_LD + H_BU + g * 16;
            const h8 pu0 = *(const h8*)pu, pu1 = *(const h8*)(pu + 8);
            float hr = 0.f, hi = 0.f;
            const float tr = C[S5_ATR + 1024 + gp], ti = C[S5_ATI + 1024 + gp];
            for (int cp0 = 0; cp0 < c; cp0 += 16) {
                f32x2 hl[16];
#pragma unroll
                for (int i = 0; i < 16; ++i) hl[i] = HL[((size_t)((b * 16 + g) * 64 + min(cp0 + i, c - 1))) * 64 + lane];
                if (cp0 + 16 <= c) {
#pragma unroll
                    for (int i = 0; i < 16; ++i) { const float nr = (hr * tr - hi * ti) + hl[i][0], ni = (hr * ti + hi * tr) + hl[i][1]; hr = nr; hi = ni; }
                } else {
#pragma unroll
                    for (int i = 0; i < 16; ++i) if (cp0 + i < c) { const float nr = (hr * tr - hi * ti) + hl[i][0], ni = (hr * ti + hi * tr) + hl[i][1]; hr = nr; hi = ni; }
                }
            }
            {
                LAS float* d = ul + lane * 16;
                *(LAS f32x4*)(d) = (f32x4){(float)pu0[0], (float)pu0[1], (float)pu0[2], (float)pu0[3]};
                *(LAS f32x4*)(d + 4) = (f32x4){(float)pu0[4], (float)pu0[5], (float)pu0[6], (float)pu0[7]};
                *(LAS f32x4*)(d + 8) = (f32x4){(float)pu1[0], (float)pu1[1], (float)pu1[2], (float)pu1[3]};
                *(LAS f32x4*)(d + 12) = (f32x4){(float)pu1[4], (float)pu1[5], (float)pu1[6], (float)pu1[7]};
                lds_fence();
            }
            for (int half = 0; half < 2; ++half) {
                {
                    const h8 uf = half ? ufb : ufa;
#pragma unroll
                    for (int ct = 0; ct < 4; ++ct) {
                        f32x16 X;
#pragma unroll
                        for (int i = 0; i < 16; ++i) X[i] = 0.f;
                        X = MFMA32(uf, bb[ct], X);
#pragma unroll
                        for (int i = 0; i < 16; ++i) *(LAS f16*)(ht + ((i & 3) + 8 * (i >> 2) + 4 * hf) * HRS + (32 * ct + r31) * 2) = (f16)X[i];
                    }
                }
                lds_fence();
                {
                    f16 xr16[32], xi16[32];
#pragma unroll
                    for (int jj = 0; jj < 32; ++jj) { xr16[jj] = *(const LAS f16*)(ht + jj * HRS + lane * 2); xi16[jj] = *(const LAS f16*)(ht + jj * HRS + 128 + lane * 2); }
#pragma unroll
                    for (int jj = 0; jj < 32; ++jj) {
                        const float xr = (float)xr16[jj] * (1.f / 256.f), xi = (float)xi16[jj] * (1.f / 256.f);
                        const float nr = ar * hr - ai * hi + xr, ni = ar * hi + ai * hr + xi; hr = nr; hi = ni;
                        *(LAS f16*)(ht + jj * HRS + lane * 2) = (f16)hr; *(LAS f16*)(ht + jj * HRS + 128 + lane * 2) = (f16)hi;
                    }
                }
                lds_fence();
                f32x16 Y;
#pragma unroll
                for (int i = 0; i < 16; ++i) Y[i] = 0.f;
#pragma unroll
                for (int s = 0; s < 8; ++s) { const h8 af = *(const LAS h8*)(ht + r31 * HRS + (16 * s + 8 * hf) * 2); Y = MFMA32(af, cm[s], Y); }
                if (r31 < 16) {
#pragma unroll
                    for (int i = 0; i < 16; ++i) {
                        const int tok = half * 32 + (i & 3) + 8 * (i >> 2) + 4 * hf;
                        const float y = Y[i] + dho * ul[tok * 16 + r31];
                        yh[tok * 264 + g * 16 + r31] = (f16)gelu_tanh(y);
                    }
                }
                lds_fence();
            }
        }
        __syncthreads();
        {
            const int hf = lane >> 5, r31 = lane & 31, col = 32 * w + r31;
            f32x16 G0, G1;
#pragma unroll
            for (int i = 0; i < 16; ++i) { G0[i] = 0.f; G1[i] = 0.f; }
            const f16* bp = (const f16*)(F.ws + WS_GLUT) + ((size_t)(L * 8 + w) * 16 * 64 + lane) * 8;
            LAS const f16* ap = yh + r31 * 264 + 8 * hf;
            h8 bfv[16];
#pragma unroll
            for (int s = 0; s < 16; ++s) bfv[s] = *(const h8*)(bp + (size_t)s * 512);
#pragma unroll
            for (int s = 0; s < 16; ++s) {
                const h8 a0 = *(const LAS h8*)(ap + 16 * s), a1 = *(const LAS h8*)(ap + 32 * 264 + 16 * s);
                G0 = MFMA32(a0, bfv[s], G0); G1 = MFMA32(a1, bfv[s], G1);
            }
            const float gb = glub[col];
#pragma unroll
            for (int i = 0; i < 16; ++i) {
                const int t0_ = (i & 3) + 8 * (i >> 2) + 4 * hf, t1_ = t0_ + 32;
                bo[t0_ * 256 + col] = (float)yh[t0_ * 264 + col] * sigmoidf(G0[i] + gb);
                bo[t1_ * 256 + col] = (float)yh[t1_ * 264 + col] * sigmoidf(G1[i] + gb);
            }
        }
        __syncthreads();
        const f32x4 gn = *(const f32x4*)(gainb + lane * 4);
        for (int i = 0; i < 8; ++i) {
            const int tok = w * 8 + i; const f32x4 v = *(const LAS f32x4*)(bo + tok * 256 + lane * 4);
            float sq = (v[0] * v[0] + v[1] * v[1]) + (v[2] * v[2] + v[3] * v[3]); sq = wave_sum(sq);
            const float r = rsqrtf(sq * (1.f / 256.f) + EPS);
            h4 o; o[0] = (f16)(v[0] * r * gn[0]); o[1] = (f16)(v[1] * r * gn[1]); o[2] = (f16)(v[2] * r * gn[2]); o[3] = (f16)(v[3] * r * gn[3]);
            *(u32x2*)(MIX + (size_t)(b * SEQ + c * 64 + tok) * D + 256 + lane * 4) = __builtin_bit_cast(u32x2, o);
        }
    }
    __syncthreads();
}

constexpr int NSA_WSTRIDE = 10240;
struct OS { float m[4], l[4], o[4]; };
__device__ __forceinline__ void nsa_block(Frame& F, OS& st, const LAS float* qr, LAS float* pl, const f16* rowbase  , int tok0, bool valid, int kcol, int vcol) {
    const int lane = F.lane;
    const f16* kp = rowbase + (size_t)(tok0 + lane) * PH_LD + kcol;
    float s0 = 0.f, s1 = 0.f, s2 = 0.f, s3 = 0.f;
#pragma unroll 2
    for (int c8 = 0; c8 < 8; ++c8) {
        const h8 k8 = *(const h8*)(kp + c8 * 8);
#pragma unroll
        for (int q4 = 0; q4 < 2; ++q4) {
            const int d = c8 * 8 + q4 * 4;
            const f32x4 a0 = *(const LAS f32x4*)(qr + d), a1 = *(const LAS f32x4*)(qr + 64 + d), a2 = *(const LAS f32x4*)(qr + 128 + d), a3 = *(const LAS f32x4*)(qr + 192 + d);
#pragma unroll
            for (int e = 0; e < 4; ++e) { const float kf = (float)k8[q4 * 4 + e]; s0 += a0[e] * kf; s1 += a1[e] * kf; s2 += a2[e] * kf; s3 += a3[e] * kf; }
        }
    }
    float sv[4] = {s0, s1, s2, s3}; float al[4]; f32x4 pv;
#pragma unroll
    for (int h = 0; h < 4; ++h) {
        const float s = valid ? sv[h] : -1e30f;
        const float bm = wave_max(s), mn = fmaxf(st.m[h], bm);
        al[h] = __expf(st.m[h] - mn);
        const float p = valid ? __expf(s - mn) : 0.f;
        st.l[h] = st.l[h] * al[h] + wave_sum(p); st.m[h] = mn; st.o[h] *= al[h]; pv[h] = p;
    }
    *(LAS f32x4*)(pl + lane * 4) = pv;
    lds_fence();
    const f16* vp = rowbase + (size_t)tok0 * PH_LD + vcol + lane;
#pragma unroll 8
    for (int i = 0; i < 64; ++i) {
        const float v = (float)vp[(size_t)i * PH_LD]; const f32x4 p4 = *(const LAS f32x4*)(pl + i * 4);
        st.o[0] += p4[0] * v; st.o[1] += p4[1] * v; st.o[2] += p4[2] * v; st.o[3] += p4[3] * v;
    }
    lds_fence();
}
__device__ __forceinline__ void nsa_token(Frame& F, int L, ArgsP a, int b, int t, LAS unsigned char* wl) {
    const int lane = F.lane;
    const float* PP = (const float*)(F.ws + WS_PP); const f16* PH = (const f16*)(F.ws + WS_PH); const float* R = (const float*)(F.ws + WS_ROPE);
    LAS float* qs = (LAS float*)wl; LAS float* qr = (LAS float*)(wl + 1024); LAS float* pc = (LAS float*)(wl + 2048); LAS float* pl = (LAS float*)(wl + 6144); LAS float* cvl = (LAS float*)(wl + 7168);
    const int m = b * SEQ + t, cur = t >> 6;
    const f16* rowbase = PH + (size_t)(b * SEQ) * PH_LD;
    const float* KC = (const float*)(F.ws + WS_KCMP); const float* VC = (const float*)(F.ws + WS_VCMP);
    const f16* gatep = PH + (size_t)m * PH_LD + H_GATE;
    for (int g = 0; g < 2; ++g) {
        {
            const float* qp = PP + (size_t)m * PP_LD + P_CQ + g * 256;
            const float c = (lane < 16) ? R[(size_t)m * 8 + (lane & 7)] : 1.f, s = (lane < 16) ? R[(size_t)M * 8 + (size_t)m * 8 + (lane & 7)] : 0.f;
#pragma unroll
            for (int h = 0; h < 4; ++h) {
                const float x = qp[h * 64 + lane];
                const float other = __shfl_xor(x, 8);
                float xr = x;
                if (lane < 8) xr = x * c - other * s; else if (lane < 16) xr = x * c + other * s;
                qs[h * 64 + lane] = x * 0.125f; qr[h * 64 + lane] = xr * 0.125f;
            }
        }
        lds_fence();
        const int ncv = (t < 31) ? 0 : min(255, ((t - 31) >> 4) + 1);
        float sc[4][4];
#pragma unroll
        for (int j = 0; j < 4; ++j) {
            const int n = j * 64 + lane;
#pragma unroll
            for (int h = 0; h < 4; ++h) sc[j][h] = -1e30f;
            if (j * 64 < ncv) {
                const float* kp = KC + ((size_t)(b * 256 + n) * 2 + g) * 64;
                float s0 = 0.f, s1 = 0.f, s2 = 0.f, s3 = 0.f;
#pragma unroll 4
                for (int d4 = 0; d4 < 16; ++d4) {
                    const f32x4 k4 = *(const f32x4*)(kp + d4 * 4);
                    const f32x4 a0 = *(const LAS f32x4*)(qs + d4 * 4), a1 = *(const LAS f32x4*)(qs + 64 + d4 * 4), a2 = *(const LAS f32x4*)(qs + 128 + d4 * 4), a3 = *(const LAS f32x4*)(qs + 192 + d4 * 4);
#pragma unroll
                    for (int e = 0; e < 4; ++e) { s0 += a0[e] * k4[e]; s1 += a1[e] * k4[e]; s2 += a2[e] * k4[e]; s3 += a3[e] * k4[e]; }
                }
                if (n < ncv) { sc[j][0] = s0; sc[j][1] = s1; sc[j][2] = s2; sc[j][3] = s3; }
            }
        }
#pragma unroll
        for (int h = 0; h < 4; ++h) {
            float mx = fmaxf(fmaxf(sc[0][h], sc[1][h]), fmaxf(sc[2][h], sc[3][h])); mx = wave_max(mx);
            float sm = 0.f;
#pragma unroll
            for (int j = 0; j < 4; ++j) { const float p = ((j * 64 + lane) < ncv) ? __expf(sc[j][h] - mx) : 0.f; sc[j][h] = p; sm += p; }
            sm = wave_sum(sm);
            const float inv = (ncv > 0) ? 1.f / sm : 0.f;
#pragma unroll
            for (int j = 0; j < 4; ++j) pc[h * 256 + j * 64 + lane] = sc[j][h] * inv;
        }
        lds_fence();
        float oc[4] = {0.f, 0.f, 0.f, 0.f};
        {
            const float* vp = VC + ((size_t)(b * 256) * 2 + g) * 64 + lane;
#pragma unroll 4
            for (int n = 0; n < ncv; ++n) {
                const float v = vp[(size_t)n * 128];
                oc[0] += pc[n] * v; oc[1] += pc[256 + n] * v; oc[2] += pc[512 + n] * v; oc[3] += pc[768 + n] * v;
            }
        }
        unsigned long long selmask;
        if (cur < 16) selmask = (1ull << (cur + 1)) - 1ull;
        else {
            float imp = 0.f;
#pragma unroll
            for (int h = 0; h < 4; ++h) {
                const LAS float* p = pc + h * 256 + 4 * lane;
                const f32x4 p4 = *(const LAS f32x4*)p;
                const float pm1 = (lane > 0) ? p[-1] : 0.f;
                imp += (p4[0] + p4[1] + p4[2]) + 0.5f * p4[3] + 0.5f * pm1;
            }
            float val = imp;
            if (lane == 0 || lane == cur || lane == cur - 1) val = 1e9f;
            if (lane > cur) val = -INFINITY;
            int rank = 0;
            for (int j = 0; j < 64; ++j) { const float o = __shfl(val, j); rank += (o > val || (o == val && j < lane)) ? 1 : 0; }
            selmask = __ballot(rank < 16);
        }
        OS ss;
#pragma unroll
        for (int h = 0; h < 4; ++h) { ss.m[h] = -1e30f; ss.l[h] = 0.f; ss.o[h] = 0.f; }
        {
            unsigned long long mk = selmask;
            while (mk) {
                const int mb = __builtin_ctzll(mk); mk &= mk - 1ull;
                const int tok0 = mb * 64;
                nsa_block(F, ss, qr, pl, rowbase, tok0, (tok0 + lane) <= t, H_KS + g * 64, H_VS + g * 64);
            }
        }
        OS sw;
#pragma unroll
        for (int h = 0; h < 4; ++h) { sw.m[h] = -1e30f; sw.l[h] = 0.f; sw.o[h] = 0.f; }
        {
            const int lo = (t - 511 > 0) ? (t - 511) : 0;
            for (int mb = lo >> 6; mb <= cur; ++mb) {
                const int tok = mb * 64 + lane;
                nsa_block(F, sw, qr, pl, rowbase, mb * 64, (tok <= t) && (tok > t - 512), H_KW + g * 64, H_VW + g * 64);
            }
        }
#pragma unroll
        for (int h = 0; h < 4; ++h) {
            const float g0 = (float)gatep[g * 12 + h * 3 + 0], g1 = (float)gatep[g * 12 + h * 3 + 1], g2 = (float)gatep[g * 12 + h * 3 + 2];
            const float os_ = (ss.l[h] > 0.f) ? ss.o[h] / ss.l[h] : 0.f, ow_ = (sw.l[h] > 0.f) ? sw.o[h] / sw.l[h] : 0.f;
            cvl[(g * 4 + h) * 64 + lane] = g0 * oc[h] + g1 * os_ + g2 * ow_;
        }
        lds_fence();
    }
    float cv[8]; float sq = 0.f;
#pragma unroll
    for (int i = 0; i < 8; ++i) { cv[i] = cvl[i * 64 + lane]; sq += cv[i] * cv[i]; }
    sq = wave_sum(sq);
    const float r = rsqrtf(sq * (1.f / 512.f) + EPS);
    const float* gc = gin(a, 25) + L * 512;
    f16* dst = (f16*)(F.ws + WS_XA) + (size_t)m * D + 512;
#pragma unroll
    for (int i = 0; i < 8; ++i) dst[i * 64 + lane] = (f16)(cv[i] * r * gc[i * 64 + lane]);
}


namespace nsa {
constexpr int KRS = 144, VRS = 192, KTB = 64 * KRS, VTB = 64 * VRS;
constexpr int KT = 0, KL = 2 * KTB, VT = 4 * KTB, WSF = VT + 2 * VTB, IMP = WSF + 2048, SELM = IMP + 16384, GTAB = SELM + 512, OTS = 272, OT = GTAB + 4096, LDS_END = OT + 8 * 32 * OTS;
static_assert(LDS_END <= LDS_BYTES, "nsa LDS map");
constexpr float LOG2E = 1.4426950408889634f;
constexpr float QSC = 0.125f * LOG2E;
constexpr float CQS = 8.f, CKS = 64.f, CSC = 0.125f * LOG2E / (CQS * CKS);
__device__ __forceinline__ h4 tr_read4(LAS const unsigned char* p) { return __builtin_bit_cast(h4, __builtin_amdgcn_ds_read_tr16_b64_v4i16((LAS v4i16_t*)p)); }
__device__ __forceinline__ int crow(int i, int hf) { return (i & 3) + 8 * (i >> 2) + 4 * hf; }

template <int MODE> __device__ __forceinline__ void st_load(const Frame& F, int b, int g, int blk, int kcol, int vcol, f32x4& r0, f32x4& r1, f32x4& r2, f32x4& r3) {
    const int key = F.tid >> 3, ch = F.tid & 7;
    if constexpr (MODE == 0) {
        const size_t off = ((size_t)(b * 256 + blk * 64 + key) * 2 + g) * 64 + ch * 8;
        const float* kp = (const float*)(F.ws + WS_KCMP) + off; const float* vp = (const float*)(F.ws + WS_VCMP) + off;
        r0 = *(const f32x4*)kp; r1 = *(const f32x4*)(kp + 4); r2 = *(const f32x4*)vp; r3 = *(const f32x4*)(vp + 4);
    } else {
        const f16* rowp = (const f16*)(F.ws + WS_PH) + (size_t)(b * SEQ + blk * 64 + key) * PH_LD;
        r0 = *(const f32x4*)(rowp + kcol + ch * 8); r2 = *(const f32x4*)(rowp + vcol + ch * 8);
    }
}
template <int MODE> __device__ __forceinline__ void st_write(const Frame& F, int buf, const f32x4& r0, const f32x4& r1, const f32x4& r2, const f32x4& r3) {
    const int key = F.tid >> 3, ch = F.tid & 7;
    LAS unsigned char* kd = F.lds + KT + buf * KTB + key * KRS + ch * 16; LAS unsigned char* vd = F.lds + VT + buf * VTB + key * VRS + ch * 16;
    if constexpr (MODE == 0) {
        h8 hi, lo;
#pragma unroll
        for (int e = 0; e < 4; ++e) { const float x0 = r0[e] * CKS, x1 = r1[e] * CKS; hi[e] = (f16)x0; lo[e] = (f16)(x0 - (float)hi[e]); hi[4 + e] = (f16)x1; lo[4 + e] = (f16)(x1 - (float)hi[4 + e]); }
        *(LAS u32x4*)kd = __builtin_bit_cast(u32x4, hi); if constexpr (SPLIT) *(LAS u32x4*)(kd + (KL - KT)) = __builtin_bit_cast(u32x4, lo);
        *(LAS u32x4*)vd = pg8::pack8h(r2, r3);
    } else {
        *(LAS f32x4*)kd = r0; *(LAS f32x4*)vd = r2;
    }
}
template <bool PREC> __device__ __forceinline__ void s_tiles(const Frame& F, int buf, const h8 (&qa)[4], const h8 (&qb)[4], f32x16& S0, f32x16& S1) {
    const int r = F.lane & 31, hf = F.lane >> 5;
    LAS const unsigned char* k0 = F.lds + KT + buf * KTB + r * KRS + hf * 16;
#pragma unroll
    for (int i = 0; i < 16; ++i) { S0[i] = 0.f; S1[i] = 0.f; }
    h8 a0[2], a1[2], l0[2], l1[2];
#define NSA_KRD(s) do { a0[(s) & 1] = *(const LAS h8*)(k0 + (s) * 32); a1[(s) & 1] = *(const LAS h8*)(k0 + 32 * KRS + (s) * 32); \
        if constexpr (PREC) { l0[(s) & 1] = *(const LAS h8*)(k0 + (KL - KT) + (s) * 32); l1[(s) & 1] = *(const LAS h8*)(k0 + (KL - KT) + 32 * KRS + (s) * 32); } } while (0)
    NSA_KRD(0);
    __builtin_amdgcn_sched_barrier(0);
#pragma unroll
    for (int s = 0; s < 4; ++s) {
        if (s + 1 < 4) NSA_KRD(s + 1);
        __builtin_amdgcn_sched_barrier(0);
        S0 = MFMA32(a0[s & 1], qa[s], S0); S1 = MFMA32(a1[s & 1], qa[s], S1);
        if constexpr (PREC) {
            S0 = MFMA32(a0[s & 1], qb[s], S0); S1 = MFMA32(a1[s & 1], qb[s], S1);
            S0 = MFMA32(l0[s & 1], qa[s], S0); S1 = MFMA32(l1[s & 1], qa[s], S1);
        }
        __builtin_amdgcn_sched_barrier(0);
    }
#undef NSA_KRD
}
__device__ __forceinline__ h8 pack_step(const f32x16& x, int s) {
    h8 r;
#pragma unroll
    for (int j = 0; j < 8; ++j) r[j] = (f16)x[8 * s + j];
    return r;
}
__device__ __forceinline__ void pv_tiles(const Frame& F, int buf, const f32x16& P0, const f32x16& P1, f32x16 (&O)[2]) {
    const int lane = F.lane, hf = lane >> 5, blk = (lane >> 4) & 1, q = (lane & 15) >> 2, p = lane & 3;
    LAS const unsigned char* vb = F.lds + VT + buf * VTB + (4 * hf + q) * VRS + (16 * blk + 4 * p) * 2;
    h4 vl[3], vh[3];
#define NSA_VRD(i) do { LAS const unsigned char* ad_ = vb + (16 * ((i) >> 1)) * VRS + 64 * ((i) & 1); vl[(i) % 3] = tr_read4(ad_); vh[(i) % 3] = tr_read4(ad_ + 8 * VRS); } while (0)
    NSA_VRD(0); NSA_VRD(1);
    h8 pf[4];
    pf[0] = pack_step(P0, 0);
    __builtin_amdgcn_sched_barrier(0);
#pragma unroll
    for (int i = 0; i < 8; ++i) {
        if (i + 2 < 8) NSA_VRD(i + 2);
        __builtin_amdgcn_sched_barrier(0);
        const h8 av = __builtin_shufflevector(vl[i % 3], vh[i % 3], 0, 1, 2, 3, 4, 5, 6, 7);
        O[i & 1] = MFMA32(av, pf[i >> 1], O[i & 1]);
        if ((i & 1) == 0 && i < 6) pf[(i >> 1) + 1] = (i < 2) ? pack_step(P0, 1) : pack_step(P1, (i >> 1) - 1);
        __builtin_amdgcn_sched_barrier(0);
    }
#undef NSA_VRD
}
__device__ __forceinline__ float max16(const f32x16& x) {
    float m = fmaxf(fmaxf(fmaxf(x[0], x[1]), fmaxf(x[2], x[3])), fmaxf(fmaxf(x[4], x[5]), fmaxf(x[6], x[7])));
    return fmaxf(m, fmaxf(fmaxf(fmaxf(x[8], x[9]), fmaxf(x[10], x[11])), fmaxf(fmaxf(x[12], x[13]), fmaxf(x[14], x[15]))));
}
__device__ __forceinline__ f32x2 pr2(const f32x16& x, int i) { return (f32x2){x[i], x[i + 1]}; }
__device__ __forceinline__ float sum16(const f32x16& x) {
    const f32x2 a = (pr2(x, 0) + pr2(x, 2)) + (pr2(x, 4) + pr2(x, 6)), b = (pr2(x, 8) + pr2(x, 10)) + (pr2(x, 12) + pr2(x, 14)), c = a + b;
    return c[0] + c[1];
}
__device__ __forceinline__ float sum32(const f32x16& x, const f32x16& y) {
    const f32x2 a = (pr2(x, 0) + pr2(y, 0)) + (pr2(x, 2) + pr2(y, 2)), b = (pr2(x, 4) + pr2(y, 4)) + (pr2(x, 6) + pr2(y, 6));
    const f32x2 c = (pr2(x, 8) + pr2(y, 8)) + (pr2(x, 10) + pr2(y, 10)), d = (pr2(x, 12) + pr2(y, 12)) + (pr2(x, 14) + pr2(y, 14)), e = (a + b) + (c + d);
    return e[0] + e[1];
}
__device__ __forceinline__ void osm_step(f32x16& S0, f32x16& S1, float& mrun, float& lrun, f32x16 (&O)[2]) {
    float mx = fmaxf(max16(S0), max16(S1)); mx = max_x32(mx);
    const float mn = fmaxf(mrun, mx), alpha = __builtin_amdgcn_exp2f(mrun - mn); mrun = mn;
#pragma unroll
    for (int i = 0; i < 16; i += 2) { const f32x2 nm2 = {-mn, -mn}; const f32x2 a = pr2(S0, i) + nm2, b = pr2(S1, i) + nm2;
        S0[i] = __builtin_amdgcn_exp2f(a[0]); S0[i + 1] = __builtin_amdgcn_exp2f(a[1]); S1[i] = __builtin_amdgcn_exp2f(b[0]); S1[i + 1] = __builtin_amdgcn_exp2f(b[1]); }
    float sm = sum32(S0, S1); sm = add_x32(sm);
    lrun = lrun * alpha + sm;
    O[0] = O[0] * alpha; O[1] = O[1] * alpha;
}

__device__ __forceinline__ float max3f(float a, float b, float c) { float r; asm("v_max3_f32 %0, %1, %2, %3" : "=v"(r) : "v"(a), "v"(b), "v"(c)); return r; }
__device__ __forceinline__ float max2f(float a, float b) { float r; asm("v_max_f32_e32 %0, %1, %2" : "=v"(r) : "v"(a), "v"(b)); return r; }
constexpr int SW_SLOTB = 8192, SW_K = 0, SW_V = 3 * SW_SLOTB;
typedef LAS const char* lds_cptr;
__device__ __forceinline__ void sw_glds16(const void* sbase, unsigned voff, unsigned lds_dst) { unsigned keep;
    asm volatile("s_mov_b32 %0, m0\n\ts_mov_b32 m0, %3\n\ts_nop 0\n\tglobal_load_lds_dwordx4 %1, %2\n\ts_mov_b32 m0, %0" : "=&s"(keep) : "v"(voff), "s"(sbase), "s"(lds_dst) : "memory"); }
#define SW_WAIT_BAR(N) asm volatile("s_waitcnt vmcnt(" #N ") lgkmcnt(0)\n\ts_barrier" ::: "memory")
#define SW_SBAR() __builtin_amdgcn_sched_barrier(0)
__device__ __forceinline__ float sw_fadd(float a, float b) { float r; asm("v_add_f32_e32 %0, %1, %2" : "=v"(r) : "v"(a), "v"(b)); return r; }
__device__ __forceinline__ float sw_fsub(float a, float b) { float r; asm("v_sub_f32_e32 %0, %1, %2" : "=v"(r) : "v"(a), "v"(b)); return r; }
__device__ __forceinline__ unsigned sw_cvtpk(float lo, float hi) { f32x2 v = {lo, hi}; h2 b = __builtin_convertvector(v, h2); return __builtin_bit_cast(unsigned, b); }
__device__ __forceinline__ void sw_kload8(h8* kf, lds_cptr kp) {
    kf[0] = *(const LAS h8*)(kp);        kf[1] = *(const LAS h8*)(kp + 512);  kf[2] = *(const LAS h8*)(kp + 2048); kf[3] = *(const LAS h8*)(kp + 2560);
    kf[4] = *(const LAS h8*)(kp + 4096); kf[5] = *(const LAS h8*)(kp + 4608); kf[6] = *(const LAS h8*)(kp + 6144); kf[7] = *(const LAS h8*)(kp + 6656); }
__device__ __forceinline__ void sw_kload2(h8* kf, lds_cptr kp, int j) { kf[2 * j] = *(const LAS h8*)(kp + j * 2048); kf[2 * j + 1] = *(const LAS h8*)(kp + j * 2048 + 512); }
__device__ __forceinline__ h4 sw_vtr(lds_cptr p) { return __builtin_bit_cast(h4, __builtin_amdgcn_ds_read_tr16_b64_v4i16((LAS v4i16_t*)p)); }
__device__ __forceinline__ float sw_rowmax(const f32x16& p0, const f32x16& p1) {
    float a = max3f(p0[0], p0[1], p1[0]), b = max3f(p0[2], p0[3], p1[1]); a = max3f(a, p1[2], p1[3]);
#pragma unroll
    for (int r = 4; r < 16; r += 4) { a = max3f(a, p0[r], p0[r + 1]); b = max3f(b, p0[r + 2], p0[r + 3]); a = max3f(a, p1[r], p1[r + 1]); b = max3f(b, p1[r + 2], p1[r + 3]); }
    const float m = max2f(a, b);
    auto rr = __builtin_amdgcn_permlane32_swap(__float_as_uint(m), __float_as_uint(m), false, false);
    return max2f(__uint_as_float(rr[0]), __uint_as_float(rr[1]));
}
template <int MODE> __device__ __forceinline__ void sw_mask(f32x16& p0, f32x16& p1, int t, int c, int NTr, int tq, int hi, unsigned sel_lo, unsigned sel_hi) {
    const float NEG = -INFINITY;
    if (t >= NTr) {
#pragma unroll
        for (int r = 0; r < 16; ++r) { p0[r] = NEG; p1[r] = NEG; }
        return;
    }
    if (MODE == 1) {
        const bool bit = ((t < 32) ? (sel_lo >> t) : (sel_hi >> (t - 32))) & 1u;
        if (t == c) {
#pragma unroll
            for (int r = 0; r < 16; ++r) { const int kk = (r & 3) + 8 * (r >> 2) + 4 * hi; if (!(bit && kk <= tq)) p0[r] = NEG; if (!(bit && kk + 32 <= tq)) p1[r] = NEG; }
        } else if (!__all(bit)) {
#pragma unroll
            for (int r = 0; r < 16; ++r) { if (!bit) { p0[r] = NEG; p1[r] = NEG; } }
        }
    } else {
        if (t == 0) {
#pragma unroll
            for (int r = 0; r < 16; ++r) { const int kk = (r & 3) + 8 * (r >> 2) + 4 * hi; if (kk > tq) p0[r] = NEG; if (kk + 32 > tq) p1[r] = NEG; }
        } else if (t == 8) {
#pragma unroll
            for (int r = 0; r < 16; ++r) { const int kk = (r & 3) + 8 * (r >> 2) + 4 * hi; if (kk <= tq) p0[r] = NEG; if (kk + 32 <= tq) p1[r] = NEG; }
        }
    }
}
template <int MODE, int THRL>
__device__ __forceinline__ void sweep(Frame& F, LAS unsigned char* ring, LAS float* wsf, const f16* Kg, const f16* Vg, int c, int NTr, const h8 (&qr)[4], int tq, unsigned sel_lo, unsigned sel_hi, f32x16 (&o)[2], float (&rli)[16]) {
    const int lane = F.lane, r32 = lane & 31, hi = lane >> 5, wid = F.wave;
    const int NT = (NTr < 4) ? 4 : ((NTr + 1) & ~1);
#define SW_SRC(t) ((MODE == 1) ? (((t) < c) ? (t) : c) : (c - (((t) < NTr) ? (t) : (NTr - 1))))
    const unsigned lds0 = (unsigned)(unsigned long)ring;
    const unsigned koff = (unsigned)((lane * PH_LD + wid * 8) * 2);
    const unsigned voff = (unsigned)(((16 * (wid & 3) + (lane >> 2)) * PH_LD + (wid >> 2) * 32 + (lane & 3) * 8) * 2);
    const unsigned kdst = lds0 + SW_K + wid * 1024, vdst = lds0 + SW_V + wid * 1024;
#define SW_DMA_K(t, slot) sw_glds16(Kg + (size_t)SW_SRC(t) * 64 * PH_LD, koff, (unsigned)__builtin_amdgcn_readfirstlane((int)(kdst + (slot))))
#define SW_DMA_V(t, slot) sw_glds16(Vg + (size_t)SW_SRC(t) * 64 * PH_LD, voff, (unsigned)__builtin_amdgcn_readfirstlane((int)(vdst + (slot))))
    h8 kf[8];
    const lds_cptr shm3 = (lds_cptr)ring; const lds_cptr kp0 = shm3 + SW_K + hi * 1024 + r32 * 16;
    const lds_cptr vp0 = shm3 + SW_V + ((lane >> 4) & 1) * 32 + (lane & 3) * 8 + (4 * hi + ((lane & 15) >> 2)) * 64;
    SW_DMA_K(0, 0); SW_DMA_V(0, 0); SW_DMA_K(1, SW_SLOTB);
    float mhat = 0.f, l_reg = 0.f; o[0] = f32x16{}; o[1] = f32x16{}; f32x16 negm = f32x16{}; asm volatile("" : "+v"(negm));
#define SW_CMASK(P0, P1, t) sw_mask<MODE>(P0, P1, (t), c, NTr, tq, hi, sel_lo, sel_hi)
    bool resc = false;
#define SW_START(P0, P1) do { const float rm = sw_rowmax(P0, P1); resc = false; \
    { const float dl = rm; mhat = sw_fadd(mhat, dl); \
      _Pragma("unroll") for (int r = 0; r < 16; ++r) { P0[r] = sw_fsub(P0[r], dl); P1[r] = sw_fsub(P1[r], dl); } \
      _Pragma("unroll") for (int r = 0; r < 16; ++r) negm[r] = -mhat; asm volatile("" : "+v"(negm)); } \
    _Pragma("unroll") for (int r = 0; r < 16; ++r) P0[r] = __builtin_amdgcn_exp2f(P0[r]); } while (0)
#define SW_RESC() do { if (resc) { asm volatile("s_waitcnt lgkmcnt(0)" ::: "memory"); \
      _Pragma("unroll") for (int d_ = 0; d_ < 2; ++d_) _Pragma("unroll") for (int r = 0; r < 16; ++r) o[d_][r] *= wsf[(r & 3) + 8 * (r >> 2) + 4 * hi]; } } while (0)
    f32x16 pA0, pA1, pB0, pB1;
    int sl_prev = 0, sl_cur = 0, sl_next = SW_SLOTB;
#define SW_ROT() do { sl_prev = sl_cur; sl_cur = sl_next; sl_next = (sl_next == 2 * SW_SLOTB) ? 0 : sl_next + SW_SLOTB; } while (0)
    SW_DMA_K(2, 2 * SW_SLOTB);
    SW_WAIT_BAR(3);
    {
        const lds_cptr kb = kp0;
#pragma unroll
        for (int d0 = 0; d0 < 4; ++d0) {
            const h8 b0 = *(const LAS h8*)(kb + d0 * 2048), b1 = *(const LAS h8*)(kb + d0 * 2048 + 512);
            if (d0 == 0) { pA0 = MFMA32(b0, qr[0], negm); pA1 = MFMA32(b1, qr[0], negm); }
            else { pA0 = MFMA32(b0, qr[d0], pA0); pA1 = MFMA32(b1, qr[d0], pA1); }
        }
    }
    asm volatile("s_nop 15\n\ts_nop 7" : "+v"(pA0), "+v"(pA1)); SW_CMASK(pA0, pA1, 0);
    SW_START(pA0, pA1);
#pragma unroll
    for (int r = 0; r < 16; ++r) pA1[r] = __builtin_amdgcn_exp2f(pA1[r]);
    SW_WAIT_BAR(0);
    SW_DMA_K(3, 0); SW_DMA_V(1, SW_SLOTB);
    SW_ROT();
    sw_kload8(kf, kp0 + sl_cur);
    SW_WAIT_BAR(2);
    h4 vlo[8], vhi[8]; u32x4 pw0, pw1, pw2, pw3;
#define SW_PKW(P, B) sw_cvtpk(P[B], P[B + 1])
#define SW_PAF(k) __builtin_bit_cast(h8, pw##k)
#define SW_VFR(i) (h8){vlo[i][0], vlo[i][1], vlo[i][2], vlo[i][3], vhi[i][0], vhi[i][1], vhi[i][2], vhi[i][3]}
#define SW_PIN(x) asm volatile("" : "+v"(x))
#define SW_MX3(a, b, c_) __builtin_fmaxf(__builtin_fmaxf((a), (b)), (c_))
#define SW_GAPA(MF, PA, ia, PB, ib, W0, W1, PW) do { MF; sacc += pr2(PA, ia); if ((ib) >= 0) sacc += pr2(PB, (ib) < 0 ? 0 : (ib)); SW_PIN(sacc); W0; W1; SW_PIN(PW); SW_SBAR(); } while (0)
#define SW_EX(v) __builtin_amdgcn_exp2f(v)
#define SW_GAPB(MF, X, B) do { MF; X[B] = SW_EX(X[B]); X[B + 1] = SW_EX(X[B + 1]); X[B + 2] = SW_EX(X[B + 2]); X[B + 3] = SW_EX(X[B + 3]); SW_PIN(X); SW_SBAR(); } while (0)
#define SW_VRD(i) do { vlo[i] = sw_vtr(vp_ + (((i) >> 2) * 4096 + ((i) & 3) * 1024)); vhi[i] = sw_vtr(vp_ + (((i) >> 2) * 4096 + ((i) & 3) * 1024 + 512)); } while (0)
#define SW_KRD(G, j) do { if (G) { sw_kload2(kf, kp0 + sl_next, j); SW_SBAR(); } } while (0)
#define SW_MSK(MK, C0, C1, t) do { if (MK) { if (MODE == 1) { const bool bit_ = (((t) < 32) ? (sel_lo >> (t)) : (sel_hi >> ((t) - 32))) & 1u; \
        const float bias_ = bit_ ? 0.f : -INFINITY; const f32x2 b2_ = {bias_, bias_}; \
        _Pragma("unroll") for (int r = 0; r < 16; r += 2) { const f32x2 u_ = pr2(C0, r) + b2_, v_ = pr2(C1, r) + b2_; C0[r] = u_[0]; C0[r + 1] = u_[1]; C1[r] = v_[0]; C1[r + 1] = v_[1]; } } } else { SW_CMASK(C0, C1, t); } } while (0)
#define SW_STEP(C0, C1, P0, P1, t, GK, GV, GL, MK) do { SW_SBAR(); \
    const lds_cptr vp_ = vp0 + sl_prev; \
    SW_VRD(0); SW_SBAR(); f32x2 sacc = pr2(P0, 0); \
    SW_GAPA(C0 = MFMA32(kf[0], qr[0], negm), P0, 2, P0, 4,     pw0[0] = SW_PKW(P0, 0), pw0[1] = SW_PKW(P0, 2), pw0); \
    SW_VRD(4); SW_SBAR(); SW_GAPA(C1 = MFMA32(kf[1], qr[0], negm), P0, 6, P0, 8,     pw0[2] = SW_PKW(P0, 4), pw0[3] = SW_PKW(P0, 6), pw0); \
    SW_VRD(1); SW_SBAR(); SW_GAPA(C0 = MFMA32(kf[2], qr[1], C0),   P0, 10, P0, 12, pw1[0] = SW_PKW(P0, 8), pw1[1] = SW_PKW(P0, 10), pw1); \
    SW_VRD(5); SW_SBAR(); SW_GAPA(C1 = MFMA32(kf[3], qr[1], C1),   P0, 14, P1, 0,   pw1[2] = SW_PKW(P0, 12), pw1[3] = SW_PKW(P0, 14), pw1); \
    SW_VRD(2); SW_SBAR(); SW_GAPA(C0 = MFMA32(kf[4], qr[2], C0),   P1, 2, P1, 4,     pw2[0] = SW_PKW(P1, 0), pw2[1] = SW_PKW(P1, 2), pw2); \
    SW_VRD(6); SW_SBAR(); SW_GAPA(C1 = MFMA32(kf[5], qr[2], C1),   P1, 6, P1, 8,     pw2[2] = SW_PKW(P1, 4), pw2[3] = SW_PKW(P1, 6), pw2); \
    SW_VRD(3); SW_SBAR(); SW_GAPA(C0 = MFMA32(kf[6], qr[3], C0),   P1, 10, P1, 12, pw3[0] = SW_PKW(P1, 8), pw3[1] = SW_PKW(P1, 10), pw3); \
    SW_VRD(7); SW_SBAR(); SW_GAPA(C1 = MFMA32(kf[7], qr[3], C1),   P1, 14, P1, -1,       pw3[2] = SW_PKW(P1, 12), pw3[3] = SW_PKW(P1, 14), pw3); \
    l_reg += sacc[0] + sacc[1]; \
    if (GK) { SW_DMA_K((t) + 3, sl_cur); } if (GV) { SW_DMA_V((t) + 1, sl_next); } \
    SW_MSK(MK, C0, C1, t); \
    { float a = SW_MX3(C0[0], C0[1], C1[0]), b = SW_MX3(C0[2], C0[3], C1[1]); a = SW_MX3(a, C1[2], C1[3]); \
      _Pragma("unroll") for (int r = 4; r < 16; r += 4) { a = SW_MX3(a, C0[r], C0[r + 1]); b = SW_MX3(b, C0[r + 2], C0[r + 3]); a = SW_MX3(a, C1[r], C1[r + 1]); b = SW_MX3(b, C1[r + 2], C1[r + 3]); } \
      float rm = __builtin_fmaxf(a, b); { auto rr = __builtin_amdgcn_permlane32_swap(__float_as_uint(rm), __float_as_uint(rm), false, false); rm = __builtin_fmaxf(__uint_as_float(rr[0]), __uint_as_float(rr[1])); } \
      resc = false; \
      if (__builtin_expect(__any(rm > (float)THRL), 0)) { const float dl = __builtin_fmaxf(rm, 0.f); mhat += dl; \
        _Pragma("unroll") for (int r = 0; r < 16; ++r) { C0[r] -= dl; C1[r] -= dl; } \
        _Pragma("unroll") for (int r = 0; r < 16; ++r) negm[r] = -mhat; asm volatile("" : "+v"(negm)); \
        const float f = __builtin_amdgcn_exp2f(-dl); l_reg *= f; if (hi == 0) wsf[r32] = f; resc = true; } } \
    SW_SBAR(); \
    SW_GAPB(o[0] = MFMA32(SW_PAF(0), SW_VFR(0), o[0]), C0, 0); \
    SW_GAPB(o[1] = MFMA32(SW_PAF(0), SW_VFR(4), o[1]), C0, 4); \
    SW_KRD(GL, 0); SW_GAPB(o[0] = MFMA32(SW_PAF(1), SW_VFR(1), o[0]), C0, 8); \
    SW_KRD(GL, 1); SW_GAPB(o[1] = MFMA32(SW_PAF(1), SW_VFR(5), o[1]), C0, 12); \
    SW_KRD(GL, 2); SW_GAPB(o[0] = MFMA32(SW_PAF(2), SW_VFR(2), o[0]), C1, 0); \
    SW_KRD(GL, 3); SW_GAPB(o[1] = MFMA32(SW_PAF(2), SW_VFR(6), o[1]), C1, 4); \
    SW_GAPB(o[0] = MFMA32(SW_PAF(3), SW_VFR(3), o[0]), C1, 8); \
    SW_GAPB(o[1] = MFMA32(SW_PAF(3), SW_VFR(7), o[1]), C1, 12); \
    } while (0)
    int t = 1;
#define SW_ENDW(tt) do { if ((tt) + 3 < NT) { SW_WAIT_BAR(2); } else if ((tt) + 2 < NT) { SW_WAIT_BAR(1); } else { SW_WAIT_BAR(0); } } while (0)
    const int t_int = (MODE == 1) ? c : ((NTr < 8) ? NTr : 8);
    for (; t + 4 < NT && t + 1 < t_int; t += 2) {
        SW_STEP(pB0, pB1, pA0, pA1, t, true, true, true, 1);         SW_WAIT_BAR(2); SW_RESC(); SW_ROT();
        SW_STEP(pA0, pA1, pB0, pB1, t + 1, true, true, true, 1);     SW_WAIT_BAR(2); SW_RESC(); SW_ROT();
    }
    for (; t + 1 < NT; t += 2) {
        SW_STEP(pB0, pB1, pA0, pA1, t, (t + 3 < NT), (t + 1 < NT), (t + 1 < NT), 0);         SW_ENDW(t);     SW_RESC(); SW_ROT();
        SW_STEP(pA0, pA1, pB0, pB1, t + 1, (t + 4 < NT), (t + 2 < NT), (t + 2 < NT), 0);     SW_ENDW(t + 1); SW_RESC(); SW_ROT();
    }
    SW_STEP(pB0, pB1, pA0, pA1, NT - 1, false, false, false, 0); SW_RESC();
    {
        float sacc = pB0[0] + pB0[1];
#pragma unroll
        for (int r = 2; r < 16; ++r) sacc += pB0[r];
#pragma unroll
        for (int r = 0; r < 16; ++r) sacc += pB1[r];
        l_reg += sacc;
        pw0 = (u32x4){SW_PKW(pB0, 0), SW_PKW(pB0, 2), SW_PKW(pB0, 4), SW_PKW(pB0, 6)}; pw1 = (u32x4){SW_PKW(pB0, 8), SW_PKW(pB0, 10), SW_PKW(pB0, 12), SW_PKW(pB0, 14)};
        pw2 = (u32x4){SW_PKW(pB1, 0), SW_PKW(pB1, 2), SW_PKW(pB1, 4), SW_PKW(pB1, 6)}; pw3 = (u32x4){SW_PKW(pB1, 8), SW_PKW(pB1, 10), SW_PKW(pB1, 12), SW_PKW(pB1, 14)};
        SW_SBAR();
        const lds_cptr vq = vp0 + sl_cur;
#pragma unroll
        for (int d0 = 0; d0 < 2; ++d0) {
            h4 lo_[4], hi_[4];
#pragma unroll
            for (int ks = 0; ks < 4; ++ks) { lo_[ks] = sw_vtr(vq + d0 * 4096 + ks * 1024); hi_[ks] = sw_vtr(vq + d0 * 4096 + ks * 1024 + 512); }
#define SW_PK(k) (h8){lo_[k][0], lo_[k][1], lo_[k][2], lo_[k][3], hi_[k][0], hi_[k][1], hi_[k][2], hi_[k][3]}
            o[d0] = MFMA32(SW_PAF(0), SW_PK(0), o[d0]); o[d0] = MFMA32(SW_PAF(1), SW_PK(1), o[d0]); o[d0] = MFMA32(SW_PAF(2), SW_PK(2), o[d0]); o[d0] = MFMA32(SW_PAF(3), SW_PK(3), o[d0]);
#undef SW_PK
        }
    }
    { auto rr = __builtin_amdgcn_permlane32_swap(__float_as_uint(l_reg), __float_as_uint(l_reg), false, false); l_reg = __uint_as_float(rr[0]) + __uint_as_float(rr[1]); }
    if (hi == 0) wsf[32 + r32] = l_reg;
    asm volatile("s_waitcnt lgkmcnt(0)" ::: "memory");
#pragma unroll
    for (int r = 0; r < 16; ++r) rli[r] = __builtin_amdgcn_rcpf(wsf[32 + (r & 3) + 8 * (r >> 2) + 4 * hi]);
    asm volatile("s_waitcnt lgkmcnt(0)\n\ts_barrier" ::: "memory");
#undef SW_SRC
#undef SW_DMA_K
#undef SW_DMA_V
#undef SW_CMASK
#undef SW_START
#undef SW_RESC
#undef SW_ROT
#undef SW_PKW
#undef SW_PAF
#undef SW_VFR
#undef SW_PIN
#undef SW_MX3
#undef SW_GAPA
#undef SW_EX
#undef SW_GAPB
#undef SW_VRD
#undef SW_KRD
#undef SW_STEP
#undef SW_MSK
#undef SW_ENDW
}

__device__ __forceinline__ void item(Frame& F, int L, ArgsP a, int b, int c) {
    int lane, w, hf, rho, ql, h, tq, t, m;
    const float* PP; const f16* PH; const float* R; LAS float* impw; LAS unsigned* selm; LAS unsigned char* otw; LAS float* gtw; LAS float* wsf; f16* dst;
#define NSA_SECTION() do { refresh(F); asm volatile("" : "+s"(b), "+s"(c)); lane = F.lane; w = F.wave; hf = lane >> 5; rho = lane & 31; ql = rho >> 2; h = rho & 3; \
        tq = 8 * w + ql; t = 64 * c + tq; m = b * SEQ + t; \
        PP = (const float*)(F.ws + WS_PP); PH = (const f16*)(F.ws + WS_PH); R = (const float*)(F.ws + WS_ROPE); \
        impw = (LAS float*)(F.lds + IMP) + w * 512; selm = (LAS unsigned*)(F.lds + SELM) + w * 16; \
        otw = F.lds + OT + w * (32 * OTS); gtw = (LAS float*)(F.lds + GTAB) + w * 128; wsf = (LAS float*)(F.lds + WSF) + w * 64; \
        dst = (f16*)(F.ws + WS_XA) + (size_t)m * D + 512 + h * 64 + 4 * hf; } while (0)
    NSA_SECTION();
    const int ncv = (t < 31) ? 0 : min(255, ((t - 31) >> 4) + 1);
    const int ncv_max = min(255, 4 * c + 3), nblk_c = (ncv_max + 63) >> 6;
    int it = 0;
    float sq = 0.f;
    for (int g = 0; g < 2; ++g) {
        asm volatile("" : "+s"(g)); NSA_SECTION();
        h8 qh[4], qlw[4];
        {
            const float* qp = PP + (size_t)m * PP_LD + P_CQ + g * 256 + h * 64 + 8 * hf;
            f32x4 xq[8];
#pragma unroll
            for (int s = 0; s < 4; ++s) { xq[2 * s] = *(const f32x4*)(qp + 16 * s); xq[2 * s + 1] = *(const f32x4*)(qp + 16 * s + 4); }
            asm volatile("" : "+v"(xq[0]), "+v"(xq[1]), "+v"(xq[2]), "+v"(xq[3]), "+v"(xq[4]), "+v"(xq[5]), "+v"(xq[6]), "+v"(xq[7]));
#pragma unroll
            for (int s = 0; s < 4; ++s) {
                const f32x4 x0 = xq[2 * s], x1 = xq[2 * s + 1];
                const float xv[8] = {x0[0], x0[1], x0[2], x0[3], x1[0], x1[1], x1[2], x1[3]};
#pragma unroll
                for (int j = 0; j < 8; ++j) { const float xs = xv[j] * CQS; qh[s][j] = (f16)xs; if constexpr (SPLIT) qlw[s][j] = (f16)(xs - (float)qh[s][j]); else qlw[s][j] = (f16)0.f; }
            }
        }
        f32x16 O[2]; float mrun, lrun;
        f32x4 r0, r1, r2, r3;
        mrun = -1e30f; lrun = 0.f;
#pragma unroll
        for (int i = 0; i < 16; ++i) { O[0][i] = 0.f; O[1][i] = 0.f; }
        st_load<0>(F, b, g, 0, 0, 0, r0, r1, r2, r3);
        for (int blk = 0; blk < nblk_c; ++blk, ++it) {
            st_write<0>(F, it & 1, r0, r1, r2, r3);
            __syncthreads();
            st_load<0>(F, b, g, (blk + 1 < nblk_c) ? blk + 1 : 0, 0, 0, r0, r1, r2, r3);
            f32x16 S0, S1; s_tiles<SPLIT>(F, it & 1, qh, qlw, S0, S1);
            const int lim = ncv - blk * 64 - 4 * hf;
#pragma unroll
            for (int i = 0; i < 16; ++i) { const int kc = (i & 3) + 8 * (i >> 2); S0[i] = (kc < lim) ? S0[i] : -INFINITY; S1[i] = (kc + 32 < lim) ? S1[i] : -INFINITY; }
            float mx = fmaxf(max16(S0), max16(S1)); mx = max_x32(mx) * CSC;
            const float mn = fmaxf(mrun, mx), alpha = __builtin_amdgcn_exp2f(mrun - mn); mrun = mn;
            float sm = 0.f;
#pragma unroll
            for (int i = 0; i < 16; ++i) { sm += __builtin_amdgcn_exp2f(__builtin_fmaf(S0[i], CSC, -mn)); sm += __builtin_amdgcn_exp2f(__builtin_fmaf(S1[i], CSC, -mn)); }
            lrun = lrun * alpha + sm;
        }
        lrun = add_x32(lrun);
        const float inv_lc = (lrun > 0.f) ? 1.f / lrun : 0.f, mfin = mrun + ((lrun > 0.f) ? __builtin_amdgcn_logf(lrun) : 0.f);
        NSA_SECTION();
#pragma unroll
        for (int i = 0; i < 8; ++i) impw[lane * 8 + i] = 0.f;
        lds_fence();
        float prev_pc = 0.f;
        for (int blk = 0; blk < nblk_c; ++blk, ++it) {
            st_write<0>(F, it & 1, r0, r1, r2, r3);
            __syncthreads();
            if (blk + 1 < nblk_c) st_load<0>(F, b, g, blk + 1, 0, 0, r0, r1, r2, r3);
            f32x16 S0, S1; s_tiles<SPLIT>(F, it & 1, qh, qlw, S0, S1);
#pragma unroll
            for (int i = 0; i < 16; ++i) { const int n0 = blk * 64 + crow(i, hf);
                S0[i] = (n0 < ncv) ? __builtin_amdgcn_exp2f(__builtin_fmaf(S0[i], CSC, -mfin)) : 0.f; S1[i] = (n0 + 32 < ncv) ? __builtin_amdgcn_exp2f(__builtin_fmaf(S1[i], CSC, -mfin)) : 0.f; }
            pv_tiles(F, it & 1, S0, S1, O);
#pragma unroll
            for (int u = 0; u < 2; ++u)
#pragma unroll
                for (int r4 = 0; r4 < 4; ++r4) {
                    const float p0 = u ? S1[4 * r4] : S0[4 * r4], p1 = u ? S1[4 * r4 + 1] : S0[4 * r4 + 1], p2 = u ? S1[4 * r4 + 2] : S0[4 * r4 + 2], p3 = u ? S1[4 * r4 + 3] : S0[4 * r4 + 3];
                    float av = (p0 + p1 + p2) + 0.5f * p3, cvv = 0.5f * p3;
                    av += dpp_f<0xB1>(av); av += dpp_f<0x4E>(av); cvv += dpp_f<0xB1>(cvv); cvv += dpp_f<0x4E>(cvv);
                    const float pc = partner_x32(cvv, hf);
                    const float add = hf ? pc : prev_pc; prev_pc = pc;
                    const int mb = 16 * blk + 8 * u + 2 * r4 + hf;
                    if (h == 0) impw[ql * 64 + mb] = av + add;
                }
        }
        {
            const f16* gp = PH + (size_t)m * PH_LD + H_GATE + g * 12 + h * 3;
            const float g0 = (float)gp[0];
            if (hf == 0) *(LAS f32x4*)(gtw + rho * 4) = (f32x4){g0, (float)gp[1], (float)gp[2], 0.f};
#pragma unroll
            for (int cd = 0; cd < 2; ++cd)
#pragma unroll
                for (int r4 = 0; r4 < 4; ++r4) *(LAS f32x4*)(otw + rho * OTS + (32 * cd + 8 * r4 + 4 * hf) * 4) = (f32x4){O[cd][4 * r4] * g0, O[cd][4 * r4 + 1] * g0, O[cd][4 * r4 + 2] * g0, O[cd][4 * r4 + 3] * g0};
        }
        NSA_SECTION();
        unsigned sel_lo, sel_hi;
        if (c < 16) { sel_lo = (2u << c) - 1u; sel_hi = 0u; }
        else {
            lds_fence();
            const int q8 = lane >> 3, mg = lane & 7;
            unsigned long long mk[8];
            {
                const f32x4 v0 = *(const LAS f32x4*)(impw + q8 * 64 + mg * 8), v1 = *(const LAS f32x4*)(impw + q8 * 64 + mg * 8 + 4);
                const float myv[8] = {v0[0], v0[1], v0[2], v0[3], v1[0], v1[1], v1[2], v1[3]};
                unsigned k32[8];
#pragma unroll
                for (int i = 0; i < 8; ++i) { const int mb = mg * 8 + i;
                    k32[i] = (mb > c) ? 0u : ((mb == 0 || mb == c || mb == c - 1) ? __float_as_uint(1e9f) + 1u : __float_as_uint(fmaxf(myv[i], 0.f)) + 1u);
                    mk[i] = ((unsigned long long)k32[i] << 6) | (unsigned)(63 - mb); }
                *(LAS u32x4*)(impw + q8 * 64 + mg * 8) = (u32x4){k32[0], k32[1], k32[2], k32[3]}; *(LAS u32x4*)(impw + q8 * 64 + mg * 8 + 4) = (u32x4){k32[4], k32[5], k32[6], k32[7]};
            }
            lds_fence();
            int rank[8];
#pragma unroll
            for (int i = 0; i < 8; ++i) rank[i] = 0;
            for (int j4 = 0; j4 <= (c >> 2); ++j4) {
                const u32x4 o4 = *(const LAS u32x4*)(impw + q8 * 64 + j4 * 4);
#pragma unroll
                for (int e = 0; e < 4; ++e) { const unsigned long long ko = ((unsigned long long)o4[e] << 6) | (unsigned)(63 - (j4 * 4 + e));
#pragma unroll
                    for (int i = 0; i < 8; ++i) asm("v_cmp_gt_u64_e32 vcc, %1, %2\n\tv_addc_co_u32_e32 %0, vcc, 0, %0, vcc" : "+v"(rank[i]) : "v"(ko), "v"(mk[i]) : "vcc"); }
            }
            unsigned bits = 0u;
#pragma unroll
            for (int i = 0; i < 8; ++i) bits |= (rank[i] < 16) ? (1u << i) : 0u;
            unsigned lo = (mg < 4) ? (bits << (8 * mg)) : 0u, hi = (mg >= 4) ? (bits << (8 * (mg - 4))) : 0u;
            lo |= (unsigned)__builtin_amdgcn_mov_dpp((int)lo, 0xB1, 0xF, 0xF, true); lo |= (unsigned)__builtin_amdgcn_mov_dpp((int)lo, 0x4E, 0xF, 0xF, true); lo |= (unsigned)__builtin_amdgcn_mov_dpp((int)lo, 0x141, 0xF, 0xF, true);
            hi |= (unsigned)__builtin_amdgcn_mov_dpp((int)hi, 0xB1, 0xF, 0xF, true); hi |= (unsigned)__builtin_amdgcn_mov_dpp((int)hi, 0x4E, 0xF, 0xF, true); hi |= (unsigned)__builtin_amdgcn_mov_dpp((int)hi, 0x141, 0xF, 0xF, true);
            if (mg == 0) { selm[q8 * 2] = lo; selm[q8 * 2 + 1] = hi; }
            lds_fence();
            sel_lo = selm[ql * 2]; sel_hi = selm[ql * 2 + 1];
            lds_fence();
        }
        NSA_SECTION();
        h8 qr[4];
        {
            const float* qp = PP + (size_t)m * PP_LD + P_CQ + g * 256 + h * 64 + 8 * hf;
            f32x4 xq[8];
#pragma unroll
            for (int s = 0; s < 4; ++s) { xq[2 * s] = *(const f32x4*)(qp + 16 * s); xq[2 * s + 1] = *(const f32x4*)(qp + 16 * s + 4); }
            const f32x4 c0 = *(const f32x4*)(R + (size_t)m * 8), c1 = *(const f32x4*)(R + (size_t)m * 8 + 4);
            const f32x4 s0 = *(const f32x4*)(R + (size_t)M * 8 + (size_t)m * 8), s1 = *(const f32x4*)(R + (size_t)M * 8 + (size_t)m * 8 + 4);
            asm volatile("" : "+v"(xq[0]), "+v"(xq[1]), "+v"(xq[2]), "+v"(xq[3]), "+v"(xq[4]), "+v"(xq[5]), "+v"(xq[6]), "+v"(xq[7]));
#pragma unroll
            for (int s = 0; s < 4; ++s) {
                const f32x4 x0 = xq[2 * s], x1 = xq[2 * s + 1];
                float xv[8] = {x0[0], x0[1], x0[2], x0[3], x1[0], x1[1], x1[2], x1[3]};
                if (s == 0) {
                    const float cs[8] = {c0[0], c0[1], c0[2], c0[3], c1[0], c1[1], c1[2], c1[3]}, sn[8] = {s0[0], s0[1], s0[2], s0[3], s1[0], s1[1], s1[2], s1[3]};
#pragma unroll
                    for (int j = 0; j < 8; ++j) { const float other = partner_x32(xv[j], hf); xv[j] = hf ? (xv[j] * cs[j] + other * sn[j]) : (xv[j] * cs[j] - other * sn[j]); }
                }
#pragma unroll
                for (int j = 0; j < 8; ++j) qr[s][j] = (f16)(xv[j] * QSC);
            }
        }
        lds_fence();
        __syncthreads();
        NSA_SECTION();
        {
            f32x16 os[2]; float rli[16];
            sweep<1, 8>(F, F.lds, wsf, PH + (size_t)(b * SEQ) * PH_LD + H_KS + g * 64, PH + (size_t)(b * SEQ) * PH_LD + H_VS + g * 64, c, c + 1, qr, tq, sel_lo, sel_hi, os, rli);
#pragma unroll
            for (int r = 0; r < 16; ++r) { const int row = (r & 3) + 8 * (r >> 2) + 4 * hf; const float gs = gtw[row * 4 + 1] * rli[r];
#pragma unroll
                for (int d0 = 0; d0 < 2; ++d0) { LAS float* p = (LAS float*)(otw + row * OTS) + 32 * d0 + rho; *p += os[d0][r] * gs; } }
            lds_fence();
            NSA_SECTION();
            sweep<2, 8>(F, F.lds, wsf, PH + (size_t)(b * SEQ) * PH_LD + H_KW + g * 64, PH + (size_t)(b * SEQ) * PH_LD + H_VW + g * 64, c, (c >= 8) ? 9 : c + 1, qr, tq, 0u, 0u, os, rli);
#pragma unroll
            for (int r = 0; r < 16; ++r) { const int row = (r & 3) + 8 * (r >> 2) + 4 * hf; const float gs = gtw[row * 4 + 2] * rli[r];
#pragma unroll
                for (int d0 = 0; d0 < 2; ++d0) { LAS float* p = (LAS float*)(otw + row * OTS) + 32 * d0 + rho; *p += os[d0][r] * gs; } }
            lds_fence();
        }
        NSA_SECTION();
#pragma unroll
        for (int cd = 0; cd < 2; ++cd)
#pragma unroll
            for (int r4 = 0; r4 < 4; ++r4) { const f32x4 v = *(const LAS f32x4*)(otw + rho * OTS + (32 * cd + 8 * r4 + 4 * hf) * 4);
                h4 o; o[0] = (f16)v[0]; o[1] = (f16)v[1]; o[2] = (f16)v[2]; o[3] = (f16)v[3];
                sq += ((float)o[0] * (float)o[0] + (float)o[1] * (float)o[1]) + ((float)o[2] * (float)o[2] + (float)o[3] * (float)o[3]);
                *(u32x2*)(dst + g * 256 + 32 * cd + 8 * r4) = __builtin_bit_cast(u32x2, o); }
        lds_fence();
    }
    NSA_SECTION();
    sq += dpp_f<0xB1>(sq); sq += dpp_f<0x4E>(sq); sq = add_x32(sq);
    const float rn = rsqrtf(sq * (1.f / 512.f) + EPS);
    const float* gc = gin(a, 25) + L * 512 + h * 64 + 4 * hf;
    dst = launder_g(dst); gc = launder_g(gc);
    u32x2 vv[16]; f32x4 gv[16];
#pragma unroll
    for (int k = 0; k < 16; ++k) { const int col = (k >> 3) * 256 + 32 * ((k >> 2) & 1) + 8 * (k & 3); vv[k] = *(const u32x2*)(dst + col); gv[k] = *(const f32x4*)(gc + col); }
#pragma unroll
    for (int k = 0; k < 16; ++k) {
        const int col = (k >> 3) * 256 + 32 * ((k >> 2) & 1) + 8 * (k & 3);
        const h4 v = __builtin_bit_cast(h4, vv[k]); const f32x4 gn = gv[k];
        h4 o; o[0] = (f16)((float)v[0] * rn * gn[0]); o[1] = (f16)((float)v[1] * rn * gn[1]); o[2] = (f16)((float)v[2] * rn * gn[2]); o[3] = (f16)((float)v[3] * rn * gn[3]);
        *(u32x2*)(dst + col) = __builtin_bit_cast(u32x2, o);
    }
    __syncthreads();
#undef NSA_SECTION
}
}

__device__ __forceinline__ float dpp_xor1(float v) { return __builtin_bit_cast(float, __builtin_amdgcn_mov_dpp(__builtin_bit_cast(int, v), 0xB1, 0xF, 0xF, true)); }
__device__ __forceinline__ float dpp_xor2(float v) { return __builtin_bit_cast(float, __builtin_amdgcn_mov_dpp(__builtin_bit_cast(int, v), 0x4E, 0xF, 0xF, true)); }
namespace dsa {
constexpr int KBUF = 16384;
constexpr int KRS = 304, VRS = 320, KTB = 64 * KRS, VTB = 64 * VRS;
constexpr int KT = 0, VT = 2 * KTB, SSQ = VT + 2 * VTB, LDS_END = SSQ + 1024;
static_assert(8 * KBUF + 8 * 1024 <= LDS_BYTES - 16 && LDS_END <= LDS_BYTES, "dsa LDS map");
constexpr float QSC = 0.125f * 1.4426950408889634f;

__device__ __forceinline__ unsigned row_or(unsigned v) { v |= (unsigned)__builtin_amdgcn_mov_dpp((int)v, 0xB1, 0xF, 0xF, true); v |= (unsigned)__builtin_amdgcn_mov_dpp((int)v, 0x4E, 0xF, 0xF, true);
    v |= (unsigned)__builtin_amdgcn_mov_dpp((int)v, 0x141, 0xF, 0xF, true); v |= (unsigned)__builtin_amdgcn_mov_dpp((int)v, 0x140, 0xF, 0xF, true); return v; }
__device__ __forceinline__ unsigned row_add(unsigned v) { v += (unsigned)__builtin_amdgcn_mov_dpp((int)v, 0xB1, 0xF, 0xF, true); v += (unsigned)__builtin_amdgcn_mov_dpp((int)v, 0x4E, 0xF, 0xF, true);
    v += (unsigned)__builtin_amdgcn_mov_dpp((int)v, 0x141, 0xF, 0xF, true); v += (unsigned)__builtin_amdgcn_mov_dpp((int)v, 0x140, 0xF, 0xF, true); return v; }
__device__ __forceinline__ unsigned wave_add_u(unsigned v) { v = row_add(v);
    return (unsigned)(__builtin_amdgcn_readlane((int)v, 0) + __builtin_amdgcn_readlane((int)v, 16)) + (unsigned)(__builtin_amdgcn_readlane((int)v, 32) + __builtin_amdgcn_readlane((int)v, 48)); }
__device__ __forceinline__ unsigned wave_max_u(unsigned v) {
    v = max(v, (unsigned)__builtin_amdgcn_mov_dpp((int)v, 0xB1, 0xF, 0xF, true)); v = max(v, (unsigned)__builtin_amdgcn_mov_dpp((int)v, 0x4E, 0xF, 0xF, true));
    v = max(v, (unsigned)__builtin_amdgcn_mov_dpp((int)v, 0x141, 0xF, 0xF, true)); v = max(v, (unsigned)__builtin_amdgcn_mov_dpp((int)v, 0x140, 0xF, 0xF, true));
    return max(max((unsigned)__builtin_amdgcn_readlane((int)v, 0), (unsigned)__builtin_amdgcn_readlane((int)v, 16)), max((unsigned)__builtin_amdgcn_readlane((int)v, 32), (unsigned)__builtin_amdgcn_readlane((int)v, 48))); }
__device__ __forceinline__ unsigned wave_min_u(unsigned v) { return ~wave_max_u(~v); }
__device__ __forceinline__ unsigned wave_or_u(unsigned v) { v = row_or(v);
    return (unsigned)(__builtin_amdgcn_readlane((int)v, 0) | __builtin_amdgcn_readlane((int)v, 16)) | (unsigned)(__builtin_amdgcn_readlane((int)v, 32) | __builtin_amdgcn_readlane((int)v, 48)); }

struct P1Ops { h8 bh[2], bl[2]; float wv[4][4]; h8 ah0, ah1, al0, al1; };
__device__ __forceinline__ void pass1_load(const Frame& F, int b, int t0, P1Ops& o) {
    const int lane = F.lane, w = F.wave, hf = lane >> 5, rho = lane & 31, q = rho >> 2, h = rho & 3;
    const float* PP = (const float*)(F.ws + WS_PP);
    const f16* qp = (const f16*)(PP + (size_t)(b * SEQ + t0 + q) * PP_LD + P_IQS) + h * 32 + 8 * hf;
    o.bh[0] = *(const h8*)qp; o.bh[1] = *(const h8*)(qp + 16); if constexpr (SPLIT) { o.bl[0] = *(const h8*)(qp + 128); o.bl[1] = *(const h8*)(qp + 144); }
#pragma unroll
    for (int r4 = 0; r4 < 4; ++r4) {
        const f32x4 w4 = *(const f32x4*)(PP + (size_t)(b * SEQ + t0 + 2 * r4 + hf) * PP_LD + P_IW);
#pragma unroll
        for (int e = 0; e < 4; ++e) o.wv[r4][e] = w4[e] * (0.17677669529663687f / (ISC * ISC));
    }
    const int ntiles = 2 * (((t0 + 7) >> 6) + 1);
    const f16* kp = (const f16*)(F.ws + WS_IKT) + ((size_t)(b * 128 + min(w, ntiles - 1)) * 256 + lane) * 8;
    o.ah0 = *(const h8*)kp; o.ah1 = *(const h8*)(kp + 512); if constexpr (SPLIT) { o.al0 = *(const h8*)(kp + 1024); o.al1 = *(const h8*)(kp + 1536); }
}
__device__ __forceinline__ void pass1_round(Frame& F, int b, int t0, P1Ops& ops, bool has_next) {
    const int lane = F.lane, w = F.wave, hf = lane >> 5, rho = lane & 31;
    const float* PP = (const float*)(F.ws + WS_PP);
    h8 bh[2] = {ops.bh[0], ops.bh[1]}, bl[2] = {ops.bl[0], ops.bl[1]};
    float wv[4][4];
#pragma unroll
    for (int r4 = 0; r4 < 4; ++r4)
#pragma unroll
        for (int e = 0; e < 4; ++e) wv[r4][e] = ops.wv[r4][e];
    const int ntiles = 2 * (((t0 + 7) >> 6) + 1);
    const f16* kp0 = (const f16*)(F.ws + WS_IKT) + ((size_t)(b * 128) * 256 + lane) * 8;
    const size_t tstride = (size_t)256 * 8;
    h8 ah0 = ops.ah0, ah1 = ops.ah1, al0 = ops.al0, al1 = ops.al1, nh0, nh1, nl0, nl1;
    for (int tt = w; tt < ntiles; tt += NWAVES) {
        { const f16* kp = kp0 + (size_t)min(tt + NWAVES, ntiles - 1) * tstride; nh0 = *(const h8*)kp; nh1 = *(const h8*)(kp + 512); if constexpr (SPLIT) { nl0 = *(const h8*)(kp + 1024); nl1 = *(const h8*)(kp + 1536); } }
        f32x16 S;
#pragma unroll
        for (int i = 0; i < 16; ++i) S[i] = 0.f;
        S = MFMA32(bh[0], ah0, S); S = MFMA32(bh[1], ah1, S);
        if constexpr (SPLIT) { S = MFMA32(bl[0], ah0, S); S = MFMA32(bh[0], al0, S); S = MFMA32(bl[1], ah1, S); S = MFMA32(bh[1], al1, S); }
        const int kidx = 32 * tt + rho;
#define P1_RELU(x) ({ float r_; asm("v_max_f32_e32 %0, 0, %1" : "=v"(r_) : "v"(x)); r_; })
        asm volatile("s_nop 15\n\ts_nop 7" : "+v"(S));
        if (32 * tt + 31 <= t0) {
#pragma unroll
            for (int r4 = 0; r4 < 4; ++r4) {
                const float r = (P1_RELU(S[4 * r4]) * wv[r4][0] + P1_RELU(S[4 * r4 + 1]) * wv[r4][1]) + (P1_RELU(S[4 * r4 + 2]) * wv[r4][2] + P1_RELU(S[4 * r4 + 3]) * wv[r4][3]);
                ((LAS unsigned*)(F.lds + (2 * r4 + hf) * KBUF))[kidx] = mono_key(r);
            }
        } else {
#pragma unroll
            for (int r4 = 0; r4 < 4; ++r4) {
                const float r = (P1_RELU(S[4 * r4]) * wv[r4][0] + P1_RELU(S[4 * r4 + 1]) * wv[r4][1]) + (P1_RELU(S[4 * r4 + 2]) * wv[r4][2] + P1_RELU(S[4 * r4 + 3]) * wv[r4][3]);
                const int qq = 2 * r4 + hf;
                ((LAS unsigned*)(F.lds + qq * KBUF))[kidx] = (kidx <= t0 + qq) ? mono_key(r) : 0u;
            }
        }
#undef P1_RELU
        ah0 = nh0; ah1 = nh1; if constexpr (SPLIT) { al0 = nl0; al1 = nl1; }
    }
    __syncthreads();
    if (has_next) pass1_load(F, b, t0 + 8, ops);
    {
        const int t = t0 + w, nsteps = (t >> 6) + 1;
        LAS unsigned* kbuf = (LAS unsigned*)(F.lds + w * KBUF);
        LAS unsigned* hist = (LAS unsigned*)(F.lds + 8 * KBUF + w * 1024);
        unsigned kreg[64];
#pragma unroll
        for (int j8 = 0; j8 < 8; ++j8) {
            if ((j8 + 1) * 8 <= nsteps) {
#pragma unroll
                for (int j = j8 * 8; j < j8 * 8 + 8; ++j) kreg[j] = kbuf[j * 64 + lane];
            } else if (j8 * 8 < nsteps) {
#pragma unroll
                for (int j = j8 * 8; j < j8 * 8 + 8; ++j) { const unsigned kv_ = kbuf[j * 64 + lane]; kreg[j] = (j < nsteps) ? kv_ : 0u; }
            } else {
#pragma unroll
                for (int j = j8 * 8; j < j8 * 8 + 8; ++j) kreg[j] = 0u;
            }
        }
#define KLOOP(...) _Pragma("unroll") for (int j8 = 0; j8 < 8; ++j8) if (j8 * 8 < nsteps) { _Pragma("unroll") for (int j = j8 * 8; j < j8 * 8 + 8; ++j) { const unsigned k = kreg[j]; __VA_ARGS__ } }
        unsigned T = 0u; int scut = 4095;
        if (t >= 256) {
            constexpr int D1 = 11, BPL = (1 << D1) / 64;
            unsigned kmx = 0u, kmn1 = ~0u;
            KLOOP(kmx = max(kmx, k); kmn1 = min(kmn1, k - 1u);)
            kmx = wave_max_u(kmx); const unsigned kmn = wave_min_u(kmn1) + 1u;
            const unsigned range = kmx - kmn;
            unsigned above = 0u, ceq = 0u;
            if (range == 0u) T = kmn;
            else {
                const int msb = 31 - __builtin_clz(range), shift = (msb + 1 > D1) ? msb + 1 - D1 : 0;
                {
                    LAS u32x4* hz = (LAS u32x4*)(kbuf + BPL * lane);
#pragma unroll
                    for (int i = 0; i < BPL / 4; ++i) hz[i] = (u32x4){0u, 0u, 0u, 0u};
                }
#pragma unroll
                for (int j8 = 0; j8 < 8; ++j8) {
                    if ((j8 + 1) * 8 <= nsteps) {
#pragma unroll
                        for (int j = j8 * 8; j < j8 * 8 + 8; ++j) { const unsigned d = __builtin_elementwise_sub_sat(kreg[j], kmn); __hip_atomic_fetch_add(kbuf + (d >> shift), 1u, __ATOMIC_RELAXED, __HIP_MEMORY_SCOPE_WORKGROUP); }
                    } else if (j8 * 8 < nsteps) {
#pragma unroll
                        for (int j = j8 * 8; j < j8 * 8 + 8; ++j) if (j < nsteps) { const unsigned d = __builtin_elementwise_sub_sat(kreg[j], kmn); __hip_atomic_fetch_add(kbuf + (d >> shift), 1u, __ATOMIC_RELAXED, __HIP_MEMORY_SCOPE_WORKGROUP); }
                    }
                }
                lds_fence();
                const unsigned nzero = (unsigned)(64 * nsteps - (t + 1));
                unsigned s4 = 0u;
                {
                    const LAS u32x4* hr = (const LAS u32x4*)(kbuf + BPL * lane);
#pragma unroll
                    for (int i = 0; i < BPL / 4; ++i) { const u32x4 v = hr[i]; s4 += (v[0] + v[1]) + (v[2] + v[3]); }
                }
                if (lane == 0) s4 -= nzero;
                unsigned ps = s4;
                ps += (unsigned)__builtin_amdgcn_update_dpp(0, (int)ps, 0x111, 0xF, 0xF, true);
                ps += (unsigned)__builtin_amdgcn_update_dpp(0, (int)ps, 0x112, 0xF, 0xF, true);
                ps += (unsigned)__builtin_amdgcn_update_dpp(0, (int)ps, 0x114, 0xF, 0xF, true);
                ps += (unsigned)__builtin_amdgcn_update_dpp(0, (int)ps, 0x118, 0xF, 0xF, true);
                const unsigned r0t = (unsigned)__builtin_amdgcn_readlane((int)ps, 15), r1t = (unsigned)__builtin_amdgcn_readlane((int)ps, 31), r2t = (unsigned)__builtin_amdgcn_readlane((int)ps, 47), r3t = (unsigned)__builtin_amdgcn_readlane((int)ps, 63);
                ps += (lane >= 16 ? r0t : 0u) + (lane >= 32 ? r1t : 0u) + (lane >= 48 ? r2t : 0u);
                const unsigned total = (r0t + r1t) + (r2t + r3t);
                const unsigned sfx = total - ps;
                const bool mine = (sfx < 256u) && (sfx + s4 >= 256u);
                const unsigned long long mm = __ballot(mine);
                const int src = __builtin_ctzll(mm);
                const unsigned sfx_s = (unsigned)__builtin_amdgcn_readlane((int)sfx, src), tot_s = (unsigned)__builtin_amdgcn_readlane((int)s4, src);
                const int bi = lane & 31;
                unsigned hv = kbuf[BPL * src + bi];
                if (src == 0 && bi == 0) hv -= nzero;
                unsigned p2 = hv;
                p2 += (unsigned)__builtin_amdgcn_update_dpp(0, (int)p2, 0x111, 0xF, 0xF, true);
                p2 += (unsigned)__builtin_amdgcn_update_dpp(0, (int)p2, 0x112, 0xF, 0xF, true);
                p2 += (unsigned)__builtin_amdgcn_update_dpp(0, (int)p2, 0x114, 0xF, 0xF, true);
                p2 += (unsigned)__builtin_amdgcn_update_dpp(0, (int)p2, 0x118, 0xF, 0xF, true);
                const unsigned row0 = (unsigned)__builtin_amdgcn_readlane((int)p2, 15);
                p2 += (lane & 16) ? row0 : 0u;
                const unsigned cum = sfx_s + (tot_s - p2) + hv;
                const unsigned gem = (unsigned)__ballot(cum >= 256u);
                const int istar = 31 - __builtin_clz(gem);
                ceq = (unsigned)__builtin_amdgcn_readlane((int)hv, istar);
                above = (unsigned)__builtin_amdgcn_readlane((int)cum, istar) - ceq;
                const unsigned b1 = (unsigned)(BPL * src + istar);
                const unsigned klo = kmn + (b1 << shift);
                unsigned Td = 0u;
                int rem = shift;
                if (rem > 0) {
                    const unsigned width = 1u << shift;
                    LAS unsigned* wp = kbuf + lane;
                    KLOOP(const unsigned d = k - klo; *wp = d; wp += (d < width) ? 64 : 0;)
                    const unsigned cnt = (unsigned)(wp - (kbuf + lane)) >> 6;
                    const int mcnt = (int)wave_max_u(cnt);
                    while (rem > 0) {
                        const int wd = (rem < 8) ? rem : 8, sh = rem - wd;
                        *(LAS u32x4*)(hist + 4 * lane) = (u32x4){0u, 0u, 0u, 0u};
                        lds_fence();
                        const unsigned pref = Td >> rem;
                        const unsigned dmask = (1u << wd) - 1u;
                        for (int i = 0; i < mcnt; ++i) {
                            const unsigned d = kbuf[i * 64 + lane];
                            if ((unsigned)i < cnt && (d >> rem) == pref) __hip_atomic_fetch_add(hist + ((d >> sh) & dmask), 1u, __ATOMIC_RELAXED, __HIP_MEMORY_SCOPE_WORKGROUP);
                        }
                        lds_fence();
                        const u32x4 h4 = *(const LAS u32x4*)(hist + 4 * lane);
                        const unsigned q4 = (h4[0] + h4[1]) + (h4[2] + h4[3]);
                        unsigned p2 = q4;
                        p2 += (unsigned)__builtin_amdgcn_update_dpp(0, (int)p2, 0x111, 0xF, 0xF, true);
                        p2 += (unsigned)__builtin_amdgcn_update_dpp(0, (int)p2, 0x112, 0xF, 0xF, true);
                        p2 += (unsigned)__builtin_amdgcn_update_dpp(0, (int)p2, 0x114, 0xF, 0xF, true);
                        p2 += (unsigned)__builtin_amdgcn_update_dpp(0, (int)p2, 0x118, 0xF, 0xF, true);
                        const unsigned u0 = (unsigned)__builtin_amdgcn_readlane((int)p2, 15), u1 = (unsigned)__builtin_amdgcn_readlane((int)p2, 31), u2 = (unsigned)__builtin_amdgcn_readlane((int)p2, 47), u3 = (unsigned)__builtin_amdgcn_readlane((int)p2, 63);
                        p2 += (lane >= 16 ? u0 : 0u) + (lane >= 32 ? u1 : 0u) + (lane >= 48 ? u2 : 0u);
                        const unsigned tot2 = (u0 + u1) + (u2 + u3);
                        const unsigned sfx2 = above + (tot2 - p2);
                        const bool mine2 = (sfx2 < 256u) && (sfx2 + q4 >= 256u);
                        unsigned bs2 = 0u, ab3 = 0u, cq2 = 0u;
                        if (mine2) {
                            unsigned acc_ = sfx2;
                            if (acc_ + h4[3] >= 256u) { bs2 = 3u; ab3 = acc_; cq2 = h4[3]; }
                            else { acc_ += h4[3];
                                if (acc_ + h4[2] >= 256u) { bs2 = 2u; ab3 = acc_; cq2 = h4[2]; }
                                else { acc_ += h4[2];
                                    if (acc_ + h4[1] >= 256u) { bs2 = 1u; ab3 = acc_; cq2 = h4[1]; }
                                    else { acc_ += h4[1]; bs2 = 0u; ab3 = acc_; cq2 = h4[0]; } } }
                            bs2 += 4u * (unsigned)lane;
                        }
                        const unsigned long long mm2 = __ballot(mine2);
                        const int src2 = __builtin_ctzll(mm2);
                        bs2 = (unsigned)__builtin_amdgcn_readlane((int)bs2, src2); above = (unsigned)__builtin_amdgcn_readlane((int)ab3, src2); ceq = (unsigned)__builtin_amdgcn_readlane((int)cq2, src2);
                        Td |= bs2 << sh;
                        rem = sh;
                    }
                }
                T = klo + Td;
            }
            if (range == 0u) {
                unsigned ce = 0u;
                KLOOP(ce += (k == T) ? 1u : 0u;)
                ceq = wave_add_u(ce); above = 0u;
            }
            const int need = 256 - (int)above;
            if ((int)ceq > need) {
                int accn = 0, jS = -1, kS = 0; unsigned long long emS = 0ull;
                KLOOP(const unsigned long long em = __ballot(k == T); const int c = __popcll(em); if (jS < 0 && accn + c >= need) { jS = j; emS = em; kS = need - accn; } accn += c;)
                if (jS >= 0) { while (kS > 1) { emS &= emS - 1ull; --kS; } scut = jS * 64 + __builtin_ctzll(emS); }
            }
        }
        unsigned* bm = (unsigned*)(F.ws + WS_BM) + (size_t)(b * SEQ + t) * 128;
        int mlo = 0, mhi = 0;
        const unsigned Tm = (T == 0u) ? 1u : T; const bool cut = (scut != 4095);
#define DSA_BMW(sm_) asm("s_nop 1\n\tv_writelane_b32 %0, %2, %4\n\tv_writelane_b32 %1, %3, %4" : "+v"(mlo), "+v"(mhi) : "s"((int)(unsigned)(sm_)), "s"((int)(unsigned)((sm_) >> 32)), "n"(j))
        if (!cut) { KLOOP(const unsigned long long sm = __ballot(k >= Tm); DSA_BMW(sm);) }
        else { KLOOP(const unsigned long long sm = __ballot(k > T || (k == T && T != 0u && (j * 64 + lane) <= scut)); DSA_BMW(sm);) }
#undef DSA_BMW
        if (lane < nsteps) *(u32x2*)(bm + 2 * lane) = (u32x2){(unsigned)mlo, (unsigned)mhi};
#undef KLOOP
    }
    __syncthreads();
}

__device__ __forceinline__ void pass2(Frame& F, int L, ArgsP a, int b, int c) {
    const int lane = F.lane, w = F.wave, hf = lane >> 5, rho = lane & 31, hd = w & 3, qh = w >> 2;
    const int tq = 32 * qh + rho, t = 64 * c + tq, m = b * SEQ + t;
    const f16* PH = (const f16*)(F.ws + WS_PH);
    h8 qf[9];
    {
        const f16* qp = PH + (size_t)m * PH_LD + H_QA + hd * 144 + 8 * hf;
        h8 qv[9];
#pragma unroll
        for (int s = 0; s < 9; ++s) qv[s] = *(const h8*)(qp + 16 * s);
        asm volatile("" : "+v"(qv[0]), "+v"(qv[1]), "+v"(qv[2]), "+v"(qv[3]), "+v"(qv[4]), "+v"(qv[5]), "+v"(qv[6]), "+v"(qv[7]), "+v"(qv[8]));
#pragma unroll
        for (int s = 0; s < 9; ++s) { const h8 v = qv[s];
#pragma unroll
            for (int j = 0; j < 8; ++j) qf[s][j] = (f16)((float)v[j] * QSC); }
    }
    f32x16 O[4]; float mrun = -1e30f, lrun = 0.f;
#pragma unroll
    for (int d = 0; d < 4; ++d)
#pragma unroll
        for (int i = 0; i < 16; ++i) O[d][i] = 0.f;
    const unsigned* bm = (const unsigned*)(F.ws + WS_BM) + (size_t)m * 128;
    const int srow = F.tid >> 3, sj = F.tid & 7;
    const f16* kb = PH + (size_t)(b * SEQ + srow) * PH_LD + H_KA + sj * 8;
    LAS unsigned char* kdst = F.lds + KT + srow * KRS + sj * 16; LAS unsigned char* vdst = F.lds + VT + srow * VRS + sj * 16;
    f32x4 r0, r1, r2;
#define DSA_LOAD(blk) do { const f16* kbb = kb + (size_t)((blk) * 64) * PH_LD; r0 = *(const f32x4*)kbb; r1 = *(const f32x4*)(kbb + 64); if (sj < 2) r2 = *(const f32x4*)(kbb + 128); } while (0)
#define DSA_WRITE(buf) do { LAS unsigned char* kd_ = kdst + (buf) * KTB; LAS unsigned char* vd_ = vdst + (buf) * VTB; \
        *(LAS f32x4*)kd_ = r0; *(LAS f32x4*)(kd_ + 128) = r1; if (sj < 2) *(LAS f32x4*)(kd_ + 256) = r2; *(LAS f32x4*)vd_ = r0; *(LAS f32x4*)(vd_ + 128) = r1; } while (0)
    DSA_LOAD(0);
    u32x2 mw = __builtin_nontemporal_load((const u32x2*)bm);
    for (int blk = 0; blk <= c; ++blk) {
        const int buf = blk & 1;
        DSA_WRITE(buf);
        __syncthreads();
        const u32x2 mcur = mw;
        if (blk + 1 <= c) { DSA_LOAD(blk + 1); mw = __builtin_nontemporal_load((const u32x2*)(bm + 2 * (blk + 1))); }
        f32x16 S0, S1;
#pragma unroll
        for (int i = 0; i < 16; ++i) { S0[i] = 0.f; S1[i] = 0.f; }
        {
            LAS const unsigned char* k0 = F.lds + KT + buf * KTB + rho * KRS + hf * 16;
            h8 ka0[3], ka1[3];
            ka0[0] = *(const LAS h8*)(k0); ka1[0] = *(const LAS h8*)(k0 + 32 * KRS); ka0[1] = *(const LAS h8*)(k0 + 32); ka1[1] = *(const LAS h8*)(k0 + 32 * KRS + 32);
            __builtin_amdgcn_sched_barrier(0);
#pragma unroll
            for (int s = 0; s < 9; ++s) {
                if (s + 2 < 9) { ka0[(s + 2) % 3] = *(const LAS h8*)(k0 + (s + 2) * 32); ka1[(s + 2) % 3] = *(const LAS h8*)(k0 + 32 * KRS + (s + 2) * 32); }
                __builtin_amdgcn_sched_barrier(0);
                S0 = MFMA32(ka0[s % 3], qf[s], S0); S1 = MFMA32(ka1[s % 3], qf[s], S1);
                __builtin_amdgcn_sched_barrier(0);
            }
        }
        {
            const unsigned m0 = mcur[0] >> (4 * hf), m1 = mcur[1] >> (4 * hf);
            const float ninf = -INFINITY;
            asm volatile("s_nop 15\n\ts_nop 7" : "+v"(S0), "+v"(S1));
#pragma unroll
            for (int i = 0; i < 16; ++i) {
                int k0, k1; float s0 = S0[i], s1 = S1[i];
                asm("v_bfe_i32 %0, %1, %2, 1" : "=v"(k0) : "v"(m0), "n"((i & 3) + 8 * (i >> 2)));
                asm("v_bfe_i32 %0, %1, %2, 1" : "=v"(k1) : "v"(m1), "n"((i & 3) + 8 * (i >> 2)));
                asm("v_bfi_b32 %0, %1, %2, %3" : "=v"(s0) : "v"(k0), "v"(s0), "v"(ninf));
                asm("v_bfi_b32 %0, %1, %2, %3" : "=v"(s1) : "v"(k1), "v"(s1), "v"(ninf));
                S0[i] = s0; S1[i] = s1;
            }
        }
        float mx;
        {
            float a_ = nsa::max3f(S0[0], S0[1], S0[2]), b_ = nsa::max3f(S0[3], S0[4], S0[5]), c_ = nsa::max3f(S0[6], S0[7], S0[8]), d_ = nsa::max3f(S0[9], S0[10], S0[11]);
            a_ = nsa::max3f(a_, S0[12], S0[13]); b_ = nsa::max3f(b_, S0[14], S0[15]); c_ = nsa::max3f(c_, S1[0], S1[1]); d_ = nsa::max3f(d_, S1[2], S1[3]);
            a_ = nsa::max3f(a_, S1[4], S1[5]); b_ = nsa::max3f(b_, S1[6], S1[7]); c_ = nsa::max3f(c_, S1[8], S1[9]); d_ = nsa::max3f(d_, S1[10], S1[11]);
            a_ = nsa::max3f(a_, S1[12], S1[13]); b_ = nsa::max3f(b_, S1[14], S1[15]);
            mx = nsa::max3f(a_, b_, nsa::max2f(c_, d_));
        }
        mx = max_x32(mx);
        const float mold = mrun, mn = (mx > mrun + 8.f) ? mx : mrun; mrun = mn;
        float alpha = 1.f;
        if (__any(mn > mold)) {
            asm volatile("" ::: "memory");
            alpha = __builtin_amdgcn_exp2f(mold - mn);
            O[0] = O[0] * alpha; O[1] = O[1] * alpha; O[2] = O[2] * alpha; O[3] = O[3] * alpha;
        }
#pragma unroll
        for (int i = 0; i < 16; i += 2) {
            const f32x2 nm2 = {-mn, -mn};
            const f32x2 a = (f32x2){S0[i], S0[i + 1]} + nm2, b2 = (f32x2){S1[i], S1[i + 1]} + nm2;
            S0[i] = __builtin_amdgcn_exp2f(a[0]); S0[i + 1] = __builtin_amdgcn_exp2f(a[1]); S1[i] = __builtin_amdgcn_exp2f(b2[0]); S1[i + 1] = __builtin_amdgcn_exp2f(b2[1]); }
        const float sm = nsa::sum32(S0, S1);
        lrun = lrun * alpha + sm;
        {
            const int blk16 = (lane >> 4) & 1, q4 = (lane & 15) >> 2, p4 = lane & 3;
            LAS const unsigned char* vb = F.lds + VT + buf * VTB + (4 * hf + q4) * VRS + (16 * blk16 + 4 * p4) * 2;
            h4 vl[3], vh[3];
#define DSA_VRD(i) do { LAS const unsigned char* ad_ = vb + (16 * ((i) >> 2)) * VRS + 64 * ((i) & 3); vl[(i) % 3] = nsa::tr_read4(ad_); vh[(i) % 3] = nsa::tr_read4(ad_ + 8 * VRS); } while (0)
            DSA_VRD(0); DSA_VRD(1);
            h8 pf[4];
            pf[0] = nsa::pack_step(S0, 0);
            __builtin_amdgcn_sched_barrier(0);
#pragma unroll
            for (int i = 0; i < 16; ++i) {
                if (i + 2 < 16) DSA_VRD(i + 2);
                __builtin_amdgcn_sched_barrier(0);
                const h8 av = __builtin_shufflevector(vl[i % 3], vh[i % 3], 0, 1, 2, 3, 4, 5, 6, 7);
                O[i & 3] = MFMA32(av, pf[i >> 2], O[i & 3]);
                if ((i & 3) == 1 && i < 12) pf[(i >> 2) + 1] = (i < 4) ? nsa::pack_step(S0, 1) : nsa::pack_step(S1, (i >> 2) - 1);
                __builtin_amdgcn_sched_barrier(0);
            }
#undef DSA_VRD
        }
    }
#undef DSA_LOAD
#undef DSA_WRITE
    lrun = add_x32(lrun);
    const float invl = (lrun > 0.f) ? 1.f / lrun : 0.f;
    f32x16 A2[2];
#pragma unroll
    for (int i = 0; i < 16; ++i) { A2[0][i] = 0.f; A2[1][i] = 0.f; }
    {
        const f16* wt = (const f16*)(F.ws + WS_WUVT) + (size_t)((L * 4 + hd) * 64 + rho) * 128 + 4 * hf;
        wt = launder_g(wt);
        h4 wlo[4][2][2], whi[4][2][2];
#pragma unroll
        for (int d = 0; d < 4; ++d)
#pragma unroll
            for (int s = 0; s < 2; ++s)
#pragma unroll
                for (int vt = 0; vt < 2; ++vt) { const f16* wp = wt + (size_t)(32 * vt) * 128 + 32 * d + 16 * s; wlo[d][s][vt] = *(const h4*)wp; whi[d][s][vt] = *(const h4*)(wp + 8); }
#pragma unroll
        for (int d = 0; d < 4; ++d) {
            O[d] = O[d] * invl;
#pragma unroll
            for (int s = 0; s < 2; ++s) {
                const h8 pf = nsa::pack_step(O[d], s);
#pragma unroll
                for (int vt = 0; vt < 2; ++vt) {
                    const h8 av = __builtin_shufflevector(wlo[d][s][vt], whi[d][s][vt], 0, 1, 2, 3, 4, 5, 6, 7);
                    A2[vt] = MFMA32(av, pf, A2[vt]);
                }
            }
        }
    }
    float sq = 0.f;
#pragma unroll
    for (int i = 0; i < 16; ++i) sq += A2[0][i] * A2[0][i] + A2[1][i] * A2[1][i];
    sq = add_x32(sq);
    LAS float* ssq = (LAS float*)(F.lds + SSQ);
    __syncthreads();
    if (hf == 0) ssq[w * 32 + rho] = sq;
    __syncthreads();
    const float tot = (ssq[(qh * 4 + 0) * 32 + rho] + ssq[(qh * 4 + 1) * 32 + rho]) + (ssq[(qh * 4 + 2) * 32 + rho] + ssq[(qh * 4 + 3) * 32 + rho]);
    const float rn = rsqrtf(tot * (1.f / 256.f) + EPS);
    const float* ga = gin(a, 23) + L * 256 + hd * 64 + 4 * hf;
    f16* dst = (f16*)(F.ws + WS_XA) + (size_t)m * D + hd * 64 + 4 * hf;
    dst = launder_g(dst); ga = launder_g(ga);
    f32x4 gav[8];
#pragma unroll
    for (int k = 0; k < 8; ++k) gav[k] = *(const f32x4*)(ga + 32 * (k >> 2) + 8 * (k & 3));
#pragma unroll
    for (int vt = 0; vt < 2; ++vt)
#pragma unroll
        for (int r4 = 0; r4 < 4; ++r4) {
            const int col = 32 * vt + 8 * r4; const f32x4 gn = gav[vt * 4 + r4];
            h4 o; o[0] = (f16)(A2[vt][4 * r4] * rn * gn[0]); o[1] = (f16)(A2[vt][4 * r4 + 1] * rn * gn[1]); o[2] = (f16)(A2[vt][4 * r4 + 2] * rn * gn[2]); o[3] = (f16)(A2[vt][4 * r4 + 3] * rn * gn[3]);
            *(u32x2*)(dst + col) = __builtin_bit_cast(u32x2, o);
        }
    __syncthreads();
}

__device__ __forceinline__ void item(Frame& F, int L, ArgsP a, int b, int c) {
    P1Ops ops; pass1_load(F, b, 64 * c, ops);
    for (int r = 0; r < 8; ++r) pass1_round(F, b, 64 * c + 8 * r, ops, r < 7);
    refresh(F); asm volatile("" : "+s"(b), "+s"(c));
    pass2(F, L, a, b, c);
    refresh(F);
}
}

__device__ __forceinline__ void p4_dsa_nsa(Frame& F, int L, ArgsP a) {
    for (int p = F.bx; p < BATCH * 32; p += F.G) {
        const int b = p & 7, c = p >> 3;
        dsa::item(F, L, a, b, 63 - c);
        dsa::item(F, L, a, b, c);
    }
    __syncthreads();
    refresh(F);
    for (int p = F.bx; p < BATCH * 32; p += F.G) {
        const int b = p & 7, c = p >> 3;
        nsa::item(F, L, a, b, 63 - c);
        nsa::item(F, L, a, b, c);
    }
    __syncthreads();
}

__device__ __forceinline__ void p_final(Frame& F, ArgsP a) {
    const float* ss = (const float*)(F.ws + WS_SS1); const float* fg = gin(a, 30); const f16* XB = (const f16*)(F.ws + WS_XB);
    for (int m = F.gw; m < M; m += F.ngw) {
        const float r = pg8::rstd_from_ss(ss, m) * (1.f / XSCALE);
#pragma unroll
        for (int j = 0; j < 2; ++j) {
            const size_t off = (size_t)m * D + j * 512 + F.lane * 8;
            const h8 xh = *(const h8*)(XB + off); const f32x4 g0 = *(const f32x4*)(fg + j * 512 + F.lane * 8), g1 = *(const f32x4*)(fg + j * 512 + F.lane * 8 + 4);
            const f32x4 v0 = (f32x4){(float)xh[0], (float)xh[1], (float)xh[2], (float)xh[3]} * r * g0, v1 = (f32x4){(float)xh[4], (float)xh[5], (float)xh[6], (float)xh[7]} * r * g1;
            *(f32x4*)(gout(a) + off) = v0; *(f32x4*)(gout(a) + off + 4) = v1;
        }
    }
}

constexpr int N_PHASES = 14;
__global__ void __launch_bounds__(NTHREADS, 2) fwd(Args a_) {
    extern __shared__ __attribute__((aligned(16))) unsigned char lds_raw[];
    cg::grid_group grid = cg::this_grid();
    ArgsP a = fresh_args();
    Frame F;
    F.lds = (LAS unsigned char*)lds_raw; F.ws = (GAS unsigned char*)a->ws;
    F.tid = threadIdx.x; F.lane = F.tid & 63; F.wave = __builtin_amdgcn_readfirstlane(F.tid >> 6);
    F.G = gridDim.x; F.bx = blockIdx.x; F.gw = blockIdx.x * NWAVES + F.wave; F.ngw = F.G * NWAVES;
    const int lo = a->ph_lo, hi = a->ph_hi;
    volatile LAS unsigned* xst = (volatile LAS unsigned*)(F.lds + LDS_BYTES - 16);
    if (F.tid == 0) { xst[0] = 0u; xst[1] = 0u; }
    __syncthreads();
    XcdBarrier xbar = xcd_barrier_post((unsigned*)a->ws, xst, F.wave);
#define IN(k) (lo <= (k) && (k) < hi)
#define SEAM(k) do { if (IN(k) && IN((k) + 1)) { if ((k) == 0) grid.sync(); else xcd_barrier(xbar); } } while (0)
    if (IN(0)) { refresh(F); a = fresh_args(); p0_prologue(F, a); }
    SEAM(0);
    for (int L = 0; L < DEPTH; ++L) {
        const int pb = 1 + 6 * L;
        GAS unsigned char* wl = F.ws + WS_W + (size_t)L * WL_STRIDE;
        if (IN(pb + 0)) {
            refresh(F); a = fresh_args();
            {
                pg8::Gemm g{(const f16*)(F.ws + (L == 0 ? WS_XA : WS_XB)), (const f16*)(wl + WL_INP), D, D, D, nullptr, nullptr, nullptr, nullptr, nullptr, 1.f, 1.f};
                pg8::StaticOrder S; S.init(M, NPREC + NPLAIN, F.G, F.bx);
                pg8::EpiInX E{(float*)(F.ws + WS_PP), (f16*)(F.ws + WS_PH), (const float*)(F.ws + WS_SS1), 1.f / (XSCALE * WSCALE), 1.f / XSCALE};
                pg8::gemm_phase<pg8::EpiInX, false>(F.lds, g, S, E, F.wave);
            }
        }
        SEAM(pb + 0);
        if (IN(pb + 1)) { refresh(F); a = fresh_args(); p2_finalize(F, L, a); refresh(F); a = fresh_args(); p2_compress(F, L, a); refresh(F); a = fresh_args(); p2_s5_local(F, L); }
        SEAM(pb + 1);
        if (IN(pb + 2)) { refresh(F); a = fresh_args(); p4_s5_out(F, L, a); refresh(F); a = fresh_args(); p4_dsa_nsa(F, L, a); }
        SEAM(pb + 2);
        if (IN(pb + 3)) {
            refresh(F); a = fresh_args();
            pg8::Gemm g{(const f16*)(F.ws + WS_XA), (const f16*)(wl + WL_OUT), D, D, D, nullptr, nullptr, nullptr, nullptr, nullptr, 1.f, 1.f};
            pg8::StaticOrder S; S.init(M, D, F.G, F.bx);
            if (L == 0) { g.xin_f = gin(a, 0); g.XH = (f16*)(F.ws + WS_XB); g.ss = (float*)(F.ws + WS_SS2);
                pg8::EpiRes<false, false, true> E; pg8::gemm_phase<pg8::EpiRes<false, false, true>, false>(F.lds, g, S, E, F.wave); }
            else { g.xin_h = (const f16*)(F.ws + WS_XB); g.rs = 1.f / XSCALE; g.XH = (f16*)(F.ws + WS_XB); g.ss = (float*)(F.ws + WS_SS2);
                pg8::EpiRes<true, false, true> E; pg8::gemm_phase<pg8::EpiRes<true, false, true>, false>(F.lds, g, S, E, F.wave); }
        }
        SEAM(pb + 3);
        if (IN(pb + 4)) {
            refresh(F); a = fresh_args();
            pg8::Gemm g{(const f16*)(F.ws + WS_XB), (const f16*)(wl + WL_UP), D, D, D, nullptr, nullptr, nullptr, nullptr, nullptr, 1.f, 1.f};
            pg8::StaticOrder S; S.init(M, DFF, F.G, F.bx);
            pg8::EpiUp E{(f16*)(F.ws + WS_H), (const float*)(F.ws + WS_SS2)};
            pg8::gemm_phase<pg8::EpiUp, false>(F.lds, g, S, E, F.wave);
        }
        SEAM(pb + 4);
        if (IN(pb + 5)) {
            refresh(F); a = fresh_args();
            pg8::Gemm g{(const f16*)(F.ws + WS_H), (const f16*)(wl + WL_DOWN), DFF, DFF, DFF, nullptr, nullptr, nullptr, nullptr, nullptr, 1.f, 1.f};
            pg8::StaticOrder S; S.init(M, D, F.G, F.bx, 1);
            g.xin_h = (const f16*)(F.ws + WS_XB); g.ss = (float*)(F.ws + WS_SS1);
            g.XH = (f16*)(F.ws + WS_XB); g.hs = XSCALE;
            { pg8::EpiRes<true, false, true> E; pg8::gemm_phase<pg8::EpiRes<true, false, true>, false>(F.lds, g, S, E, F.wave); }
        }
        SEAM(pb + 5);
    }
    if (IN(13)) { refresh(F); a = fresh_args(); p_final(F, a); }
#undef IN
#undef SEAM
}

#ifndef MK_MULTI
#define MK_MULTI 0
#endif
extern "C" void kernel_launch(void* const* d_in, const int* in_sizes, int n_in, void* d_out, int out_size,
                              void* d_ws, size_t ws_size, hipStream_t stream) {
    static int grid = 0;
    if (grid == 0) {
        int dev = 0, cus = 0, per_cu = 0;
        (void)hipGetDevice(&dev);
        (void)hipDeviceGetAttribute(&cus, hipDeviceAttributeMultiprocessorCount, dev);
        (void)hipFuncSetAttribute((const void*)fwd, hipFuncAttributeMaxDynamicSharedMemorySize, LDS_BYTES);
        (void)hipOccupancyMaxActiveBlocksPerMultiprocessor(&per_cu, (const void*)fwd, NTHREADS, LDS_BYTES);
        if (per_cu < 1) per_cu = 1;
        grid = cus * per_cu;
        if (n_in != 31 || ws_size < WS_END) fprintf(stderr, "kernel_launch: unexpected n_in %d / ws %zu\n", n_in, ws_size);
        fprintf(stderr, "grid %d (cus %d per_cu %d) ws %zu\n", grid, cus, per_cu, ws_size);
    }
    (void)hipMemsetAsync(d_ws, 0, 16384, stream);
    Args a{};
    for (int i = 0; i < 31; ++i) a.in[i] = (const float*)d_in[i];
    a.out = (float*)d_out; a.ws = (unsigned char*)d_ws;
    for (int i = 0; i < 8; ++i) a.inv16[i] = (float)pow(500000.0, -(double)(2 * i) / 16.0);
    for (int i = 0; i < 4; ++i) a.inv8[i] = (float)pow(500000.0, -(double)(2 * i) / 8.0);
#if MK_MULTI
    for (int p = 0; p < N_PHASES; ++p) { a.ph_lo = p; a.ph_hi = p + 1; hipLaunchKernelGGL(fwd, dim3(grid), dim3(NTHREADS), LDS_BYTES, stream, a); }
#else
    a.ph_lo = 0; a.ph_hi = N_PHASES;
    void* args[] = {&a};
    hipError_t e = hipLaunchCooperativeKernel((const void*)fwd, dim3(grid), dim3(NTHREADS), args, LDS_BYTES, stream);
    if (e != hipSuccess) fprintf(stderr, "cooperative launch failed: %s (grid %d)\n", hipGetErrorString(e), grid);
#endif
}
```
